# Optimizing an MI355X kernel written in HIP

```python
import math
import jax
import jax.numpy as jnp
from jax import lax
import numpy as np

D_MODEL = 1024
BATCH = 2
SEQ = 16384
DEPTH = 4

CTX_LEN = 256
GRID_W = 64
D_S5 = D_MODEL // 2
S5_GROUP = 16
S5_GROUPS = D_S5 // S5_GROUP
S5_STATE = 64
D_HGRN = D_MODEL // 2
HGRN_EXPAND = 128
HGRN_HEADS = D_HGRN // HGRN_EXPAND
HGRN_DK = HGRN_EXPAND
HGRN_DV = D_HGRN // HGRN_HEADS
HGRN_CHUNK = 64
N_IN = D_S5 + 5 * D_HGRN + 2 * D_MODEL
N_EXPERTS = 32
TOP_K = 4
D_FF = D_MODEL
SWIGLU_LIMIT = 7.0
SWIGLU_ALPHA = 1.702
MOE_BLOCK = 128
N_MOD = 6
EPS = 1e-6

kernel_name = 'hybrid_s5_hgrn2_moe_flow_trunk'


def _rms_norm(x, g):
    xf = x.astype(jnp.float32)
    y = xf * lax.rsqrt(jnp.mean(xf * xf, axis=-1, keepdims=True) + EPS) * g.astype(jnp.float32)
    return y.astype(x.dtype)


def _to_colmajor(h, rows):
    b, n, d = h.shape
    return h.reshape(b, rows, GRID_W, d).transpose(0, 2, 1, 3).reshape(b, n, d)


def _from_colmajor(h, rows):
    b, n, d = h.shape
    return h.reshape(b, GRID_W, rows, d).transpose(0, 2, 1, 3).reshape(b, n, d)


def _split_in(z):
    sizes = (D_S5, D_HGRN, D_HGRN, D_HGRN, D_HGRN, D_HGRN, D_MODEL, D_MODEL)
    return jnp.split(z, [int(i) for i in np.cumsum(sizes)[:-1]], axis=-1)


def _complex_affine_combine(e1, e2):
    a1r, a1i, b1r, b1i = e1
    a2r, a2i, b2r, b2i = e2
    return (a2r * a1r - a2i * a1i,
            a2r * a1i + a2i * a1r,
            a2r * b1r - a2i * b1i + b2r,
            a2r * b1i + a2i * b1r + b2i)


def _s5_discretise(a_re, a_im, log_dt, b_re, b_im):
    a_re, a_im, b_re, b_im = (t.astype(jnp.float32) for t in (a_re, a_im, b_re, b_im))
    dt = jnp.exp(log_dt.astype(jnp.float32))[:, None]
    mag = jnp.exp(a_re * dt)
    lbr = mag * jnp.cos(a_im * dt)
    lbi = mag * jnp.sin(a_im * dt)
    den = a_re * a_re + a_im * a_im
    nr = lbr - 1.0
    qr = ((nr * a_re + lbi * a_im) / den)[..., None]
    qi = ((lbi * a_re - nr * a_im) / den)[..., None]
    return lbr, lbi, qr * b_re - qi * b_im, qr * b_im + qi * b_re


def _s5_scan(ur, ui, lbr, lbi):
    n = ur.shape[1]
    ar = jnp.broadcast_to(lbr, (1, n) + lbr.shape)
    ai = jnp.broadcast_to(lbi, (1, n) + lbi.shape)
    _, _, xr, xi = lax.associative_scan(_complex_affine_combine, (ar, ai, ur, ui), axis=1)
    return xr, xi


def _s5_direction(uc, ul, lbr, lbi, bbr, bbi, cr, ci, need_ctx):
    def drive(u):
        return (jnp.einsum('blgh,gph->blgp', u, bbr), jnp.einsum('blgh,gph->blgp', u, bbi))

    def readout(xr, xi):
        return (jnp.einsum('blgp,ghp->blgh', xr, cr.astype(jnp.float32))
                - jnp.einsum('blgp,ghp->blgh', xi, ci.astype(jnp.float32)))

    xcr, xci = _s5_scan(*drive(uc), lbr, lbi)
    x0r, x0i = xcr[:, -1], xci[:, -1]
    ur, ui = drive(ul)
    ur = ur.at[:, 0].add(lbr * x0r - lbi * x0i)
    ui = ui.at[:, 0].add(lbr * x0i + lbi * x0r)
    xlr, xli = _s5_scan(ur, ui, lbr, lbi)
    yc = readout(xcr, xci) if need_ctx else None
    return yc, readout(xlr, xli)


def _s5_branch(uc, ul, a_re, a_im, log_dt, b_re, b_im, c_re, c_im, d_skip, w_glu, need_ctx):
    dtype = ul.dtype

    def grp(u):
        b, n, _ = u.shape
        return u.astype(jnp.float32).reshape(b, n, S5_GROUPS, S5_GROUP)

    ucg, ulg = grp(uc), grp(ul)
    yc, yl = None, None
    for d in range(2):
        lbr, lbi, bbr, bbi = _s5_discretise(a_re[d], a_im[d], log_dt[d], b_re[d], b_im[d])
        ucd, uld = (ucg, ulg) if d == 0 else (jnp.flip(ucg, axis=1), jnp.flip(ulg, axis=1))
        ycd, yld = _s5_direction(ucd, uld, lbr, lbi, bbr, bbi, c_re[d], c_im[d], need_ctx)
        if d == 1:
            yld = jnp.flip(yld, axis=1)
            ycd = jnp.flip(ycd, axis=1) if need_ctx else None
        yl = yld if yl is None else yl + yld
        if need_ctx:
            yc = ycd if yc is None else yc + ycd
    d_g = d_skip.astype(jnp.float32).reshape(S5_GROUPS, S5_GROUP)
    wg = w_glu.astype(jnp.float32)

    def finish(y, u):
        b, n = y.shape[:2]
        z = jax.nn.gelu((y + d_g * u).reshape(b, n, D_S5))
        return (z * jax.nn.sigmoid(z @ wg)).astype(dtype)

    return (finish(yc, ucg) if need_ctx else None), finish(yl, ulg)


def _heads(t):
    b, n, _ = t.shape
    return t.astype(jnp.float32).reshape(b, n, HGRN_HEADS, -1).transpose(0, 2, 1, 3)


def _hgrn2_gates(f_logit, lb):
    lb = lb.reshape(HGRN_HEADS, 1, HGRN_DK)
    logf = jnp.log(lb + (1.0 - lb) * jax.nn.sigmoid(f_logit))
    k = (1.0 - lb) * jax.nn.sigmoid(-f_logit)
    return logf, k


def _hgrn2_chunk_scan(q, k, v, logf, s0):
    b, h, n, _ = q.shape
    nc = n // HGRN_CHUNK

    def blocks(t):
        return jnp.moveaxis(t.reshape(b, h, nc, HGRN_CHUNK, t.shape[-1]), 2, 0)

    tril = jnp.tril(jnp.ones((HGRN_CHUNK, HGRN_CHUNK), dtype=bool))[:, :, None]
    tril_f = tril.astype(jnp.float32)

    def step(state, inp):
        qc, kc, vc, gc = inp
        cum = jnp.cumsum(gc, axis=2)
        rel = cum[:, :, :, None, :] - cum[:, :, None, :, :]
        decay = jnp.exp(jnp.where(tril, rel, 0.0)) * tril_f
        scores = jnp.einsum('bhtd,bhsd,bhtsd->bhts', qc, kc, decay)
        o = (jnp.einsum('bhts,bhse->bhte', scores, vc)
             + jnp.einsum('bhtd,bhde->bhte', qc * jnp.exp(cum), state))
        tot = cum[:, :, -1:, :]
        state = (jnp.exp(tot)[:, :, 0, :, None] * state
                 + jnp.einsum('bhsd,bhse->bhde', kc * jnp.exp(tot - cum), vc))
        return state, o

    s_fin, o = lax.scan(step, s0, (blocks(q), blocks(k), blocks(v), blocks(logf)))
    return s_fin, jnp.moveaxis(o, 0, 2).reshape(b, h, n, v.shape[-1])


def _hgrn2_readout(o, g, norm_g, dtype):
    o = o * lax.rsqrt(jnp.mean(o * o, axis=-1, keepdims=True) + EPS) * norm_g.astype(jnp.float32)
    b, h, n, dv = o.shape
    o = o.transpose(0, 2, 1, 3).reshape(b, n, h * dv)
    return (o * jax.nn.silu(g.astype(jnp.float32))).astype(dtype)


def _hgrn2_branch(qc, ic, fcf, fcb, gc, ql, il, flf, flb, gl, lb, norm_g, need_ctx):
    dtype = ql.dtype
    qch, ich, qlh, ilh = _heads(qc), _heads(ic), _heads(ql), _heads(il)
    b = qlh.shape[0]
    s0 = jnp.zeros((b, HGRN_HEADS, HGRN_DK, HGRN_DV), jnp.float32)
    oc, ol = None, None
    for d, (fc, fl) in enumerate(((fcf, flf), (fcb, flb))):
        logf_c, k_c = _hgrn2_gates(_heads(fc), lb[d])
        logf_l, k_l = _hgrn2_gates(_heads(fl), lb[d])
        args_c = (qch, k_c, ich, logf_c)
        args_l = (qlh, k_l, ilh, logf_l)
        if d == 1:
            args_c = tuple(jnp.flip(t, axis=2) for t in args_c)
            args_l = tuple(jnp.flip(t, axis=2) for t in args_l)
        s_ctx, ocd = _hgrn2_chunk_scan(*args_c, s0)
        _, old = _hgrn2_chunk_scan(*args_l, s_ctx)
        if d == 1:
            ocd, old = jnp.flip(ocd, axis=2), jnp.flip(old, axis=2)
        oc = ocd if oc is None else oc + ocd
        ol = old if ol is None else ol + old
    yc = _hgrn2_readout(oc, gc, norm_g, dtype) if need_ctx else None
    return yc, _hgrn2_readout(ol, gl, norm_g, dtype)


def _token_mixer(hc, hl, need_ctx, w_in, a_re, a_im, log_dt, b_re, b_im, c_re, c_im, d_skip,
                 w_glu, lb, norm_g, w_up_s5, w_up_hgrn, w_out):
    zc = _split_in(hc @ w_in)
    zl = _split_in(hl @ w_in)
    y5c, y5l = _s5_branch(zc[0], zl[0], a_re, a_im, log_dt, b_re, b_im, c_re, c_im,
                          d_skip, w_glu, need_ctx)
    yhc, yhl = _hgrn2_branch(zc[1], zc[2], zc[3], zc[4], zc[5],
                             zl[1], zl[2], zl[3], zl[4], zl[5], lb, norm_g, need_ctx)

    def merge(z, y5, yh):
        return (jax.nn.sigmoid(z[6]) * (y5 @ w_up_s5)
                + jax.nn.sigmoid(z[7]) * (yh @ w_up_hgrn)) @ w_out

    yc = merge(zc, y5c, yhc) if need_ctx else None
    return yc, merge(zl, y5l, yhl)


def _moe_ffn(h, router_w, router_b, w1, b1, w2, b2):
    n, d = h.shape
    logits = (h @ router_w + router_b).astype(jnp.float32)
    top_val, top_idx = lax.top_k(logits, TOP_K)
    gate = jax.nn.softmax(top_val, axis=-1).astype(h.dtype)
    nk = n * TOP_K
    flat_e = top_idx.reshape(nk).astype(jnp.int32)
    flat_tok = jnp.repeat(jnp.arange(n, dtype=jnp.int32), TOP_K)
    order = jnp.argsort(flat_e)
    sorted_e = flat_e[order]
    counts = jnp.bincount(flat_e, length=N_EXPERTS)
    padded = (counts + MOE_BLOCK - 1) // MOE_BLOCK * MOE_BLOCK
    pad_end = jnp.cumsum(padded)
    pad_start = pad_end - padded
    grp_start = jnp.cumsum(counts) - counts
    dest = pad_start[sorted_e] + jnp.arange(nk, dtype=jnp.int32) - grp_start[sorted_e]
    n_rows = -(-nk // MOE_BLOCK) * MOE_BLOCK + N_EXPERTS * MOE_BLOCK
    n_blocks = n_rows // MOE_BLOCK
    row_tok = jnp.full((n_rows,), n, jnp.int32).at[dest].set(flat_tok[order])
    row_gate = jnp.zeros((n_rows,), h.dtype).at[dest].set(gate.reshape(nk)[order])
    block_e = jnp.minimum(
        jnp.searchsorted(pad_end, jnp.arange(n_blocks, dtype=jnp.int32) * MOE_BLOCK, side='right'),
        N_EXPERTS - 1)
    xs = jnp.concatenate([h, jnp.zeros((1, d), h.dtype)], axis=0)[row_tok]
    xs = xs.reshape(n_blocks, MOE_BLOCK, d)

    def expert_block(args):
        xb, e = args
        gu = xb @ w1[e] + b1[e]
        g, u = jnp.split(gu, 2, axis=-1)
        g = jnp.minimum(g, SWIGLU_LIMIT)
        u = jnp.clip(u, -SWIGLU_LIMIT, SWIGLU_LIMIT)
        return (g * jax.nn.sigmoid(SWIGLU_ALPHA * g) * (u + 1.0)) @ w2[e] + b2[e]

    ys = lax.map(expert_block, (xs, block_e)).reshape(n_rows, d)
    return jax.ops.segment_sum(ys * row_gate[:, None], row_tok, num_segments=n + 1)[:n]


def setup_inputs(seed: int = 0) -> dict:
    key = jax.random.key(seed)
    ks = jax.random.split(key, 32)

    def nrm(k, shape, s):
        return s * jax.random.normal(k, shape, jnp.float32)

    G, P, H = S5_GROUPS, S5_STATE, S5_GROUP
    n_idx = jnp.arange(P, dtype=jnp.float32)
    return {
        'x': nrm(ks[0], (BATCH, SEQ, D_MODEL), 1.0),
        'c': nrm(ks[1], (BATCH, D_MODEL), 1.0),
        'ctx': nrm(ks[2], (BATCH, CTX_LEN, D_MODEL), 1.0),
        'c_ctx': nrm(ks[3], (D_MODEL,), 1.0),
        'mod_w': nrm(ks[4], (DEPTH, D_MODEL, N_MOD * D_MODEL), 0.2 * D_MODEL ** -0.5),
        'mod_b': nrm(ks[5], (DEPTH, N_MOD * D_MODEL), 0.02),
        'norm1_g': 1.0 + nrm(ks[6], (DEPTH, D_MODEL), 0.02),
        'norm2_g': 1.0 + nrm(ks[7], (DEPTH, D_MODEL), 0.02),
        'w_in': nrm(ks[8], (DEPTH, D_MODEL, N_IN), D_MODEL ** -0.5),
        's5_a_re': -0.5 + nrm(ks[9], (DEPTH, 2, G, P), 0.02),
        's5_a_im': math.pi * n_idx + nrm(ks[10], (DEPTH, 2, G, P), 0.02),
        's5_log_dt': jax.random.uniform(ks[11], (DEPTH, 2, G), jnp.float32,
                                        math.log(1e-3), math.log(1e-1)),
        's5_b_re': nrm(ks[12], (DEPTH, 2, G, P, H), (2 * H) ** -0.5),
        's5_b_im': nrm(ks[13], (DEPTH, 2, G, P, H), (2 * H) ** -0.5),
        's5_c_re': nrm(ks[14], (DEPTH, 2, G, H, P), (2 * P) ** -0.5),
        's5_c_im': nrm(ks[15], (DEPTH, 2, G, H, P), (2 * P) ** -0.5),
        's5_d': nrm(ks[16], (DEPTH, D_S5), 1.0),
        's5_w_glu': nrm(ks[17], (DEPTH, D_S5, D_S5), D_S5 ** -0.5),
        'hgrn_lb_logits': nrm(ks[18], (2, DEPTH + 1, D_HGRN), 0.1),
        'hgrn_norm_g': 1.0 + nrm(ks[19], (DEPTH, HGRN_DV), 0.02),
        'w_up_s5': nrm(ks[20], (DEPTH, D_S5, D_MODEL), D_S5 ** -0.5),
        'w_up_hgrn': nrm(ks[21], (DEPTH, D_HGRN, D_MODEL), D_HGRN ** -0.5),
        'w_out': nrm(ks[22], (DEPTH, D_MODEL, D_MODEL), D_MODEL ** -0.5),
        'router_w': nrm(ks[23], (DEPTH, D_MODEL, N_EXPERTS), D_MODEL ** -0.5),
        'router_b': nrm(ks[24], (DEPTH, N_EXPERTS), 0.01),
        'moe_w1': nrm(ks[25], (DEPTH, N_EXPERTS, D_MODEL, 2 * D_FF), D_MODEL ** -0.5),
        'moe_b1': nrm(ks[26], (DEPTH, N_EXPERTS, 2 * D_FF), 0.01),
        'moe_w2': nrm(ks[27], (DEPTH, N_EXPERTS, D_FF, D_MODEL), D_FF ** -0.5),
        'moe_b2': nrm(ks[28], (DEPTH, N_EXPERTS, D_MODEL), 0.01),
        'final_g': 1.0 + nrm(ks[29], (D_MODEL,), 0.02),
    }


def reference(x, c, ctx, c_ctx, mod_w, mod_b, norm1_g, norm2_g, w_in,
              s5_a_re, s5_a_im, s5_log_dt, s5_b_re, s5_b_im, s5_c_re, s5_c_im, s5_d, s5_w_glu,
              hgrn_lb_logits, hgrn_norm_g, w_up_s5, w_up_hgrn, w_out,
              router_w, router_b, moe_w1, moe_b1, moe_w2, moe_b2, final_g):
    b, n_lat, d = x.shape
    n_ctx = ctx.shape[1]
    rows = n_lat // GRID_W
    p = jax.nn.softmax(hgrn_lb_logits.astype(jnp.float32), axis=1)
    lb_all = jnp.cumsum(p, axis=1)[:, :DEPTH]
    sc = jax.nn.silu(c)
    scc = jax.nn.silu(c_ctx)
    xc = ctx
    for l in range(DEPTH):
        need_ctx = l < DEPTH - 1
        ml = jnp.split((sc @ mod_w[l] + mod_b[l])[:, None, :], N_MOD, axis=-1)
        mc = jnp.split(scc @ mod_w[l] + mod_b[l], N_MOD, axis=-1)
        hl = _rms_norm(x, norm1_g[l]) * (1.0 + ml[1]) + ml[0]
        hc = _rms_norm(xc, norm1_g[l]) * (1.0 + mc[1]) + mc[0]
        if l % 2 == 1:
            hl = _to_colmajor(hl, rows)
        yc, yl = _token_mixer(hc, hl, need_ctx, w_in[l], s5_a_re[l], s5_a_im[l], s5_log_dt[l],
                              s5_b_re[l], s5_b_im[l], s5_c_re[l], s5_c_im[l], s5_d[l],
                              s5_w_glu[l], lb_all[:, l], hgrn_norm_g[l],
                              w_up_s5[l], w_up_hgrn[l], w_out[l])
        if l % 2 == 1:
            yl = _from_colmajor(yl, rows)
        x = x + ml[2] * yl
        hl = _rms_norm(x, norm2_g[l]) * (1.0 + ml[4]) + ml[3]
        if need_ctx:
            xc = xc + mc[2] * yc
            hc = _rms_norm(xc, norm2_g[l]) * (1.0 + mc[4]) + mc[3]
            tokens = jnp.concatenate([hc.reshape(-1, d), hl.reshape(-1, d)], axis=0)
            y = _moe_ffn(tokens, router_w[l], router_b[l], moe_w1[l], moe_b1[l],
                         moe_w2[l], moe_b2[l])
            xc = xc + mc[5] * y[: b * n_ctx].reshape(b, n_ctx, d)
            x = x + ml[5] * y[b * n_ctx:].reshape(b, n_lat, d)
        else:
            y = _moe_ffn(hl.reshape(-1, d), router_w[l], router_b[l], moe_w1[l], moe_b1[l],
                         moe_w2[l], moe_b2[l])
            x = x + ml[5] * y.reshape(b, n_lat, d)
    return _rms_norm(x, final_g)
```

```cpp
#include <hip/hip_runtime.h>
#include <cstdio>
#include <cstdint>

typedef unsigned short bf16_t;
typedef short bf16x8 __attribute__((ext_vector_type(8)));
typedef float f32x4 __attribute__((ext_vector_type(4)));
typedef unsigned u32x2 __attribute__((ext_vector_type(2)));
typedef unsigned u32x4 __attribute__((ext_vector_type(4)));
typedef int i32x8 __attribute__((ext_vector_type(8)));
typedef int i32x4v __attribute__((ext_vector_type(4)));
#define MOE1_FP8 1
#define MOE2_FP8 1
constexpr float FP8_WSCALE = MOE1_FP8 ? 32.0f : 1.0f, FP8_ASCALE = MOE1_FP8 ? 4.0f : 1.0f;
#define LAS __attribute__((address_space(3)))

constexpr int DM = 1024, NB = 2, SEQ = 16384, DEPTH = 4, CTXL = 256;
constexpr int NLAT = NB * SEQ, NCTX = NB * CTXL, NTOK = NLAT + NCTX;
constexpr int CH = 64, NCHUNK = NTOK / CH;
constexpr int S5G = 32, S5H = 16, S5P = 64;
constexpr int HH = 4;
constexpr int NIN = 5120, ZC = NIN - 512;
constexpr int ZQ = 0, ZI = 512, ZFF = 1024, ZFB = 1536, ZG = 2048, Z6 = 2560, Z7 = 3584;
constexpr int NE = 32, TOPK = 4;
constexpr int NMOD = 6 * DM;
constexpr int UAROWS = 768, UALD = 1280;
constexpr int MAXROWS = NTOK * TOPK + NE * 256;
constexpr int NTHREADS = 512;
constexpr int LDS_BYTES = 147456;
constexpr float EPS = 1e-6f;

constexpr size_t al256(size_t x) { return (x + 255) & ~(size_t)255; }
constexpr size_t WS_CTL = 0;                 constexpr size_t CTL_BYTES = 1u << 20;
constexpr size_t WS_MOD = WS_CTL + CTL_BYTES;            constexpr size_t SZ_MOD = (size_t)DEPTH * 3 * NMOD * 4;
constexpr size_t WS_LB = al256(WS_MOD + SZ_MOD);         constexpr size_t SZ_LB = (size_t)2 * DEPTH * 512 * 4;
constexpr size_t WS_LAMT = al256(WS_LB + SZ_LB);         constexpr size_t SZ_LAMT = (size_t)DEPTH * 2 * S5G * S5P * 2 * 4;
constexpr size_t WS_KT = al256(WS_LAMT + SZ_LAMT);       constexpr size_t SZ_KT = (size_t)DEPTH * S5G * 2 * 64 * 256 * 4;
constexpr size_t WS_S5T = al256(WS_KT + SZ_KT);          constexpr size_t SZ_S5T = (size_t)DEPTH * S5G * (2 * 64 * 65 + 2 * 64 * 16 + 2 * 16 * 64) * 8;
constexpr size_t WS_BT1 = al256(WS_S5T + SZ_S5T);          constexpr size_t SZ_BT1 = (size_t)DEPTH * S5G * 256 * 1024 * 2;
constexpr size_t WS_BT2 = al256(WS_BT1 + SZ_BT1);        constexpr size_t SZ_BT2 = (size_t)DEPTH * S5G * 1024 * UALD * 2;
constexpr size_t WS_XF = al256(WS_BT2 + SZ_BT2);         constexpr size_t SZ_XF = (size_t)NTOK * DM * 4;
constexpr size_t WS_HA = al256(WS_XF + SZ_XF);           constexpr size_t SZ_HA = (size_t)NTOK * DM * 2;
constexpr size_t WS_UA = al256(WS_HA + SZ_HA);           constexpr size_t SZ_UA = (size_t)S5G * UAROWS * UALD * 2;
constexpr size_t WS_Z = al256(WS_UA + SZ_UA);            constexpr size_t SZ_Z = (size_t)NTOK * ZC * 2;
constexpr size_t WS_Z5 = al256(WS_Z + SZ_Z);             constexpr size_t SZ_Z5 = (size_t)NTOK * 512 * 2;
constexpr size_t WS_YCAT = al256(WS_Z5 + SZ_Z5);         constexpr size_t SZ_YCAT = (size_t)NTOK * DM * 2;
constexpr size_t WS_MBUF = al256(WS_YCAT + SZ_YCAT);     constexpr size_t SZ_MBUF = (size_t)NTOK * DM * 2;
constexpr size_t WS_S5E = al256(WS_MBUF + SZ_MBUF);      constexpr size_t SZ_S5E = (size_t)S5G * UAROWS * 256 * 4;
constexpr size_t WS_HKV = al256(WS_S5E + SZ_S5E);        constexpr size_t SZ_HKV = (size_t)NCHUNK * HH * 2 * 128 * 128 * 4;
constexpr size_t WS_HS = al256(WS_HKV + SZ_HKV);         constexpr size_t SZ_HS = SZ_HKV;
constexpr size_t WS_HTOT = al256(WS_HS + SZ_HS);         constexpr size_t SZ_HTOT = (size_t)NCHUNK * HH * 2 * 128 * 4;
constexpr size_t WS_TOPE = al256(WS_HTOT + SZ_HTOT);     constexpr size_t SZ_TOP = (size_t)NTOK * TOPK * 4;
constexpr size_t WS_TOPG = al256(WS_TOPE + SZ_TOP);
constexpr size_t WS_TOPR = al256(WS_TOPG + SZ_TOP);
constexpr size_t WS_POS = al256(WS_TOPR + SZ_TOP);
constexpr size_t WS_ROWTOK = al256(WS_POS + SZ_TOP);     constexpr size_t SZ_ROWS = (size_t)NE * NTOK * 4;
constexpr size_t WS_ROWGATE = al256(WS_ROWTOK + SZ_ROWS);
constexpr size_t WS_ACT = al256(WS_ROWGATE + SZ_ROWS);   constexpr size_t SZ_ACT = (size_t)MAXROWS * DM * 2;
constexpr size_t WS_OUT2 = al256(WS_ACT + SZ_ACT);
constexpr size_t WS_WIN = al256(WS_OUT2 + SZ_ACT);       constexpr size_t SZ_WIN = (size_t)DEPTH * NIN * DM * 2;
constexpr size_t WS_WGLU = al256(WS_WIN + SZ_WIN);       constexpr size_t SZ_WGLU = (size_t)DEPTH * 512 * 512 * 2;
constexpr size_t WS_WUP5 = al256(WS_WGLU + SZ_WGLU);     constexpr size_t SZ_WUP = (size_t)DEPTH * 1024 * 512 * 2;
constexpr size_t WS_WUPH = al256(WS_WUP5 + SZ_WUP);
constexpr size_t WS_WOUT = al256(WS_WUPH + SZ_WUP);      constexpr size_t SZ_WOUT = (size_t)DEPTH * 1024 * 1024 * 2;
constexpr size_t WS_W1 = al256(WS_WOUT + SZ_WOUT);       constexpr size_t SZ_W1 = (size_t)DEPTH * NE * 2048 * 1024 * 2;
constexpr size_t WS_W2 = al256(WS_W1 + SZ_W1);           constexpr size_t SZ_W2 = (size_t)DEPTH * NE * 1024 * 1024 * 2;
constexpr size_t WS_HA8 = al256(WS_W2 + SZ_W2);         constexpr size_t SZ_HA8 = (size_t)NTOK * DM;
constexpr size_t WS_ZG8 = al256(WS_HA8 + SZ_HA8);       constexpr size_t SZ_ZG8 = (size_t)NTOK * 2048;
constexpr size_t WS_END = al256(WS_ZG8 + SZ_ZG8);

constexpr int CW_BAR = 0;
constexpr int CW_WQ = 3584;
constexpr int CW_CNT = 4096;
constexpr int CW_WQ2 = 8192;
constexpr size_t WS_PTRS = WS_CTL + 65536;

enum { I_X = 0, I_C, I_CTX, I_CCTX, I_MODW, I_MODB, I_N1G, I_N2G, I_WIN, I_ARE, I_AIM, I_LOGDT, I_BRE, I_BIM, I_CRE, I_CIM, I_S5D, I_WGLU,
       I_LBL, I_HNG, I_WUP5, I_WUPH, I_WOUT, I_RW, I_RB, I_W1, I_B1, I_W2, I_B2, I_FG, N_INPUTS };

struct Params { const float* in[N_INPUTS]; float* out; unsigned char* ws; int ph_lo, ph_hi; };

typedef __bf16 bf16v2 __attribute__((ext_vector_type(2)));
typedef float f32v2 __attribute__((ext_vector_type(2)));
__device__ __forceinline__ unsigned pack2(float a, float b) { const f32v2 v = {a, b}; const bf16v2 r = __builtin_convertvector(v, bf16v2); return __builtin_bit_cast(unsigned, r); }
__device__ __forceinline__ bf16_t f2bf(float f) { return __builtin_bit_cast(unsigned short, (__bf16)f); }
__device__ __forceinline__ float sat_fp8(float x) { return __builtin_amdgcn_fmed3f(x, -448.0f, 448.0f); }
__device__ __forceinline__ unsigned pack4_fp8(float a, float b, float c, float d) { unsigned w = 0u; w = __builtin_amdgcn_cvt_pk_fp8_f32(sat_fp8(a), sat_fp8(b), w, false); w = __builtin_amdgcn_cvt_pk_fp8_f32(sat_fp8(c), sat_fp8(d), w, true); return w; }
__device__ __forceinline__ float bf2f(bf16_t b) { return __uint_as_float(((unsigned)b) << 16); }
__device__ __forceinline__ float bflo(unsigned w) { return __uint_as_float(w << 16); }
__device__ __forceinline__ float bfhi(unsigned w) { return __uint_as_float(w & 0xffff0000u); }
__device__ __forceinline__ f32x4 up4_fp8(unsigned w) { typedef float f32x2v __attribute__((ext_vector_type(2))); const f32x2v lo = __builtin_amdgcn_cvt_pk_f32_fp8(w, false), hi = __builtin_amdgcn_cvt_pk_f32_fp8(w, true); return (f32x4){lo.x, lo.y, hi.x, hi.y}; }
#ifndef ZG8_FP8
#define ZG8_FP8 1
#endif
constexpr float ZG8_SCALE = 16.0f;
__device__ __forceinline__ float sigmoidf_(float x) { return __builtin_amdgcn_rcpf(1.0f + __builtin_amdgcn_exp2f(-1.4426950408889634f * x)); }
__device__ __forceinline__ float ex2(float x) { return __builtin_amdgcn_exp2f(x); }
__device__ __forceinline__ float lg2(float x) { return __builtin_amdgcn_logf(x); }
__device__ __forceinline__ float sigf(float x) { return __builtin_amdgcn_rcpf(1.0f + ex2(-1.4426950408889634f * x)); }
__device__ __forceinline__ float gelu_tanh(float x) { const float y = 0.7978845608028654f * (x + 0.044715f * x * x * x); return x * __builtin_amdgcn_rcpf(1.0f + __builtin_amdgcn_exp2f(-2.8853900817779268f * y)); }
__device__ __forceinline__ float wave_sum(float v) {
#pragma unroll
    for (int o = 32; o >= 1; o >>= 1) v += __shfl_xor(v, o);
    return v;
}
__device__ __forceinline__ int sigma_row(int r, int odd) {
    if (r >= NLAT || !odd) return r;
    const int b = r >> 14, n = r & 16383; return (b << 14) + ((n & 63) << 8) + (n >> 6);
}
__device__ __forceinline__ int sigma_inv(int s, int odd) {
    if (s >= NLAT || !odd) return s;
    const int b = s >> 14, q = s & 16383; return (b << 14) + ((q & 255) << 6) + (q >> 8);
}

__device__ __forceinline__ int ltid() { int t = threadIdx.x; asm volatile("" : "+v"(t)); return t; }
__device__ __forceinline__ int lbid() { int t = blockIdx.x; asm volatile("" : "+s"(t)); return t; }
#define XB_TMO      128
#define XB_XCNT(j)  (256  + 64 * (j))
#define XB_XSUB(j)  (1280 + 64 * (j))
#define XB_XGEN(j)  (2304 + 64 * (j))
#define XB_TOP      3328
#define XB_TOPGEN   3392
#define XCD_BAR_WORDS 3456
#define XB_SPIN_CAP (1u << 22)
__device__ __forceinline__ unsigned xb_ld(unsigned* p)              { return __hip_atomic_load(p, __ATOMIC_RELAXED, __HIP_MEMORY_SCOPE_AGENT); }
__device__ __forceinline__ unsigned xb_add(unsigned* p, unsigned v) { return __hip_atomic_fetch_add(p, v, __ATOMIC_RELAXED, __HIP_MEMORY_SCOPE_AGENT); }
__device__ __forceinline__ unsigned xb_xcc_id() { return (unsigned)__builtin_amdgcn_s_getreg((3 << 11) | 20) & 0xFu; }
#define XB_SPIN(cond, bar) do { unsigned _sp = 0; while (cond) { __builtin_amdgcn_s_sleep(1); \
    if ((++_sp & 255u) == 0u) { if (xb_ld(&(bar)[XB_TMO])) break; if (_sp > XB_SPIN_CAP) { atomicAdd(&(bar)[XB_TMO], 1u); break; } } } } while (0)
struct XcdBarrier { unsigned* bar; unsigned x; volatile LAS unsigned* st; };
__device__ __forceinline__ XcdBarrier xcd_barrier_post(unsigned* bar, volatile LAS unsigned* st) {
    XcdBarrier b; b.bar = bar; b.x = xb_xcc_id(); b.st = st;
    if (threadIdx.x == 0) (void)xb_add(&bar[XB_XCNT(b.x)], 1u);
    return b;
}
__device__ __forceinline__ void xcd_barrier_complete(unsigned* bar, unsigned x, unsigned& nloc, unsigned& nx) {
    const unsigned G = gridDim.x * gridDim.y * gridDim.z;
    unsigned sum, cnt, mine, sp = 0u;
    for (;;) {
        sum = 0u; cnt = 0u; mine = 0u;
#pragma unroll
        for (unsigned j = 0; j < 16; ++j) { const unsigned c = xb_ld(&bar[XB_XCNT(j)]); sum += c; cnt += (c > 0u) ? 1u : 0u; mine = (j == x) ? c : mine; }
        if (sum == G) break;
        __builtin_amdgcn_s_sleep(1);
        if ((++sp & 255u) == 0u) { if (xb_ld(&bar[XB_TMO])) break; if (sp > XB_SPIN_CAP) { atomicAdd(&bar[XB_TMO], 1u); break; } }
    }
    nloc = mine > 0u ? mine : 1u; nx = cnt > 0u ? cnt : 1u;
}
__device__ __forceinline__ void xcd_barrier(const XcdBarrier& b) {
    asm volatile("s_waitcnt vmcnt(0)" ::: "memory");
    __syncthreads();
    if (threadIdx.x == 0) {
        unsigned* bar = b.bar;
        __builtin_amdgcn_s_waitcnt(0);
        unsigned nloc = b.st[0], nx = b.st[1];
        if (nloc == 0u) { xcd_barrier_complete(bar, b.x, nloc, nx); b.st[0] = nloc; b.st[1] = nx; }
        const unsigned old = xb_add(&bar[XB_XSUB(b.x)], 1u);
        const unsigned gen = old / nloc;
        if (old + 1u == (gen + 1u) * nloc) {
            __builtin_amdgcn_fence(__ATOMIC_RELEASE, "agent");
            asm volatile("s_waitcnt vmcnt(0)" ::: "memory");
            const unsigned og = xb_add(&bar[XB_TOP], 1u);
            const unsigned tg = og / nx;
            if (og + 1u == (tg + 1u) * nx) xb_add(&bar[XB_TOPGEN], 1u);
            else XB_SPIN(xb_ld(&bar[XB_TOPGEN]) == tg, bar);
            __builtin_amdgcn_fence(__ATOMIC_ACQUIRE, "agent");
            xb_add(&bar[XB_XGEN(b.x)], 1u);
            asm volatile("s_waitcnt vmcnt(0)" ::: "memory");
        } else {
            XB_SPIN(xb_ld(&bar[XB_XGEN(b.x)]) == gen, bar);
            __builtin_amdgcn_fence(__ATOMIC_ACQUIRE, "agent");
            asm volatile("s_waitcnt vmcnt(0)" ::: "memory");
        }
    }
    __syncthreads();
}

constexpr int G_ABUF = 32768, G_BBUF = 16384, G_BUF = G_ABUF + G_BBUF;
template <class Epi>
__device__ __forceinline__ void gemm256x128(unsigned char* lds_g, const bf16_t* A, long lda, const int* rowidx, const bf16_t* Bt, long ldb, int K, const Epi& epi) {
    LAS unsigned char* lds = (LAS unsigned char*)lds_g;
    const int tid = ltid(), lane = tid & 63, wid = tid >> 6, wr = wid >> 1, wc = wid & 1, fr = lane & 15, fq = lane >> 4;
    const int r0 = tid >> 3, cg = (tid & 7) ^ (r0 & 7);
    const int wvu = __builtin_amdgcn_readfirstlane(wid);
    const bf16_t* pa[4]; const bf16_t* pb[2];
#pragma unroll
    for (int i = 0; i < 4; ++i) { const int r = r0 + 64 * i; const long rr = rowidx ? (long)rowidx[r] : (long)r; pa[i] = A + rr * lda + cg * 8; }
#pragma unroll
    for (int i = 0; i < 2; ++i) { const int r = r0 + 64 * i; pb[i] = Bt + (long)r * ldb + cg * 8; }
    f32x4 acc[4][4];
#pragma unroll
    for (int m = 0; m < 4; ++m)
#pragma unroll
        for (int n = 0; n < 4; ++n) acc[m][n] = (f32x4){0.f, 0.f, 0.f, 0.f};
    const int nk = K >> 6;
#define G_STAGE(kt, buf) do { \
        _Pragma("unroll") for (int _i = 0; _i < 4; ++_i) __builtin_amdgcn_global_load_lds((const unsigned*)(pa[_i] + (size_t)(kt) * 64), (LAS unsigned*)(lds + (buf) * G_BUF + wvu * 1024 + _i * 8192), 16, 0, 0); \
        _Pragma("unroll") for (int _i = 0; _i < 2; ++_i) __builtin_amdgcn_global_load_lds((const unsigned*)(pb[_i] + (size_t)(kt) * 64), (LAS unsigned*)(lds + (buf) * G_BUF + G_ABUF + wvu * 1024 + _i * 8192), 16, 0, 0); } while (0)
    G_STAGE(0, 0);
    const int arow = wr * 64 + fr, brow = wc * 64 + fr, sw = fr & 7;
    for (int kt = 0; kt < nk; ++kt) {
        const int cur = kt & 1;
        if (kt + 1 < nk) { G_STAGE(kt + 1, cur ^ 1); asm volatile("s_waitcnt vmcnt(6)" ::: "memory"); }
        else asm volatile("s_waitcnt vmcnt(0)" ::: "memory");
        __builtin_amdgcn_s_barrier();
        asm volatile("" ::: "memory");
        const LAS unsigned char* ab = lds + cur * G_BUF; const LAS unsigned char* bb = ab + G_ABUF;
#pragma unroll
        for (int ks = 0; ks < 2; ++ks) {
            bf16x8 af[4], bfr[4];
            const int co = (((ks * 4 + fq) ^ sw) << 4);
#pragma unroll
            for (int m = 0; m < 4; ++m) af[m] = *(const LAS bf16x8*)(ab + (arow + m * 16) * 128 + co);
#pragma unroll
            for (int n = 0; n < 4; ++n) bfr[n] = *(const LAS bf16x8*)(bb + (brow + n * 16) * 128 + co);
#pragma unroll
            for (int m = 0; m < 4; ++m)
#pragma unroll
                for (int n = 0; n < 4; ++n) acc[m][n] = __builtin_amdgcn_mfma_f32_16x16x32_bf16(bfr[n], af[m], acc[m][n], 0, 0, 0);
        }
        asm volatile("s_waitcnt lgkmcnt(0)" ::: "memory");
        __builtin_amdgcn_s_barrier();
        asm volatile("" ::: "memory");
    }
#undef G_STAGE
    epi(acc, wr, wc, fr, fq);
}
template <class E> struct EpiFrag {
    E e;
    __device__ __forceinline__ void operator()(const f32x4 (&acc)[4][4], int wr, int wc, int fr, int fq) const {
#pragma unroll
        for (int m = 0; m < 4; ++m)
#pragma unroll
            for (int n = 0; n < 4; ++n) e.store(wr * 64 + m * 16 + fr, wc * 64 + n * 16 + fq * 4, acc[m][n]);
    }
};
__device__ __forceinline__ void st_bf4(bf16_t* p, f32x4 v) { u32x2 w; w.x = pack2(v[0], v[1]); w.y = pack2(v[2], v[3]); *(u32x2*)p = w; }
__device__ __forceinline__ f32x4 ld_bf4(const bf16_t* p) { const u32x2 w = *(const u32x2*)p; return (f32x4){bflo(w.x), bfhi(w.x), bflo(w.y), bfhi(w.y)}; }

struct EInproj { bf16_t* UA; bf16_t* Z; int m0, n0;
    __device__ __forceinline__ void store(int rl, int cl, f32x4 v) const { const int s = m0 + rl, c = n0 + cl;
        if (c < 512) { const int g = c >> 4, hi = c & 15, rho = s >> 6, j = s & 63; st_bf4(UA + ((size_t)(g * UAROWS + rho) * UALD + j * 16 + hi), v); }
        else st_bf4(Z + (size_t)s * ZC + (c - 512), v); } };
struct ES5E { float* E; int g, m0, n0;
    __device__ __forceinline__ void store(int rl, int cl, f32x4 v) const { const int rho = m0 + rl; if (rho < NCHUNK) *(f32x4*)(E + ((size_t)(g * UAROWS + rho) * 256 + n0 + cl)) = v; } };
struct ES5Y { bf16_t* Z5; int g, m0, n0;
    __device__ __forceinline__ void store(int rl, int cl, f32x4 v) const { const int rho = m0 + rl; if (rho < NCHUNK) { const int col = n0 + cl, j = col >> 4, ho = col & 15;
        f32x4 o; o[0] = gelu_tanh(v[0]); o[1] = gelu_tanh(v[1]); o[2] = gelu_tanh(v[2]); o[3] = gelu_tanh(v[3]); st_bf4(Z5 + ((size_t)(rho * 64 + j) * 512 + g * 16 + ho), o); } } };
struct EGlu { const bf16_t* Z5; bf16_t* Y; int m0, n0;
    __device__ __forceinline__ void store(int rl, int cl, f32x4 v) const { const size_t r = m0 + rl; const int c = n0 + cl; const f32x4 z = ld_bf4(Z5 + r * 512 + c);
        f32x4 o; o[0] = z[0] * sigmoidf_(v[0]); o[1] = z[1] * sigmoidf_(v[1]); o[2] = z[2] * sigmoidf_(v[2]); o[3] = z[3] * sigmoidf_(v[3]); st_bf4(Y + r * DM + c, o); } };
struct EUp5 { const bf16_t* Z; bf16_t* Mb; int m0, n0;
    __device__ __forceinline__ void store(int rl, int cl, f32x4 v) const { const size_t r = m0 + rl; const int c = n0 + cl; const f32x4 z = ld_bf4(Z + r * ZC + Z6 + c);
        f32x4 o; o[0] = sigmoidf_(z[0]) * v[0]; o[1] = sigmoidf_(z[1]) * v[1]; o[2] = sigmoidf_(z[2]) * v[2]; o[3] = sigmoidf_(z[3]) * v[3]; st_bf4(Mb + r * DM + c, o); } };
struct EUph { const bf16_t* Z; bf16_t* Mb; int m0, n0;
    __device__ __forceinline__ void store(int rl, int cl, f32x4 v) const { const size_t r = m0 + rl; const int c = n0 + cl; const f32x4 z = ld_bf4(Z + r * ZC + Z7 + c); const f32x4 p = ld_bf4(Mb + r * DM + c);
        f32x4 o; o[0] = p[0] + sigmoidf_(z[0]) * v[0]; o[1] = p[1] + sigmoidf_(z[1]) * v[1]; o[2] = p[2] + sigmoidf_(z[2]) * v[2]; o[3] = p[3] + sigmoidf_(z[3]) * v[3]; st_bf4(Mb + r * DM + c, o); } };
struct EOut { float* XF; const float* modl; int odd, m0, n0;
    __device__ __forceinline__ void store(int rl, int cl, f32x4 v) const { const int s = m0 + rl, c = n0 + cl; const int r = sigma_inv(s, odd); const int mb = r < NLAT ? (r >> 14) : 2;
        const f32x4 g = *(const f32x4*)(modl + mb * NMOD + 2 * DM + c); float* xp = XF + (size_t)r * DM + c; f32x4 x = *(f32x4*)xp; x += g * v; *(f32x4*)xp = x; } };
struct EMoe2 { bf16_t* O; const float* b2; const float* rgate; int m0, n0;
    __device__ __forceinline__ void store(int rl, int cl, f32x4 v) const { const size_t r = m0 + rl; const int c = n0 + cl; const float g = rgate[r]; const f32x4 b = *(const f32x4*)(b2 + c);
        f32x4 o = (v + b) * g; st_bf4(O + r * DM + c, o); } };
struct EMoe1 { bf16_t* ACT; const float* b1; int m0, pn;
    __device__ __forceinline__ void operator()(const f32x4 (&acc)[4][4], int wr, int wc, int fr, int fq) const {
#pragma unroll
        for (int m = 0; m < 4; ++m)
#pragma unroll
            for (int n = 0; n < 2; ++n) { const size_t r = m0 + wr * 64 + m * 16 + fr; const int ch = pn * 64 + wc * 32 + n * 16 + fq * 4;
                const f32x4 bg = *(const f32x4*)(b1 + ch), bu = *(const f32x4*)(b1 + 1024 + ch); f32x4 o;
#pragma unroll
                for (int j = 0; j < 4; ++j) { float g = acc[m][n][j] + bg[j], u = acc[m][n + 2][j] + bu[j]; g = fminf(g, 7.0f); u = fminf(fmaxf(u, -7.0f), 7.0f); o[j] = g * sigmoidf_(1.702f * g) * (u + 1.0f); }
                st_bf4(ACT + r * DM + ch, o); }
    }
};


#define PROBE_EPI2 0
template <class E> struct epi_dup { static constexpr bool v = false; };
template <class E> struct epi_nst { static constexpr int v = 0; };
namespace g8 {
constexpr int BM = 256, BK = 64, HALF = 128, HTB = HALF * BK * 2, STAGE_BYTES = 8 * HTB;
__device__ __forceinline__ int lds_byte(int r, int c) { const int st = (r >> 4) * 2 + (c >> 5), rr = r & 15, cc = c & 31, ob = rr * 64 + cc * 2; return st * 1024 + (ob ^ (((ob >> 9) & 1) << 5)); }
__device__ __forceinline__ void stage_rc(int b, int& R, int& C) { const int st = b / 1024, sb = b % 1024, swz = sb ^ (((sb >> 9) & 1) << 5); R = (st >> 1) * 16 + swz / 64; C = (st & 1) * 32 + (swz % 64) / 2; }
__device__ __forceinline__ int perm32(int rho) { const int n = rho >> 4, i = rho & 15; return 8 * (i >> 2) + 4 * n + (i & 3); }
struct Unit { const char* a; const char* b; int pm, pn, aux; };
__device__ __forceinline__ i32x8 cat8(bf16x8 lo, bf16x8 hi) { typedef int i32x4 __attribute__((ext_vector_type(4))); const i32x4 a = __builtin_bit_cast(i32x4, lo), b = __builtin_bit_cast(i32x4, hi); return (i32x8){a[0], a[1], a[2], a[3], b[0], b[1], b[2], b[3]}; }
#ifndef G8_SP2
#define G8_SP2 1
#endif
#ifndef G8_ALIGN_EPI
#define G8_ALIGN_EPI 1
#endif
template <bool PERM, bool GATHER, bool FP8 = false, class Sched, class Epi>
__device__ __forceinline__ void gemm_phase(LAS unsigned char* lds, const int K, const unsigned lda_b, const unsigned ldb_b, const Sched& S, const Epi& E) {
    const int tid = ltid(), wid = __builtin_amdgcn_readfirstlane(tid >> 6), lane = tid & 63, wr = wid >> 2, wc = wid & 3, fr = lane & 15, fq = lane >> 4;
    const int nt = K / BK; constexpr int NST = epi_nst<Epi>::v;
    int Rr[2], Cc[2]; unsigned voffB[2], voffA[2][2], voffN[2][2];
#pragma unroll
    for (int i = 0; i < 2; ++i) { stage_rc(tid * 16 + i * 8192, Rr[i], Cc[i]); const int Rb = PERM ? ((Rr[i] & ~31) + perm32(Rr[i] & 31)) : Rr[i];
        voffB[i] = (unsigned)Rb * ldb_b + (unsigned)Cc[i] * 2u; }
    const size_t kstep = (size_t)(BK * 2);
    const size_t hstepB = (size_t)HALF * ldb_b;
    const unsigned ldsw = (unsigned)wid * 1024u;
    const int aoff = lds_byte(wr * 64 + fr, FP8 ? fq * 16 : fq * 8), boff = lds_byte(wc * 32 + fr, FP8 ? fq * 16 : fq * 8);
    constexpr int aoff1 = FP8 ? 16 : 1024, boff1 = aoff1;
#define G8_SA(b, h) (((b) * 2 + (h)) * HTB)
#define G8_SB(b, h) ((4 + (b) * 2 + (h)) * HTB)
#define G8_STAGE(bufoff, gbase, voff) do { _Pragma("unroll") for (int _i = 0; _i < 2; ++_i) \
        __builtin_amdgcn_global_load_lds((const unsigned*)((const char*)(gbase) + (voff)[_i]), (LAS unsigned*)(lds + (bufoff) + ldsw + _i * 8192), 16, 0, 0); } while (0)
#define G8_CAT(p0, p1) __builtin_shufflevector(p0, p1, 0, 1, 2, 3, 4, 5, 6, 7)
#define G8_LO(v) __builtin_bit_cast(bf16x8, __builtin_shufflevector(v, v, 0, 1, 2, 3))
#define G8_HI(v) __builtin_bit_cast(bf16x8, __builtin_shufflevector(v, v, 4, 5, 6, 7))
#define G8_LDA(dst, b, h) do { _Pragma("unroll") for (int m = 0; m < 4; ++m) { const i32x4v p0 = *(const LAS i32x4v*)(lds + G8_SA(b, h) + aoff + m * 2048), p1 = *(const LAS i32x4v*)(lds + G8_SA(b, h) + aoff + m * 2048 + aoff1); dst[m] = G8_CAT(p0, p1); } } while (0)
#define G8_LDB(dst, b, h) do { _Pragma("unroll") for (int n = 0; n < 2; ++n) { const i32x4v p0 = *(const LAS i32x4v*)(lds + G8_SB(b, h) + boff + n * 2048), p1 = *(const LAS i32x4v*)(lds + G8_SB(b, h) + boff + n * 2048 + boff1); dst[n] = G8_CAT(p0, p1); } } while (0)
#define G8_MMA(ai, bj, At, Bt) do { __builtin_amdgcn_s_setprio(1); _Pragma("unroll") for (int m = 0; m < 4; ++m) _Pragma("unroll") for (int n = 0; n < 2; ++n) { \
        if constexpr (FP8) asm volatile("v_mfma_scale_f32_16x16x128_f8f6f4 %0, %1, %2, %0, %3, %3 op_sel_hi:[0,0,0]" : "+v"(acc[ai][bj][m][n]) : "v"(Bt[n]), "v"(At[m]), "v"(one_scale)); \
        else { acc[ai][bj][m][n] = __builtin_amdgcn_mfma_f32_16x16x32_bf16(G8_LO(Bt[n]), G8_LO(At[m]), acc[ai][bj][m][n], 0, 0, 0); \
               acc[ai][bj][m][n] = __builtin_amdgcn_mfma_f32_16x16x32_bf16(G8_HI(Bt[n]), G8_HI(At[m]), acc[ai][bj][m][n], 0, 0, 0); } } \
        __builtin_amdgcn_s_setprio(0); } while (0)
#define G8_WAIT_V(n) asm volatile("s_waitcnt vmcnt(" #n ")" ::: "memory")
#define G8_WAIT_L(n) asm volatile("s_waitcnt lgkmcnt(" #n ")" ::: "memory")
#define G8_WAIT_VR() do { if (NST > 0 && t == 0 && ui > 0) asm volatile("s_waitcnt vmcnt(%0)" :: "i"(8 + NST) : "memory"); else G8_WAIT_V(8); } while (0)
#define G8_BAR __builtin_amdgcn_s_barrier()
#define G8_SCHED __builtin_amdgcn_sched_barrier(0)
#define G8_AOFFS(dst, u) do { _Pragma("unroll") for (int _h = 0; _h < 2; ++_h) _Pragma("unroll") for (int _i = 0; _i < 2; ++_i) { \
        const unsigned _row = GATHER ? min((unsigned)S.rows(u)[_h * HALF + Rr[_i]], (unsigned)(NTOK - 1)) : (unsigned)(_h * HALF + Rr[_i]); dst[_h][_i] = _row * lda_b + (unsigned)Cc[_i] * 2u; } } while (0)
    Unit cur, nxt; int ui = 0;
    if (!S.next(0, cur)) return;
    f32x4 acc[2][2][4][2];
#pragma unroll
    for (int a = 0; a < 2; ++a)
#pragma unroll
        for (int b = 0; b < 2; ++b)
#pragma unroll
            for (int m = 0; m < 4; ++m)
#pragma unroll
                for (int n = 0; n < 2; ++n) acc[a][b][m][n] = (f32x4){0.f, 0.f, 0.f, 0.f};
    i32x8 At[4], B0[2], B1[2];
    int one_scale = 0x7f7f7f7f; asm volatile("" : "+v"(one_scale));
    const char* cA = cur.a; const char* cB = cur.b;
    G8_AOFFS(voffA, cur);
    if (!GATHER) {
#pragma unroll
        for (int _h = 0; _h < 2; ++_h)
#pragma unroll
            for (int _i = 0; _i < 2; ++_i) voffN[_h][_i] = voffA[_h][_i]; }
    if (G8_SP2) {
        G8_STAGE(G8_SB(0, 0), cB, voffB); G8_STAGE(G8_SB(0, 1), cB + hstepB, voffB); G8_STAGE(G8_SA(0, 0), cA, voffA[0]); G8_STAGE(G8_SA(0, 1), cA, voffA[1]);
        if (wr == 1) G8_BAR;
        G8_WAIT_V(2); G8_BAR;
        G8_STAGE(G8_SB(1, 0), cB + kstep, voffB); G8_STAGE(G8_SA(1, 0), cA + kstep, voffA[0]); G8_STAGE(G8_SB(1, 1), cB + hstepB + kstep, voffB);
        G8_WAIT_V(6); G8_BAR;
    } else {
    G8_STAGE(G8_SB(0, 0), cB, voffB); G8_STAGE(G8_SA(0, 0), cA, voffA[0]); G8_STAGE(G8_SB(0, 1), cB + hstepB, voffB); G8_STAGE(G8_SA(0, 1), cA, voffA[1]);
    if (wr == 1) G8_BAR;
    G8_WAIT_V(4); G8_BAR;
    G8_STAGE(G8_SB(1, 0), cB + kstep, voffB); G8_STAGE(G8_SA(1, 0), cA + kstep, voffA[0]); G8_STAGE(G8_SB(1, 1), cB + hstepB + kstep, voffB);
    G8_WAIT_V(6); G8_BAR;
    }
    for (;;) {
        const bool has_next = S.next(ui + 1, nxt);
        const char* nA = has_next ? nxt.a : cA; const char* nB = has_next ? nxt.b : cB;
        if (GATHER) { if (has_next) { G8_AOFFS(voffN, nxt); } else {
#pragma unroll
            for (int _h = 0; _h < 2; ++_h)
#pragma unroll
                for (int _i = 0; _i < 2; ++_i) voffN[_h][_i] = voffA[_h][_i]; } }
#pragma nounroll
        for (int t = 0; t < nt; t += 2) {
            const bool last = (t == nt - 2);
            const char* a1 = cA + (size_t)(t + 1) * kstep;
            const char* a2 = last ? nA : cA + (size_t)(t + 2) * kstep; const char* b2 = last ? nB : cB + (size_t)(t + 2) * kstep;
            const char* a3 = a2 + kstep; const char* b3 = b2 + kstep;
            unsigned vA0[2], vA1[2];
#pragma unroll
            for (int _i = 0; _i < 2; ++_i) { vA0[_i] = (GATHER && last) ? voffN[0][_i] : voffA[0][_i]; vA1[_i] = (GATHER && last) ? voffN[1][_i] : voffA[1][_i]; }
            if (G8_SP2) {
            G8_LDB(B0, 0, 0); G8_LDB(B1, 0, 1); G8_SCHED; G8_LDA(At, 0, 0); G8_STAGE(G8_SA(1, 1), a1, voffA[1]);
            G8_WAIT_VR(); G8_WAIT_L(0); G8_BAR; G8_MMA(0, 0, At, B0); G8_MMA(0, 1, At, B1); G8_BAR; G8_SCHED;
            G8_LDA(At, 0, 1); G8_STAGE(G8_SB(0, 0), b2, voffB); G8_STAGE(G8_SB(0, 1), b2 + hstepB, voffB); G8_STAGE(G8_SA(0, 0), a2, vA0);
            G8_WAIT_VR(); G8_WAIT_L(0); G8_BAR; G8_MMA(1, 0, At, B0); G8_MMA(1, 1, At, B1); G8_BAR; G8_SCHED;
            G8_LDB(B0, 1, 0); G8_LDB(B1, 1, 1); G8_SCHED; G8_LDA(At, 1, 0); G8_STAGE(G8_SA(0, 1), a2, vA1);
            G8_WAIT_V(8); G8_WAIT_L(0); G8_BAR; G8_MMA(0, 0, At, B0); G8_MMA(0, 1, At, B1); G8_BAR; G8_SCHED;
            G8_LDA(At, 1, 1); G8_STAGE(G8_SB(1, 0), b3, voffB); G8_STAGE(G8_SB(1, 1), b3 + hstepB, voffB); G8_STAGE(G8_SA(1, 0), a3, vA0);
            G8_WAIT_V(8); G8_WAIT_L(0); G8_BAR; G8_MMA(1, 0, At, B0); G8_MMA(1, 1, At, B1); G8_BAR; G8_SCHED;
            } else {
            G8_LDB(B0, 0, 0); G8_SCHED; G8_LDA(At, 0, 0); G8_STAGE(G8_SA(1, 1), a1, voffA[1]);
            G8_WAIT_L(8); G8_BAR; G8_WAIT_L(0); G8_MMA(0, 0, At, B0); G8_BAR; G8_SCHED;
            G8_LDB(B1, 0, 1); G8_STAGE(G8_SB(0, 0), b2, voffB);
            G8_BAR; G8_WAIT_L(0); G8_MMA(0, 1, At, B1); G8_BAR;
            G8_LDA(At, 0, 1); G8_STAGE(G8_SA(0, 0), a2, vA0);
            G8_BAR; G8_WAIT_L(0); G8_MMA(1, 0, At, B0); G8_BAR; G8_SCHED;
            G8_STAGE(G8_SB(0, 1), b2 + hstepB, voffB);
            G8_WAIT_V(6); G8_BAR; G8_MMA(1, 1, At, B1); G8_BAR;
            G8_LDB(B0, 1, 0); G8_SCHED; G8_LDA(At, 1, 0); G8_STAGE(G8_SA(0, 1), a2, vA1);
            G8_WAIT_L(8); G8_BAR; G8_WAIT_L(0); G8_MMA(0, 0, At, B0); G8_BAR; G8_SCHED;
            G8_LDB(B1, 1, 1); G8_STAGE(G8_SB(1, 0), b3, voffB);
            G8_BAR; G8_WAIT_L(0); G8_MMA(0, 1, At, B1); G8_BAR;
            G8_LDA(At, 1, 1); G8_STAGE(G8_SA(1, 0), a3, vA0);
            G8_BAR; G8_WAIT_L(0); G8_MMA(1, 0, At, B0); G8_BAR; G8_SCHED;
            G8_STAGE(G8_SB(1, 1), b3 + hstepB, voffB);
            G8_WAIT_V(6); G8_BAR; G8_MMA(1, 1, At, B1); G8_BAR;
            }
        }
        if (G8_ALIGN_EPI) { if (wr == 0) G8_BAR; }
        asm volatile("" ::: "memory");
        E(acc, cur, wr, wc, fr, fq);
#if PROBE_EPI2
        if (epi_dup<Epi>::v) { asm volatile("" ::: "memory"); E(acc, cur, wr, wc, fr, fq); }
#endif
        if (!has_next) break;
#pragma unroll
        for (int a = 0; a < 2; ++a)
#pragma unroll
            for (int b = 0; b < 2; ++b)
#pragma unroll
                for (int m = 0; m < 4; ++m)
#pragma unroll
                    for (int n = 0; n < 2; ++n) acc[a][b][m][n] = (f32x4){0.f, 0.f, 0.f, 0.f};
        cur = nxt; cA = nA; cB = nB; ++ui;
        if (GATHER) {
#pragma unroll
            for (int _h = 0; _h < 2; ++_h)
#pragma unroll
                for (int _i = 0; _i < 2; ++_i) voffA[_h][_i] = voffN[_h][_i]; }
        if (G8_ALIGN_EPI) { if (wr == 1) G8_BAR; }
    }
    G8_WAIT_V(0);
    if (!G8_ALIGN_EPI) { if (wr == 0) G8_BAR; }
    G8_BAR;
#undef G8_SA
#undef G8_SB
#undef G8_STAGE
#undef G8_LDA
#undef G8_CAT
#undef G8_LO
#undef G8_HI
#undef G8_LDB
#undef G8_MMA
#undef G8_WAIT_V
#undef G8_WAIT_L
#undef G8_WAIT_VR
#undef G8_BAR
#undef G8_SCHED
#undef G8_AOFFS
}
template <class E> struct Epi8 { E e;
    __device__ __forceinline__ void operator()(const f32x4 (&acc)[2][2][4][2], const Unit& u, int wr, int wc, int fr, int fq) const {
#pragma unroll
        for (int ai = 0; ai < 2; ++ai)
#pragma unroll
            for (int m = 0; m < 4; ++m) {
#pragma unroll
                for (int bj = 0; bj < 2; ++bj) e.store8(u, ai * 128 + wr * 64 + m * 16 + fr, bj * 128 + wc * 32 + fq * 8, acc[ai][bj][m][0], acc[ai][bj][m][1]);
                asm volatile("" ::: "memory"); } } };
template <class E> struct Epi4 { E e;
    __device__ __forceinline__ void operator()(const f32x4 (&acc)[2][2][4][2], const Unit& u, int wr, int wc, int fr, int fq) const {
#pragma unroll
        for (int ai = 0; ai < 2; ++ai)
#pragma unroll
            for (int m = 0; m < 4; ++m) {
#pragma unroll
                for (int bj = 0; bj < 2; ++bj)
#pragma unroll
                    for (int n = 0; n < 2; ++n) e.store4(u, ai * 128 + wr * 64 + m * 16 + fr, bj * 128 + wc * 32 + n * 16 + fq * 4, acc[ai][bj][m][n]);
                asm volatile("" ::: "memory"); } } };
struct GridOrder { const char* A; const char* B; size_t tstepA, tstepB; int nM, nN, nwg, G, c;
    __device__ __forceinline__ bool next(int i, Unit& u) const {
        const long L = (long)i * G + c; if (L >= nwg) return false;
        int wgid = (int)L; { const int q = nwg / 8, r = nwg % 8, xcd = wgid % 8, off = wgid / 8; wgid = (xcd < r ? xcd * (q + 1) : r * (q + 1) + (xcd - r) * q) + off; }
        const int nig = 8 * nN, gid = wgid / nig, fm = gid * 8, gsz = (nM - fm) < 8 ? (nM - fm) : 8;
        u.pm = fm + ((wgid % nig) % gsz); u.pn = (wgid % nig) / gsz; u.a = A + (size_t)u.pm * tstepA; u.b = B + (size_t)u.pn * tstepB; u.aux = 0; return true; }
    __device__ __forceinline__ const int* rows(const Unit&) const { return nullptr; } };
}
__device__ __forceinline__ void st_bf8(bf16_t* p, f32x4 a, f32x4 b) { u32x4 w; w.x = pack2(a[0], a[1]); w.y = pack2(a[2], a[3]); w.z = pack2(b[0], b[1]); w.w = pack2(b[2], b[3]); *(u32x4*)p = w; }
__device__ __forceinline__ void ld_bf8(const bf16_t* p, f32x4& a, f32x4& b) { const u32x4 w = *(const u32x4*)p; a = (f32x4){bflo(w.x), bfhi(w.x), bflo(w.y), bfhi(w.y)}; b = (f32x4){bflo(w.z), bfhi(w.z), bflo(w.w), bfhi(w.w)}; }
__device__ __forceinline__ f32x4 sig4(f32x4 z) { return (f32x4){sigmoidf_(z[0]), sigmoidf_(z[1]), sigmoidf_(z[2]), sigmoidf_(z[3])}; }

struct F8Inproj { bf16_t* UA; bf16_t* Z; unsigned char* ZG8;
    __device__ __forceinline__ void operator()(const f32x4 (&acc)[2][2][4][2], const g8::Unit& u, int wr, int wc, int fr, int fq) const {
        const int s0 = u.pm * 256 + wr * 64 + fr, c0 = wc * 32 + fq * 8;
        if (u.pn < 2) {
#pragma unroll
            for (int ai = 0; ai < 2; ++ai)
#pragma unroll
                for (int m = 0; m < 4; ++m) { const int s = s0 + ai * 128 + m * 16, rho = s >> 6, j = s & 63;
#pragma unroll
                    for (int bj = 0; bj < 2; ++bj) { const int c = u.pn * 256 + bj * 128 + c0, g = c >> 4, hi = c & 15;
                        st_bf8(UA + ((size_t)(g * UAROWS + rho) * UALD + j * 16 + hi), acc[ai][bj][m][0], acc[ai][bj][m][1]); }
                    asm volatile("" ::: "memory"); } }
        else if (ZG8_FP8 && u.pn >= (512 + Z6) / 256) { unsigned char* zp = ZG8 + (size_t)s0 * 2048 + (u.pn * 256 + c0 - 512 - Z6);
#pragma unroll
            for (int ai = 0; ai < 2; ++ai)
#pragma unroll
                for (int m = 0; m < 4; ++m) { unsigned char* zr = zp + (size_t)(ai * 128 + m * 16) * 2048;
#pragma unroll
                    for (int bj = 0; bj < 2; ++bj) { const f32x4 v0 = acc[ai][bj][m][0] * ZG8_SCALE, v1 = acc[ai][bj][m][1] * ZG8_SCALE; u32x2 w8; w8.x = pack4_fp8(v0[0], v0[1], v0[2], v0[3]); w8.y = pack4_fp8(v1[0], v1[1], v1[2], v1[3]);
                        *(u32x2*)(zr + bj * 128) = w8; } } }
        else { bf16_t* zp = Z + (size_t)s0 * ZC + (u.pn * 256 + c0 - 512);
#pragma unroll
            for (int ai = 0; ai < 2; ++ai)
#pragma unroll
                for (int m = 0; m < 4; ++m) { bf16_t* zr = zp + (size_t)(ai * 128 + m * 16) * ZC;
                    st_bf8(zr, acc[ai][0][m][0], acc[ai][0][m][1]); st_bf8(zr + 128, acc[ai][1][m][0], acc[ai][1][m][1]); } }
    } };
struct F8S5E { float* E;
    __device__ __forceinline__ void store4(const g8::Unit& u, int rl, int cl, f32x4 v) const { const int rho = u.pm * 256 + rl; if (rho < NCHUNK) *(f32x4*)(E + ((size_t)(u.aux * UAROWS + rho) * 256 + cl)) = v; } };
struct F8S5Y { bf16_t* Z5;
    __device__ __forceinline__ void store8(const g8::Unit& u, int rl, int cl, f32x4 v0, f32x4 v1) const { const int rho = u.pm * 256 + rl; if (rho < NCHUNK) { const int col = u.pn * 256 + cl, j = col >> 4, ho = col & 15;
        f32x4 a, b;
#pragma unroll
        for (int k = 0; k < 4; ++k) { a[k] = gelu_tanh(v0[k]); b[k] = gelu_tanh(v1[k]); }
        st_bf8(Z5 + ((size_t)(rho * 64 + j) * 512 + u.aux * 16 + ho), a, b); } } };
struct F8Glu { const bf16_t* Z5; bf16_t* Y;
    __device__ __forceinline__ void store8(const g8::Unit& u, int rl, int cl, f32x4 v0, f32x4 v1) const { const size_t r = u.pm * 256 + rl; const int c = u.pn * 256 + cl; f32x4 z0, z1; ld_bf8(Z5 + r * 512 + c, z0, z1);
        st_bf8(Y + r * DM + c, z0 * sig4(v0), z1 * sig4(v1)); } };
struct F8Up5 { const bf16_t* Z; bf16_t* Mb; const unsigned char* ZG8;
    __device__ __forceinline__ void store8(const g8::Unit& u, int rl, int cl, f32x4 v0, f32x4 v1) const { const size_t r = u.pm * 256 + rl; const int c = u.pn * 256 + cl; f32x4 z0, z1;
        if (ZG8_FP8) { const u32x2 w = *(const u32x2*)(ZG8 + r * 2048 + c); z0 = up4_fp8(w.x) * (1.0f / ZG8_SCALE); z1 = up4_fp8(w.y) * (1.0f / ZG8_SCALE); } else ld_bf8(Z + r * ZC + Z6 + c, z0, z1);
        st_bf8(Mb + r * DM + c, sig4(z0) * v0, sig4(z1) * v1); } };
struct F8Uph { const bf16_t* Z; bf16_t* Mb; bf16_t* Mo; const unsigned char* ZG8;
    __device__ __forceinline__ void store8(const g8::Unit& u, int rl, int cl, f32x4 v0, f32x4 v1) const { const size_t r = u.pm * 256 + rl; const int c = u.pn * 256 + cl; f32x4 z0, z1, p0, p1;
        if (ZG8_FP8) { const u32x2 w = *(const u32x2*)(ZG8 + r * 2048 + (Z7 - Z6) + c); z0 = up4_fp8(w.x) * (1.0f / ZG8_SCALE); z1 = up4_fp8(w.y) * (1.0f / ZG8_SCALE); } else ld_bf8(Z + r * ZC + Z7 + c, z0, z1);
        ld_bf8(Mb + r * DM + c, p0, p1);
        st_bf8(Mo + r * DM + c, p0 + sig4(z0) * v0, p1 + sig4(z1) * v1); } };
struct F8Out { bf16_t* XF; const float* modl; int odd;
    __device__ __forceinline__ void operator()(const f32x4 (&acc)[2][2][4][2], const g8::Unit& u, int wr, int wc, int fr, int fq) const {
        const int s0 = u.pm * 256 + wr * 64 + fr, c0 = u.pn * 256 + wc * 32 + fq * 8;
        const int mb = u.pm < NLAT / 256 ? (u.pm >> 6) : 2;
        const float* gp = modl + mb * NMOD + 2 * DM + c0; f32x4 g[2][2];
#pragma unroll
        for (int bj = 0; bj < 2; ++bj) { g[bj][0] = *(const f32x4*)(gp + bj * 128); g[bj][1] = *(const f32x4*)(gp + bj * 128 + 4); }
#pragma unroll
        for (int ai = 0; ai < 2; ++ai)
#pragma unroll
            for (int m = 0; m < 4; ++m) { const int r = sigma_inv(s0 + ai * 128 + m * 16, odd); bf16_t* xp = XF + (size_t)r * DM + c0;
#pragma unroll
                for (int bj = 0; bj < 2; ++bj) { f32x4 x0, x1; ld_bf8(xp + bj * 128, x0, x1); x0 += g[bj][0] * acc[ai][bj][m][0]; x1 += g[bj][1] * acc[ai][bj][m][1];
                    st_bf8(xp + bj * 128, x0, x1); }
                if (m & 1) asm volatile("" ::: "memory"); }
    } };
constexpr float M2S = MOE2_FP8 ? 1.0f / (FP8_WSCALE * FP8_ASCALE) : 1.0f;
#ifndef OUT2_FP8
#define OUT2_FP8 1
#endif
constexpr float OUT2_SCALE = 32.0f;

struct F8Moe2 { bf16_t* O; const float* b2; const float* rgate; const int* ps;
    __device__ __forceinline__ void operator()(const f32x4 (&acc)[2][2][4][2], const g8::Unit& u, int wr, int wc, int fr, int fq) const {
        const size_t r0 = (size_t)u.pm * 256 + wr * 64 + fr; const int c0 = u.pn * 256 + wc * 32 + fq * 8;
        const float* bp = b2 + (size_t)u.aux * 1024 + c0; f32x4 b[2][2];
#pragma unroll
        for (int bj = 0; bj < 2; ++bj) { b[bj][0] = *(const f32x4*)(bp + bj * 128); b[bj][1] = *(const f32x4*)(bp + bj * 128 + 4); }
        float gt[2][4]; const float* gr = rgate + (size_t)u.aux * NTOK + (u.pm * 256 - ps[u.aux]) + wr * 64 + fr;
#pragma unroll
        for (int ai = 0; ai < 2; ++ai)
#pragma unroll
            for (int m = 0; m < 4; ++m) gt[ai][m] = gr[ai * 128 + m * 16];
#pragma unroll
        for (int ai = 0; ai < 2; ++ai)
#pragma unroll
            for (int m = 0; m < 4; ++m) { bf16_t* op = O + (r0 + ai * 128 + m * 16) * DM + c0; const float g = gt[ai][m] * (OUT2_FP8 ? OUT2_SCALE : 1.0f);
#pragma unroll
                for (int bj = 0; bj < 2; ++bj) { const f32x4 v0 = (acc[ai][bj][m][0] * M2S + b[bj][0]) * g, v1 = (acc[ai][bj][m][1] * M2S + b[bj][1]) * g;
                    if (OUT2_FP8) { u32x2 w8; w8.x = pack4_fp8(v0[0], v0[1], v0[2], v0[3]); w8.y = pack4_fp8(v1[0], v1[1], v1[2], v1[3]);
                        *(u32x2*)((unsigned char*)O + (r0 + ai * 128 + m * 16) * DM + c0 + bj * 128) = w8; }
                    else st_bf8(op + bj * 128, v0, v1); } }
    } };
struct F8Moe1 { bf16_t* ACT; const float* b1;
    __device__ __forceinline__ void operator()(const f32x4 (&acc)[2][2][4][2], const g8::Unit& u, int wr, int wc, int fr, int fq) const {
        typedef float f32x2 __attribute__((ext_vector_type(2)));
        constexpr float SC = 1.0f / (FP8_WSCALE * FP8_ASCALE), AS = MOE2_FP8 ? FP8_ASCALE : 1.0f;
        const int ch = u.pn * 128 + wc * 32 + fq * 8; const float* bp = b1 + (size_t)u.aux * 2048 + ch; f32x4 bg[2], bu[2];
#pragma unroll
        for (int n = 0; n < 2; ++n) { bg[n] = *(const f32x4*)(bp + n * 4); bu[n] = (*(const f32x4*)(bp + 1024 + n * 4) + 1.0f) * AS; }
        bf16_t* ap = ACT + ((size_t)u.pm * 256 + wr * 64 + fr) * DM + ch;
#pragma unroll
        for (int ai = 0; ai < 2; ++ai)
#pragma unroll
            for (int m = 0; m < 4; ++m) { f32x2 o[2][2];
#pragma unroll
                for (int n = 0; n < 2; ++n)
#pragma unroll
                    for (int q = 0; q < 2; ++q) { const f32x2 ag = {acc[ai][0][m][n][2 * q], acc[ai][0][m][n][2 * q + 1]}, au = {acc[ai][1][m][n][2 * q], acc[ai][1][m][n][2 * q + 1]};
                        const f32x2 bg2 = {bg[n][2 * q], bg[n][2 * q + 1]}, bu2 = {bu[n][2 * q], bu[n][2 * q + 1]};
                        f32x2 g = ag * SC + bg2, uu = au * (SC * AS) + bu2;
                        g.x = fminf(g.x, 7.0f); g.y = fminf(g.y, 7.0f); uu.x = __builtin_amdgcn_fmed3f(uu.x, -6.0f * AS, 8.0f * AS); uu.y = __builtin_amdgcn_fmed3f(uu.y, -6.0f * AS, 8.0f * AS);
                        const f32x2 t = g * (-1.702f * 1.4426950408889634f); f32x2 e = {__builtin_amdgcn_exp2f(t.x), __builtin_amdgcn_exp2f(t.y)}; e = e + 1.0f;
                        const f32x2 r = {__builtin_amdgcn_rcpf(e.x), __builtin_amdgcn_rcpf(e.y)};
                        o[n][q] = g * r * uu; }
                if (MOE2_FP8) { u32x2 w8; unsigned w = 0u;
                    w = __builtin_amdgcn_cvt_pk_fp8_f32(o[0][0].x, o[0][0].y, w, false); w = __builtin_amdgcn_cvt_pk_fp8_f32(o[0][1].x, o[0][1].y, w, true); w8.x = w; w = 0u;
                    w = __builtin_amdgcn_cvt_pk_fp8_f32(o[1][0].x, o[1][0].y, w, false); w = __builtin_amdgcn_cvt_pk_fp8_f32(o[1][1].x, o[1][1].y, w, true); w8.y = w;
                    *(u32x2*)((unsigned char*)ACT + ((size_t)u.pm * 256 + wr * 64 + fr + ai * 128 + m * 16) * DM + ch) = w8; }
                else st_bf8(ap + (size_t)(ai * 128 + m * 16) * DM, (f32x4){o[0][0].x, o[0][0].y, o[0][1].x, o[0][1].y}, (f32x4){o[1][0].x, o[1][0].y, o[1][1].x, o[1][1].y}); }
    } };
template <> struct epi_nst<F8Inproj> { static constexpr int v = 16; };
template <> struct epi_nst<g8::Epi8<F8Glu>> { static constexpr int v = 16; };
template <> struct epi_nst<g8::Epi8<F8Up5>> { static constexpr int v = 16; };
template <> struct epi_nst<g8::Epi8<F8Uph>> { static constexpr int v = 16; };
template <> struct epi_nst<F8Out> { static constexpr int v = 16; };
template <> struct epi_nst<F8Moe1> { static constexpr int v = 8; };
template <> struct epi_nst<F8Moe2> { static constexpr int v = 16; };
struct S5Order { const char* A; const char* B; size_t gstepA, gstepB; unsigned lda_b, ldb_b; int MT, NT, G, c;
    __device__ __forceinline__ bool next(int i, g8::Unit& u) const { int g, r;
        if ((G & 7) == 0) { const int x = c & 7, per = G >> 3, e = i * per + (per - 1 - (c >> 3)); if (e >= 4 * MT * NT) return false; g = x + 8 * (e / (MT * NT)); r = e % (MT * NT); }
        else { const int L = i * G + (G - 1 - c); if (L >= S5G * MT * NT) return false; g = L / (MT * NT); r = L % (MT * NT); }
        const int mt = r / NT, nt = r % NT;
        u.pm = mt; u.pn = nt; u.aux = g; u.a = A + (size_t)g * gstepA + (size_t)mt * 256 * lda_b; u.b = B + (size_t)g * gstepB + (size_t)nt * 256 * ldb_b; return true; }
    __device__ __forceinline__ const int* rows(const g8::Unit&) const { return nullptr; } };
struct MoeOrder { const char* A; const char* B; const int* rowtok; const int* te; unsigned estepB; int NT, ntile, G, c; bool gather; unsigned tstepB = 256 * DM * 2;
    __device__ __forceinline__ bool next(int i, g8::Unit& u) const { const int x = c & 7, slot = c >> 3; int t, pn;
        if (G != 256) { const int L = i * G + c; t = L / NT; pn = L % NT; } else if (NT == 4) { t = i * 64 + x * 8 + (slot >> 2); pn = slot & 3; } else { t = i * 32 + (x >> 1) * 8 + (slot >> 2); pn = (x & 1) * 4 + (slot & 3); }
        if (t >= ntile) return false; const int e = te[t];
        u.pm = t; u.pn = pn; u.aux = e; u.a = gather ? A : A + (size_t)t * tstepB; u.b = B + (size_t)e * estepB + (size_t)pn * tstepB; return true; }
    __device__ __forceinline__ const int* rows(const g8::Unit& u) const { return rowtok + (size_t)u.aux * NTOK + (u.pm * 256 - te[u.aux - 64]); } };

template <bool WIDE = false>
__device__ __forceinline__ void norm_mod_row(f32x4 (&x)[4], const float* g, const float* shift, const float* scale, int lane) {
    float ss = 0.f;
#pragma unroll
    for (int k = 0; k < 4; ++k) ss += x[k][0] * x[k][0] + x[k][1] * x[k][1] + x[k][2] * x[k][2] + x[k][3] * x[k][3];
    ss = wave_sum(ss);
    const float rstd = rsqrtf(ss * (1.0f / DM) + EPS);
#pragma unroll
    for (int k = 0; k < 4; ++k) { const int c = WIDE ? lane * 16 + k * 4 : lane * 4 + k * 256; const f32x4 gg = *(const f32x4*)(g + c), sh = *(const f32x4*)(shift + c), sc = *(const f32x4*)(scale + c);
        x[k] = x[k] * rstd * gg * (sc + 1.0f) + sh; }
}

typedef float2 c32;
constexpr int S5T_PW = 2 * 64 * 65, S5T_BB = 2 * 64 * 16, S5T_CC = 2 * 16 * 64, S5T_ALL = S5T_PW + S5T_BB + S5T_CC;
static __device__ __forceinline__ void s5_stage1(unsigned char* ws, const float* const* tab, unsigned char* lds_g, int l, int g) {
    c32* pw = (c32*)lds_g;
    c32* bb = pw + S5T_PW;
    c32* cc = bb + S5T_BB;
    const int tid = ltid();
    const float* a_re = tab[I_ARE]; const float* a_im = tab[I_AIM]; const float* ldt = tab[I_LOGDT];
    for (int idx = tid; idx < S5T_PW; idx += NTHREADS) { const int n = idx % 65, p = (idx / 65) & 63, d = idx / (65 * 64);
        const int gi = (l * 2 + d) * S5G + g; const double are = a_re[gi * 64 + p], aim = a_im[gi * 64 + p], dt = exp((double)ldt[gi]);
        const double mag = exp(are * dt * n), ang = aim * dt * n; pw[idx] = make_float2((float)(mag * cos(ang)), (float)(mag * sin(ang))); }
    for (int idx = tid; idx < S5T_BB; idx += NTHREADS) { const int hi = idx & 15, p = (idx >> 4) & 63, d = idx >> 10;
        const int gi = (l * 2 + d) * S5G + g; const double are = a_re[gi * 64 + p], aim = a_im[gi * 64 + p], dt = exp((double)ldt[gi]);
        const double mag = exp(are * dt), lbr = mag * cos(aim * dt), lbi = mag * sin(aim * dt), den = are * are + aim * aim, nr = lbr - 1.0;
        const double qr = (nr * are + lbi * aim) / den, qi = (lbi * are - nr * aim) / den;
        const double br = tab[I_BRE][(size_t)(gi * 64 + p) * 16 + hi], bi = tab[I_BIM][(size_t)(gi * 64 + p) * 16 + hi];
        bb[idx] = make_float2((float)(qr * br - qi * bi), (float)(qr * bi + qi * br)); }
    for (int idx = tid; idx < S5T_CC; idx += NTHREADS) { const int p = idx & 63, ho = (idx >> 6) & 15, d = idx >> 10;
        const int gi = (l * 2 + d) * S5G + g; cc[idx] = make_float2(tab[I_CRE][(size_t)(gi * 16 + ho) * 64 + p], tab[I_CIM][(size_t)(gi * 16 + ho) * 64 + p]); }
    __syncthreads();
    c32* gsc = (c32*)(ws + WS_S5T) + (size_t)(l * S5G + g) * S5T_ALL;
    for (int idx = tid; idx < S5T_ALL; idx += NTHREADS) gsc[idx] = pw[idx];
    if (tid < 128) { const int d = tid >> 6, p = tid & 63; ((c32*)(ws + WS_LAMT))[((l * 2 + d) * S5G + g) * 64 + p] = pw[(d * 64 + p) * 65 + 64]; }
    { const int hi = tid & 15, ho = (tid >> 4) & 15, d = tid >> 8; float gr[64], gim[64];
#pragma unroll
      for (int p = 0; p < 64; ++p) { const c32 c = cc[(d * 16 + ho) * 64 + p], b = bb[(d * 64 + p) * 16 + hi]; gr[p] = c.x * b.x - c.y * b.y; gim[p] = c.x * b.y + c.y * b.x; }
      float* KT = (float*)(ws + WS_KT) + (size_t)(l * S5G + g) * 2 * 64 * 256 + d * 64 * 256 + ho * 16 + hi;
      for (int dl = 0; dl < 64; ++dl) { float s = 0.f;
#pragma unroll
          for (int p = 0; p < 64; ++p) { const c32 w = pw[(d * 64 + p) * 65 + dl]; s += gr[p] * w.x - gim[p] * w.y; if ((p & 15) == 15) asm volatile("" ::: "memory"); }
          KT[dl * 256] = s; } }
    __syncthreads();
}
static __device__ __forceinline__ void s5_stage2(unsigned char* ws, const float* const* tab, unsigned char* lds_g, int l, int g, int rq) {
    c32* pw = (c32*)lds_g; c32* bb = pw + S5T_PW; c32* cc = bb + S5T_BB;
    const int tid = ltid();
    const c32* gsc = (const c32*)(ws + WS_S5T) + (size_t)(l * S5G + g) * S5T_ALL;
    for (int idx = tid; idx < S5T_ALL; idx += NTHREADS) pw[idx] = gsc[idx];
    __syncthreads();
    const float* KT = (const float*)(ws + WS_KT) + (size_t)(l * S5G + g) * 2 * 64 * 256;
    const float* dsk = tab[I_S5D] + l * 512 + g * 16;
    bf16_t* BT2 = (bf16_t*)(ws + WS_BT2) + (size_t)(l * S5G + g) * 1024 * UALD;
    for (int ck = tid; ck < 256 * 160; ck += NTHREADS) { const int row = rq * 256 + ck / 160, c8 = ck % 160, j = row >> 4, ho = row & 15; float v[8];
        if (c8 < 128) { const int i = c8 >> 1, hi0 = (c8 & 1) * 8;
#pragma unroll
            for (int q = 0; q < 8; ++q) v[q] = 0.f;
            if (j >= i) { const f32x4 a = *(const f32x4*)(KT + ((0 * 64 + (j - i)) * 16 + ho) * 16 + hi0), b = *(const f32x4*)(KT + ((0 * 64 + (j - i)) * 16 + ho) * 16 + hi0 + 4);
#pragma unroll
                for (int q = 0; q < 4; ++q) { v[q] += a[q]; v[4 + q] += b[q]; } }
            if (i >= j) { const f32x4 a = *(const f32x4*)(KT + ((1 * 64 + (i - j)) * 16 + ho) * 16 + hi0), b = *(const f32x4*)(KT + ((1 * 64 + (i - j)) * 16 + ho) * 16 + hi0 + 4);
#pragma unroll
                for (int q = 0; q < 4; ++q) { v[q] += a[q]; v[4 + q] += b[q]; } }
            if (i == j) {
#pragma unroll
                for (int q = 0; q < 8; ++q) if (hi0 + q == ho) v[q] += dsk[ho]; } }
        else { const int kap0 = (c8 - 128) * 8, d = kap0 >> 7, ri = (kap0 >> 6) & 1, p0 = kap0 & 63, n = d == 0 ? j + 1 : 64 - j;
#pragma unroll
            for (int q = 0; q < 8; ++q) { const int p = p0 + q; const c32 c = cc[(d * 16 + ho) * 64 + p], w = pw[(d * 64 + p) * 65 + n];
                const float re = c.x * w.x - c.y * w.y, im = c.x * w.y + c.y * w.x; v[q] = ri == 0 ? re : -im; } }
        u32x4 o; o.x = pack2(v[0], v[1]); o.y = pack2(v[2], v[3]); o.z = pack2(v[4], v[5]); o.w = pack2(v[6], v[7]);
        *(u32x4*)(BT2 + (size_t)row * UALD + c8 * 8) = o; }
    bf16_t* BT1 = (bf16_t*)(ws + WS_BT1) + (size_t)(l * S5G + g) * 256 * 1024;
    for (int ck = tid; ck < 64 * 128; ck += NTHREADS) { const int kap = rq * 64 + (ck >> 7), c8 = ck & 127, d = kap >> 7, ri = (kap >> 6) & 1, p = kap & 63, i = c8 >> 1, hi0 = (c8 & 1) * 8;
        const int n = d == 0 ? 63 - i : i; const c32 w = pw[(d * 64 + p) * 65 + n]; float v[8];
#pragma unroll
        for (int q = 0; q < 8; ++q) { const c32 b = bb[(d * 64 + p) * 16 + hi0 + q]; const float re = w.x * b.x - w.y * b.y, im = w.x * b.y + w.y * b.x; v[q] = ri == 0 ? re : im; }
        u32x4 o; o.x = pack2(v[0], v[1]); o.y = pack2(v[2], v[3]); o.z = pack2(v[4], v[5]); o.w = pack2(v[6], v[7]);
        *(u32x4*)(BT1 + (size_t)kap * 1024 + c8 * 8) = o; }
    __syncthreads();
}

constexpr int CVP = 66;
template <int MAPW1>
__device__ __forceinline__ void conv_run(unsigned char* lds_g, const float* src, int K, int N, bf16_t* dst, int R0, int k0, int nst) {
    const int tid = ltid(), lane = tid & 63, w = tid >> 6;
    const int n4 = (w & 3) * 16 + (lane & 15), kpl = (lane >> 4) + 4 * (w >> 2);
    const int Rl = 4 * n4; const int R = R0 + Rl;
    const int sc = MAPW1 ? ((Rl & 128) ? 1024 : 0) + (R0 >> 8) * 128 + (Rl & 127) : R;
    const float* sp = src + (size_t)(k0 + 2 * kpl) * N + sc;
    f32x4 A[8], B[8];
#define CV_LOAD(X, kt) do { _Pragma("unroll") for (int p = 0; p < 4; ++p) { const float* q = sp + (size_t)((kt) * 64 + 16 * p) * N; X[2 * p] = *(const f32x4*)q; X[2 * p + 1] = *(const f32x4*)(q + N); } } while (0)
#define CV_EMIT(X, kt, buf) do { unsigned* T = (unsigned*)(lds_g + (buf) * 256 * CVP * 2); \
        _Pragma("unroll") for (int p = 0; p < 4; ++p) _Pragma("unroll") for (int i = 0; i < 4; ++i) T[(Rl + i) * (CVP / 2) + kpl + 8 * p] = pack2(X[2 * p][i], X[2 * p + 1][i]); \
        __syncthreads(); \
        _Pragma("unroll") for (int j = 0; j < 4; ++j) { const int piece = tid + j * 512, n = piece >> 3, c = piece & 7; const unsigned* tp = T + n * (CVP / 2) + c * 4; \
            u32x4 o; o.x = tp[0]; o.y = tp[1]; o.z = tp[2]; o.w = tp[3]; *(u32x4*)(dst + (size_t)(R0 + n) * K + k0 + (kt) * 64 + c * 8) = o; } } while (0)
    CV_LOAD(A, 0);
    for (int kt = 0; kt < nst; kt += 2) {
        if (kt + 1 < nst) CV_LOAD(B, kt + 1);
        CV_EMIT(A, kt, 0);
        if (kt + 1 < nst) { if (kt + 2 < nst) CV_LOAD(A, kt + 2); CV_EMIT(B, kt + 1, 1); }
    }
    __syncthreads();
#undef CV_LOAD
#undef CV_EMIT
}

template <int MAPW1>
__device__ __forceinline__ void conv_run8(unsigned char* lds_g, const float* src, int K, int N, unsigned char* dst, int R0, int k0, int nst) {
    const int tid = ltid(), lane = tid & 63, w = tid >> 6;
    const int n4 = (w & 3) * 16 + (lane & 15), kql = (lane >> 4) + 4 * (w >> 2);
    const int Rl = 4 * n4;
    const int sc = MAPW1 ? ((Rl & 128) ? 1024 : 0) + (R0 >> 8) * 128 + (Rl & 127) : R0 + Rl;
    const float* sp = src + (size_t)(k0 + 4 * kql) * N + sc;
    f32x4 A[8], B[8];
#define CV8_LOAD(X, kt) do { _Pragma("unroll") for (int p = 0; p < 2; ++p) _Pragma("unroll") for (int q = 0; q < 4; ++q) X[4 * p + q] = *(const f32x4*)(sp + (size_t)((kt) * 64 + 32 * p + q) * N); } while (0)
#define CV8_EMIT(X, kt, buf) do { unsigned* T = (unsigned*)(lds_g + (buf) * 256 * 17 * 4); \
        _Pragma("unroll") for (int p = 0; p < 2; ++p) _Pragma("unroll") for (int i = 0; i < 4; ++i) \
            T[(Rl + i) * 17 + kql + 8 * p] = pack4_fp8(X[4 * p][i] * FP8_WSCALE, X[4 * p + 1][i] * FP8_WSCALE, X[4 * p + 2][i] * FP8_WSCALE, X[4 * p + 3][i] * FP8_WSCALE); \
        __syncthreads(); \
        _Pragma("unroll") for (int j = 0; j < 2; ++j) { const int piece = tid + j * 512, n = piece >> 2, c = piece & 3; const unsigned* tp = T + n * 17 + c * 4; \
            u32x4 o; o.x = tp[0]; o.y = tp[1]; o.z = tp[2]; o.w = tp[3]; *(u32x4*)(dst + (size_t)(R0 + n) * K + k0 + (kt) * 64 + c * 16) = o; } } while (0)
    CV8_LOAD(A, 0);
    for (int kt = 0; kt < nst; kt += 2) {
        if (kt + 1 < nst) CV8_LOAD(B, kt + 1);
        CV8_EMIT(A, kt, 0);
        if (kt + 1 < nst) { if (kt + 2 < nst) CV8_LOAD(A, kt + 2); CV8_EMIT(B, kt + 1, 1); }
    }
    __syncthreads();
#undef CV8_LOAD
#undef CV8_EMIT
}

constexpr int CVK = 4;
constexpr int PQ_S5 = DEPTH * S5G, PQ_MOD = DEPTH * 96;
constexpr int CVI_WIN = (NIN / 256) * (DM / 64 / CVK), CVI_GLU = 2 * (512 / 64 / CVK), CVI_UP = 4 * (512 / 64 / CVK), CVI_OUT = 4 * (1024 / 64 / CVK);
constexpr int CVI_LAYER = CVI_WIN + CVI_GLU + 2 * CVI_UP + CVI_OUT;
constexpr int CVI_W1 = 8 * (1024 / 64 / CVK), CVI_W2 = 4 * (1024 / 64 / CVK);
constexpr int PQ_CONV = CVI_LAYER + NE * (CVI_W1 + CVI_W2);
constexpr int PQ_XF = NTOK / 256, PQ_LB = 1;
constexpr int PQ_TOTAL = PQ_S5 + PQ_MOD + PQ_CONV + PQ_XF + PQ_LB;

constexpr int CVI_PER_LAYER = CVI_LAYER + NE * (CVI_W1 + CVI_W2);
static __device__ __forceinline__ void conv_item(unsigned char* ws, const float* const* tab, unsigned char* lds_g, int l, int w) {
    if (w < CVI_WIN) { conv_run<0>(lds_g, tab[I_WIN] + (size_t)l * DM * NIN, DM, NIN, (bf16_t*)(ws + WS_WIN) + (size_t)l * NIN * DM, (w >> 2) * 256, (w & 3) * 64 * CVK, CVK); return; }
    w -= CVI_WIN;
    if (w < CVI_GLU) { conv_run<0>(lds_g, tab[I_WGLU] + (size_t)l * 512 * 512, 512, 512, (bf16_t*)(ws + WS_WGLU) + (size_t)l * 512 * 512, (w >> 1) * 256, (w & 1) * 64 * CVK, CVK); return; }
    w -= CVI_GLU;
    if (w < CVI_UP) { conv_run<0>(lds_g, tab[I_WUP5] + (size_t)l * 512 * 1024, 512, 1024, (bf16_t*)(ws + WS_WUP5) + (size_t)l * 1024 * 512, (w >> 1) * 256, (w & 1) * 64 * CVK, CVK); return; }
    w -= CVI_UP;
    if (w < CVI_UP) { conv_run<0>(lds_g, tab[I_WUPH] + (size_t)l * 512 * 1024, 512, 1024, (bf16_t*)(ws + WS_WUPH) + (size_t)l * 1024 * 512, (w >> 1) * 256, (w & 1) * 64 * CVK, CVK); return; }
    w -= CVI_UP;
    if (w < CVI_OUT) { conv_run<0>(lds_g, tab[I_WOUT] + (size_t)l * 1024 * 1024, 1024, 1024, (bf16_t*)(ws + WS_WOUT) + (size_t)l * 1024 * 1024, (w >> 2) * 256, (w & 3) * 64 * CVK, CVK); return; }
    w -= CVI_OUT;
    const int le = l * NE + w / (CVI_W1 + CVI_W2); w = w % (CVI_W1 + CVI_W2);
    if (w < CVI_W1) { if (MOE1_FP8) conv_run8<1>(lds_g, tab[I_W1] + (size_t)le * 1024 * 2048, 1024, 2048, (unsigned char*)(ws + WS_W1) + (size_t)le * 2048 * 1024, (w >> 2) * 256, (w & 3) * 64 * CVK, CVK);
        else conv_run<1>(lds_g, tab[I_W1] + (size_t)le * 1024 * 2048, 1024, 2048, (bf16_t*)(ws + WS_W1) + (size_t)le * 2048 * 1024, (w >> 2) * 256, (w & 3) * 64 * CVK, CVK); }
    else { w -= CVI_W1; if (MOE2_FP8) conv_run8<0>(lds_g, tab[I_W2] + (size_t)le * 1024 * 1024, 1024, 1024, (unsigned char*)(ws + WS_W2) + (size_t)le * 1024 * 1024, (w >> 2) * 256, (w & 3) * 64 * CVK, CVK);
        else conv_run<0>(lds_g, tab[I_W2] + (size_t)le * 1024 * 1024, 1024, 1024, (bf16_t*)(ws + WS_W2) + (size_t)le * 1024 * 1024, (w >> 2) * 256, (w & 3) * 64 * CVK, CVK); }
}
static __device__ __forceinline__ void conv_steal(unsigned char* ws, const float* const* tab, unsigned char* lds_g, int L, int nmax) {
    int* wq = (int*)(lds_g + LDS_BYTES - 64);
    unsigned* ctr = (unsigned*)(ws + WS_CTL) + CW_WQ2 + (L * 8) * 64;
    int x = lbid() & 7, tries = 0;
    for (int n = 0; n < nmax && tries < 8; ) {
        __syncthreads();
        if (ltid() == 0) *wq = (int)atomicAdd(ctr + x * 64, 1u);
        __syncthreads();
        const int v = *wq * 8 + x;
        if (v >= CVI_PER_LAYER) { x = (x + 1) & 7; ++tries; if (nmax < 8) break; continue; }
        conv_item(ws, tab, lds_g, L, v); ++n;
    }
    __syncthreads();
}
static __device__ __forceinline__ void phase_prologue(unsigned char* ws, const float* const* tab, unsigned char* lds_g, int qslot) {
    const int tid = ltid(), lane = tid & 63, wid = tid >> 6;
    float* lsf = (float*)lds_g;
    int* wq = (int*)(lds_g + LDS_BYTES - 64);
    unsigned* ctr = (unsigned*)(ws + WS_CTL) + CW_WQ + 64 * (qslot ? 5 : 0);
    for (;;) {
        __syncthreads();
        if (tid == 0) *wq = (int)atomicAdd(ctr, 1u);
        __syncthreads();
        int v = *wq;
        if (v >= PQ_TOTAL) break;
        if (v < PQ_S5) { s5_stage1(ws, tab, lds_g, v / S5G, v % S5G); continue; }
        v -= PQ_S5;
        if (v < PQ_MOD) {
            const int l = v / 96, j = (v % 96) * 64 + (tid & 63), ks = tid >> 6;
            const float* mw = tab[I_MODW] + (size_t)l * DM * NMOD; float a0 = 0.f, a1 = 0.f, a2 = 0.f;
#pragma unroll 8
            for (int k = ks * 128; k < ks * 128 + 128; ++k) { const float w = mw[(size_t)k * NMOD + j]; const float c0 = tab[I_C][k], c1 = tab[I_C][DM + k], c2 = tab[I_CCTX][k];
                a0 += c0 * sigmoidf_(c0) * w; a1 += c1 * sigmoidf_(c1) * w; a2 += c2 * sigmoidf_(c2) * w; }
            lsf[(ks * 3 + 0) * 64 + (tid & 63)] = a0; lsf[(ks * 3 + 1) * 64 + (tid & 63)] = a1; lsf[(ks * 3 + 2) * 64 + (tid & 63)] = a2;
            __syncthreads();
            if (tid < 192) { const int r = tid >> 6, c = tid & 63; float s = 0.f;
#pragma unroll
                for (int k = 0; k < 8; ++k) s += lsf[(k * 3 + r) * 64 + c];
                const int jj = (v % 96) * 64 + c; ((float*)(ws + WS_MOD))[(size_t)(l * 3 + r) * NMOD + jj] = s + tab[I_MODB][l * NMOD + jj]; }
            continue; }
        v -= PQ_MOD;
        if (v < PQ_CONV) { conv_item(ws, tab, lds_g, 0, v); continue; }
        v -= PQ_CONV;
        if (v < PQ_XF) {
#pragma unroll 4
            for (int rr = 0; rr < 32; ++rr) { const int r = v * 256 + rr * 8 + wid; const float* sp = r < NLAT ? tab[I_X] + (size_t)r * DM : tab[I_CTX] + (size_t)(r - NLAT) * DM;
#pragma unroll
                for (int k = 0; k < 4; ++k) st_bf4((bf16_t*)(ws + WS_XF) + (size_t)r * DM + lane * 4 + k * 256, *(const f32x4*)(sp + lane * 4 + k * 256)); }
            continue; }
        {
#pragma unroll
            for (int hh = 0; hh < 2; ++hh) { const int idx = hh * 512 + tid, d = idx >> 9, ch = idx & 511; const float* lg = tab[I_LBL] + (size_t)d * (DEPTH + 1) * 512 + ch;
                float e[DEPTH + 1], mx = -1e30f, s = 0.f;
#pragma unroll
                for (int k = 0; k <= DEPTH; ++k) { e[k] = lg[k * 512]; mx = fmaxf(mx, e[k]); }
#pragma unroll
                for (int k = 0; k <= DEPTH; ++k) { e[k] = expf(e[k] - mx); s += e[k]; }
                float cum = 0.f;
#pragma unroll
                for (int k = 0; k < DEPTH; ++k) { cum += e[k] / s; ((float*)(ws + WS_LB))[(d * DEPTH + k) * 512 + ch] = cum; } } }
    }
}

static __device__ __forceinline__ void phase_norm1(unsigned char* ws, const float* const* tab, unsigned char* lds_g, int l) {
    if (l == 0) for (int u = lbid(); u < DEPTH * S5G * 4; u += gridDim.x) s5_stage2(ws, tab, lds_g, u / (S5G * 4), (u >> 2) & (S5G - 1), u & 3);
    const int tid = ltid(), lane = tid & 63, wid = tid >> 6; const int odd = l & 1;
    const float* MODl = (const float*)(ws + WS_MOD) + (size_t)l * 3 * NMOD;
    for (int u = lbid(); u < NTOK / 8; u += gridDim.x) { const int r = u * 8 + wid; const int mb = r < NLAT ? (r >> 14) : 2;
        f32x4 x[4];
#pragma unroll
        for (int k = 0; k < 4; ++k) x[k] = *(const f32x4*)((r < NLAT ? tab[I_X] + (size_t)r * DM : tab[I_CTX] + (size_t)(r - NLAT) * DM) + lane * 4 + k * 256);
        norm_mod_row(x, tab[I_N1G] + l * DM, MODl + mb * NMOD, MODl + mb * NMOD + DM, lane);
        bf16_t* hp = (bf16_t*)(ws + WS_HA) + (size_t)sigma_row(r, odd) * DM;
#pragma unroll
        for (int k = 0; k < 4; ++k) st_bf4(hp + lane * 4 + k * 256, x[k]); }
}

__device__ __forceinline__ int chunk_at(int b, int d, int s) {
    if (s < 4) return 512 + b * 4 + (d ? 3 - s : s);
    const int c = s - 4; return b * 256 + (d ? 255 - c : c);
}

constexpr int HP = 136, HPT = 72;
__device__ __forceinline__ bf16x8 lds_frag(const bf16_t* p) { return *(const bf16x8*)p; }
__device__ __forceinline__ void deal3(int c, int c1, int c2, int n0, int n1, int n2, int total, int& first, int& last) {
    int s = c < c1 ? c * n0 : (c < c2 ? c1 * n0 + (c - c1) * n1 : c1 * n0 + (c2 - c1) * n1 + (c - c2) * n2);
    int n = c < c1 ? n0 : (c < c2 ? n1 : n2);
    first = s; last = s + n; if (last > total) last = total; if (first > total) first = total;
}
__device__ __forceinline__ void hgrn_local_phase(unsigned char* ws, unsigned char* lds_g, int l) {
    bf16_t* KT = (bf16_t*)lds_g;
    bf16_t* VT = KT + 2 * 128 * HPT;
    float* qs = (float*)(VT + 128 * HPT);
    const int tid = ltid(), lane = tid & 63, wid = tid >> 6, dk = tid & 127, qt = tid >> 7, fr = lane & 15, fq = lane >> 4, G = gridDim.x;
    const int nunits = NCHUNK * HH;
    int u, uend; if (G == 256) deal3(lbid(), 128, 160, 9, 8, 7, nunits, u, uend); else { const int per = (nunits + G - 1) / G; u = lbid() * per; uend = u + per < nunits ? u + per : nunits; }
    if (u >= uend) return;
    const bf16_t* Zb = (const bf16_t*)(ws + WS_Z);
    unsigned short rf[2][16]; u32x4 vraw[2];
#define HL_LOADRAW(uu) do { const int rho_ = (uu) >> 2, h_ = (uu) & 3; const bf16_t* Zr = Zb + (size_t)rho_ * 64 * ZC + h_ * 128; \
        _Pragma("unroll") for (int jj = 0; jj < 16; ++jj) { const bf16_t* zj = Zr + (size_t)jj * ZC; rf[0][jj] = zj[loff + ZFF]; rf[1][jj] = zj[loff + ZFB]; } \
        _Pragma("unroll") for (int k = 0; k < 2; ++k) { const int idx = tid + k * 512, s = idx >> 4, dvg = idx & 15; vraw[k] = *(const u32x4*)(Zr + (size_t)s * ZC + ZI + dvg * 8); } } while (0)
    const int loff = qt * 16 * ZC + dk;
    HL_LOADRAW(u);
    for (; u < uend; ++u) {
        const int rho = u >> 2, h = u & 3;
        float lf[2][16], kk[2][16];
#pragma unroll
        for (int d = 0; d < 2; ++d) { const float lb = ((const float*)(ws + WS_LB))[(d * DEPTH + l) * 512 + h * 128 + dk]; float qsum = 1.f;
#pragma unroll
            for (int jj = 0; jj < 16; ++jj) { const float f = bf2f(rf[d][jj]); const float sg = sigf(f);
                lf[d][jj] = lb + (1.0f - lb) * sg; kk[d][jj] = (1.0f - lb) * (1.0f - sg); qsum *= lf[d][jj]; }
            qs[(d * 4 + qt) * 128 + dk] = qsum; }
#pragma unroll
        for (int k = 0; k < 2; ++k) { const int idx = tid + k * 512, s = idx >> 4, dvg = idx & 15; const unsigned ww[4] = {vraw[k].x, vraw[k].y, vraw[k].z, vraw[k].w};
#pragma unroll
            for (int i = 0; i < 4; ++i) { VT[(dvg * 8 + 2 * i) * HPT + s] = (bf16_t)(ww[i] & 0xffffu); VT[(dvg * 8 + 2 * i + 1) * HPT + s] = (bf16_t)(ww[i] >> 16); } }
        if (u + 1 < uend) HL_LOADRAW(u + 1);
        __syncthreads();
#pragma unroll
        for (int d = 0; d < 2; ++d) { float after = 1.f, tot = 0.f;
#pragma unroll
            for (int k = 0; k < 4; ++k) { const float s = qs[(d * 4 + k) * 128 + dk]; tot += lg2(s); if (d == 0 ? (k > qt) : (k < qt)) after *= s; }
            float kh[16];
            if (d == 0) { float run = after;
#pragma unroll
                for (int jj = 15; jj >= 0; --jj) { kh[jj] = kk[d][jj] * run; run *= lf[d][jj]; } }
            else { float run = after;
#pragma unroll
                for (int jj = 0; jj < 16; ++jj) { kh[jj] = kk[d][jj] * run; run *= lf[d][jj]; } }
            u32x4 o0, o1; o0.x = pack2(kh[0], kh[1]); o0.y = pack2(kh[2], kh[3]); o0.z = pack2(kh[4], kh[5]); o0.w = pack2(kh[6], kh[7]);
            o1.x = pack2(kh[8], kh[9]); o1.y = pack2(kh[10], kh[11]); o1.z = pack2(kh[12], kh[13]); o1.w = pack2(kh[14], kh[15]);
            bf16_t* kp = KT + (d * 128 + dk) * HPT + qt * 16; *(u32x4*)kp = o0; *(u32x4*)(kp + 8) = o1;
            if (qt == 0) ((float*)(ws + WS_HTOT))[((size_t)(rho * HH + h) * 2 + d) * 128 + dk] = tot; }
        __syncthreads();
#pragma unroll
        for (int d = 0; d < 2; ++d) { f32x4 acc[8];
#pragma unroll
            for (int n = 0; n < 8; ++n) acc[n] = (f32x4){0.f, 0.f, 0.f, 0.f};
#pragma unroll
            for (int ks = 0; ks < 2; ++ks) { const bf16x8 a = lds_frag(KT + (d * 128 + wid * 16 + fr) * HPT + ks * 32 + fq * 8);
#pragma unroll
                for (int n = 0; n < 8; ++n) { const bf16x8 b = lds_frag(VT + (n * 16 + fr) * HPT + ks * 32 + fq * 8); acc[n] = __builtin_amdgcn_mfma_f32_16x16x32_bf16(a, b, acc[n], 0, 0, 0); } }
            bf16_t* KV = (bf16_t*)(ws + WS_HKV) + ((size_t)(rho * HH + h) * 2 + d) * 16384;
#pragma unroll
            for (int n = 0; n < 8; ++n) st_bf4(KV + (n * 16 + fr) * 128 + wid * 16 + fq * 4, acc[n]); }
        __syncthreads();
    }
#undef HL_LOADRAW
}
__device__ __forceinline__ void hgrn_carry2(unsigned char* ws, int u) {
    const int eb = u & 15, d = (u >> 4) & 1, h = (u >> 5) & 3, b = u >> 7; const int e2 = eb * 512 + ltid(), dkp = e2 & 63;
    const unsigned* KV = (const unsigned*)(ws + WS_HKV); const float* TOT = (const float*)(ws + WS_HTOT); unsigned* HS = (unsigned*)(ws + WS_HS);
    float S0 = 0.f, S1 = 0.f;
    for (int s0 = 0; s0 < 260; s0 += 13) { unsigned kv[13]; float t0[13], t1[13]; unsigned si[13];
#pragma unroll
        for (int k = 0; k < 13; ++k) { si[k] = (unsigned)((chunk_at(b, d, s0 + k) * HH + h) * 2 + d); kv[k] = KV[(size_t)si[k] * 8192 + e2]; const float2 tt = *(const float2*)(TOT + (size_t)si[k] * 128 + 2 * dkp); t0[k] = tt.x; t1[k] = tt.y; }
#pragma unroll
        for (int k = 0; k < 13; ++k) { HS[(size_t)si[k] * 8192 + e2] = pack2(S0, S1); S0 = ex2(t0[k]) * S0 + bflo(kv[k]); S1 = ex2(t1[k]) * S1 + bfhi(kv[k]); } }
}
__device__ __forceinline__ void hgrn_out_phase(unsigned char* ws, const float* const* tab, unsigned char* lds_g, int l) {
    bf16_t* Qa = (bf16_t*)lds_g;
    bf16_t* Qi = Qa + 64 * HP;
    bf16_t* Kd = Qi + 32 * HP;
    bf16_t* Ko = Kd + 64 * HP;
    bf16_t* ST = Ko + 32 * HP;
    bf16_t* VT = ST + 128 * HP;
    bf16_t* Pm = VT + 128 * HPT;
    float* qs = (float*)(Pm + 64 * HPT);
    float* ssq = qs + 1024;
    const int tid = ltid(), lane = tid & 63, wid = tid >> 6, fr = lane & 15, fq = lane >> 4, G = gridDim.x;
    const int dp2 = 2 * lane, rg = __builtin_amdgcn_readfirstlane(wid);
    const int nunits = (l == DEPTH - 1 ? NLAT / CH : NCHUNK) * HH;
    int u, uend;
    if (G == 256 && l == DEPTH - 1) { u = lbid() * 8; uend = u + 8; }
    else if (G == 256) { const int c = lbid(); if (c < 128) deal3(c, 64, 128, 10, 9, 0, nunits, u, uend); else { deal3(c - 128, 96, 128, 7, 6, 0, nunits - 1216, u, uend); u += 1216; uend += 1216; } }
    else { const int per = (nunits + G - 1) / G; u = lbid() * per; uend = u + per < nunits ? u + per : nunits; }
    if (u >= uend) return;
    const bf16_t* Zb = (const bf16_t*)(ws + WS_Z);
    const int tt0 = wid >> 2, st = wid & 3;
    const int ot = wid & 3, oh = wid >> 2;
    unsigned rq[8], rf[2][8];
#define HO_LOADRAW(uu) do { const int rho_ = (uu) >> 2, h_ = (uu) & 3; const bf16_t* Zr = Zb + (size_t)rho_ * 64 * ZC + h_ * 128 + (size_t)(rg * 8) * ZC; \
        _Pragma("unroll") for (int jj = 0; jj < 8; ++jj) { const bf16_t* zj = Zr + (size_t)jj * ZC; rq[jj] = *(const unsigned*)(zj + ZQ + dp2); rf[0][jj] = *(const unsigned*)(zj + ZFF + dp2); rf[1][jj] = *(const unsigned*)(zj + ZFB + dp2); } } while (0)
    u32x4 vraw[2], sraw[4];
#define HO_LOADVS(uu) do { const int rho_ = (uu) >> 2, h_ = (uu) & 3; const bf16_t* Zv = Zb + (size_t)rho_ * 64 * ZC + ZI + h_ * 128; \
        _Pragma("unroll") for (int k = 0; k < 2; ++k) { const int idx = tid + k * 512, s_ = idx >> 4, dvg = idx & 15; vraw[k] = *(const u32x4*)(Zv + (size_t)s_ * ZC + dvg * 8); } \
        const u32x4* sp_ = (const u32x4*)((const bf16_t*)(ws + WS_HS) + ((size_t)(rho_ * HH + h_) * 2) * 16384); \
        _Pragma("unroll") for (int k = 0; k < 4; ++k) sraw[k] = sp_[tid + k * 512]; } while (0)
    HO_LOADRAW(u); HO_LOADVS(u);
    for (; u < uend; ++u) {
        const int rho = u >> 2, h = u & 3;
        const bf16_t* Z = Zb + (size_t)rho * 64 * ZC;
        u32x4 sbw[4]; u32x2 graw[4];
        const u32x4* sp0 = (const u32x4*)((const bf16_t*)(ws + WS_HS) + ((size_t)(rho * HH + h) * 2) * 16384);
        float qv0[8], qv1[8];
#pragma unroll
        for (int jj = 0; jj < 8; ++jj) { qv0[jj] = bflo(rq[jj]); qv1[jj] = bfhi(rq[jj]); }
        f32x4 O[4], Pk[2];
#pragma unroll
        for (int n = 0; n < 4; ++n) O[n] = (f32x4){0.f, 0.f, 0.f, 0.f};
        Pk[0] = Pk[1] = (f32x4){0.f, 0.f, 0.f, 0.f};
#pragma unroll
        for (int d = 0; d < 2; ++d) {
            const float2 lb2 = *(const float2*)((const float*)(ws + WS_LB) + (d * DEPTH + l) * 512 + h * 128 + dp2);
            float g0[8], g1[8], k0[8], k1[8], pr0 = 1.f, pr1 = 1.f;
#pragma unroll
            for (int jj = 0; jj < 8; ++jj) { const float s0 = sigf(bflo(rf[d][jj])), s1 = sigf(bfhi(rf[d][jj]));
                g0[jj] = lb2.x + (1.0f - lb2.x) * s0; k0[jj] = (1.0f - lb2.x) * (1.0f - s0); pr0 *= g0[jj];
                g1[jj] = lb2.y + (1.0f - lb2.y) * s1; k1[jj] = (1.0f - lb2.y) * (1.0f - s1); pr1 *= g1[jj]; }
            if (d == 1) __syncthreads();
            *(float2*)(qs + rg * 128 + dp2) = make_float2(pr0, pr1);
#pragma unroll
            for (int k = 0; k < 4; ++k) { const int idx = tid + k * 512, r = idx >> 4, c = idx & 15; *(u32x4*)(ST + r * HP + c * 8) = d == 0 ? sraw[k] : sbw[k]; }
            if (d == 0) {
#pragma unroll
                for (int k = 0; k < 4; ++k) sbw[k] = sp0[2048 + tid + k * 512];
#pragma unroll
                for (int n = 0; n < 4; ++n) graw[n] = *(const u32x2*)(Z + (size_t)(ot * 16 + fr) * ZC + ZG + h * 128 + (oh * 4 + n) * 16 + fq * 4); }
            if (d == 0) {
#pragma unroll
                for (int k = 0; k < 2; ++k) { const int idx = tid + k * 512, s = idx >> 4, dvg = idx & 15; const unsigned ww[4] = {vraw[k].x, vraw[k].y, vraw[k].z, vraw[k].w};
#pragma unroll
                    for (int i = 0; i < 4; ++i) { VT[(dvg * 8 + 2 * i) * HPT + s] = (bf16_t)(ww[i] & 0xffffu); VT[(dvg * 8 + 2 * i + 1) * HPT + s] = (bf16_t)(ww[i] >> 16); } } }
            __syncthreads();
            float b10 = 1.f, b11 = 1.f, R0 = 1.f, R1 = 1.f;
#pragma unroll
            for (int g = 0; g < 8; ++g) { const float2 gp = *(const float2*)(qs + g * 128 + dp2);
                const bool first = d == 0 ? (g < 4) : (g >= 4);
                const bool before = d == 0 ? (g >= (rg & ~3) && g < rg) : (g > rg && g <= (rg | 3));
                if (first) { b10 *= gp.x; b11 *= gp.y; }
                if (before) { R0 *= gp.x; R1 *= gp.y; } }
            const bool later = d == 0 ? (rg >= 4) : (rg < 4);
            float Ri0 = __builtin_amdgcn_rcpf(R0), Ri1 = __builtin_amdgcn_rcpf(R1);
#pragma unroll
            for (int jx = 0; jx < 8; ++jx) { const int jj = d == 0 ? jx : 7 - jx; const int j = rg * 8 + jj;
                R0 *= g0[jj]; R1 *= g1[jj]; Ri0 *= __builtin_amdgcn_rcpf(g0[jj]); Ri1 *= __builtin_amdgcn_rcpf(g1[jj]);
                const float qa0 = qv0[jj] * R0, qa1 = qv1[jj] * R1, kd0 = k0[jj] * Ri0, kd1 = k1[jj] * Ri1;
                *(unsigned*)(Qa + j * HP + dp2) = pack2(qa0, qa1); *(unsigned*)(Kd + j * HP + dp2) = pack2(kd0, kd1);
                if (later) *(unsigned*)(Qi + (j & 31) * HP + dp2) = pack2(qa0 * b10, qa1 * b11); else *(unsigned*)(Ko + (j & 31) * HP + dp2) = pack2(kd0 * b10, kd1 * b11); }
            if (d == 1) { asm volatile("" ::: "memory"); if (u + 1 < uend) { HO_LOADRAW(u + 1); HO_LOADVS(u + 1); } }
            __syncthreads();
#pragma unroll
            for (int pp = 0; pp < 2; ++pp) { const int tt = tt0 + 2 * pp; const bool need = d == 0 ? (st <= tt) : (st >= tt);
                if (need) { const bool same = (tt >> 1) == (st >> 1); const bf16_t* Kt = same ? Kd + (st * 16) * HP : Ko + ((st & 1) * 16) * HP; f32x4 D = (f32x4){0.f, 0.f, 0.f, 0.f};
#pragma unroll
                    for (int ks = 0; ks < 4; ++ks) D = __builtin_amdgcn_mfma_f32_16x16x32_bf16(lds_frag(Kt + fr * HP + ks * 32 + fq * 8), lds_frag(Qa + (tt * 16 + fr) * HP + ks * 32 + fq * 8), D, 0, 0, 0);
                    if (tt == st) {
#pragma unroll
                        for (int r = 0; r < 4; ++r) { const int sl = fq * 4 + r; const bool keep = d == 0 ? (sl <= fr) : (sl >= fr); if (!keep) D[r] = 0.f; } }
                    Pk[pp] += D; } }
            if (d == 1) {
#pragma unroll
                for (int pp = 0; pp < 2; ++pp) { const int tt = tt0 + 2 * pp; st_bf4(Pm + (tt * 16 + fr) * HPT + st * 16 + fq * 4, Pk[pp]); } }
            { const bool useQi = d == 0 ? (ot >= 2) : (ot < 2); const bf16_t* Qx = useQi ? Qi + ((ot & 1) * 16) * HP : Qa + (ot * 16) * HP;
#pragma unroll
              for (int ks = 0; ks < 4; ++ks) { const bf16x8 bq = lds_frag(Qx + fr * HP + ks * 32 + fq * 8);
#pragma unroll
                for (int n = 0; n < 4; ++n) O[n] = __builtin_amdgcn_mfma_f32_16x16x32_bf16(lds_frag(ST + ((oh * 4 + n) * 16 + fr) * HP + ks * 32 + fq * 8), bq, O[n], 0, 0, 0); } }
        }
        __syncthreads();
#pragma unroll
        for (int ks = 0; ks < 2; ++ks) { const bf16x8 bp = lds_frag(Pm + (ot * 16 + fr) * HPT + ks * 32 + fq * 8);
#pragma unroll
            for (int n = 0; n < 4; ++n) O[n] = __builtin_amdgcn_mfma_f32_16x16x32_bf16(lds_frag(VT + ((oh * 4 + n) * 16 + fr) * HPT + ks * 32 + fq * 8), bp, O[n], 0, 0, 0); }
        float ss = 0.f;
#pragma unroll
        for (int n = 0; n < 4; ++n) ss += O[n][0] * O[n][0] + O[n][1] * O[n][1] + O[n][2] * O[n][2] + O[n][3] * O[n][3];
        ss += __shfl_xor(ss, 16); ss += __shfl_xor(ss, 32);
        if (fq == 0) ssq[oh * 64 + ot * 16 + fr] = ss;
        __syncthreads();
        const int t = ot * 16 + fr; const float rstd = rsqrtf((ssq[t] + ssq[64 + t]) * (1.0f / 128.0f) + EPS);
        const float* ng = tab[I_HNG] + l * 128;
        bf16_t* Y = (bf16_t*)(ws + WS_YCAT) + (size_t)(rho * 64 + t) * DM + 512 + h * 128;
#pragma unroll
        for (int n = 0; n < 4; ++n) { const int dv = (oh * 4 + n) * 16 + fq * 4; const f32x4 g = (f32x4){bflo(graw[n].x), bfhi(graw[n].x), bflo(graw[n].y), bfhi(graw[n].y)}; const f32x4 w = *(const f32x4*)(ng + dv); f32x4 o;
#pragma unroll
            for (int r = 0; r < 4; ++r) o[r] = O[n][r] * rstd * w[r] * g[r] * sigmoidf_(g[r]);
            st_bf4(Y + dv, o); }
        __syncthreads();
    }
#undef HO_LOADRAW
#undef HO_LOADVS
}

__device__ __forceinline__ void s5_carry(unsigned char* ws, const float* const* tab, int l, int u) {
    const int idx = u * 512 + ltid(), p = idx & 63, d = (idx >> 6) & 1, g = (idx >> 7) & 31, b = idx >> 12;
    const float2 lam = ((const float2*)(ws + WS_LAMT))[((l * 2 + d) * S5G + g) * 64 + p];
    const float* E = (const float*)(ws + WS_S5E) + (size_t)g * UAROWS * 256 + d * 128 + p;
    bf16_t* X = (bf16_t*)(ws + WS_UA) + (size_t)g * UAROWS * UALD + 1024 + d * 128 + p;
    float xr = 0.f, xi = 0.f;
    for (int s0 = 0; s0 < 260; s0 += 4) { float er[4], ei[4]; int rho[4];
#pragma unroll
        for (int k = 0; k < 4; ++k) { rho[k] = chunk_at(b, d, s0 + k); er[k] = E[(size_t)rho[k] * 256]; ei[k] = E[(size_t)rho[k] * 256 + 64]; }
#pragma unroll
        for (int k = 0; k < 4; ++k) { X[(size_t)rho[k] * UALD] = f2bf(xr); X[(size_t)rho[k] * UALD + 64] = f2bf(xi);
            const float nr = lam.x * xr - lam.y * xi + er[k], ni = lam.x * xi + lam.y * xr + ei[k]; xr = nr; xi = ni; } }
}

static __device__ __forceinline__ void phase_norm2_route(unsigned char* ws, const float* const* tab, unsigned char* lds_g, int l, int probe = 0) {
    constexpr int HPF = 1028;
    float* hrow = (float*)lds_g;
    int* hist = (int*)(hrow + 32 * HPF);
    int* base = hist + 32;
    const int tid = ltid(), lane = tid & 63, wid = tid >> 6, e = lane & 31;
    const float* MODl = (const float*)(ws + WS_MOD) + (size_t)l * 3 * NMOD;
    const float* RW = tab[I_RW] + (size_t)l * DM * NE; const float* RB = tab[I_RB] + l * NE;
    unsigned* CNT = (unsigned*)(ws + WS_CTL) + CW_CNT + (l + (probe ? DEPTH : 0)) * NE;
    const size_t pofs = probe ? (WS_ACT - WS_TOPE) : 0;
    float bw0[32], bw1[32];
    { const int fr = lane & 15, fq = lane >> 4; const float* bp = RW + (size_t)(wid * 128 + fq) * NE + fr;
#pragma unroll
      for (int ks = 0; ks < 32; ++ks) { bw0[ks] = bp[(size_t)ks * 4 * NE]; bw1[ks] = bp[(size_t)ks * 4 * NE + 16]; } }
    int pe = 0, pl = 0, pr = -1; float pg = 0.f; unsigned bres = 0u;
#define ROUTE_FLUSH() do { if (lane < 16 && pr >= 0) { const size_t o = (size_t)pr * 4 + (lane & 3); const int rk = base[pe] + pl; \
            ((int*)(ws + pofs + WS_TOPE))[o] = pe; ((int*)(ws + pofs + WS_TOPR))[o] = rk; \
            if (!probe) { ((int*)(ws + WS_ROWTOK))[(size_t)pe * NTOK + rk] = pr; ((float*)(ws + WS_ROWGATE))[(size_t)pe * NTOK + rk] = pg; } } } while (0)
    for (int u = lbid(); u < ((l == DEPTH - 1) ? NLAT : NTOK) / 32; u += gridDim.x) {
        if (tid < 32) hist[tid] = 0;
#pragma unroll
        for (int i = 0; i < 4; ++i) { const int r = u * 32 + wid * 4 + i; const int mb = r < NLAT ? (r >> 14) : 2;
            f32x4 x[4];
#pragma unroll
            for (int k = 0; k < 4; ++k) x[k] = ld_bf4((const bf16_t*)(ws + WS_XF) + (size_t)r * DM + lane * 4 + k * 256);
            norm_mod_row(x, tab[I_N2G] + l * DM, MODl + mb * NMOD + 3 * DM, MODl + mb * NMOD + 4 * DM, lane);
            unsigned* hp = (unsigned*)(ws + WS_HA8 + (size_t)r * DM);
#pragma unroll
            for (int k = 0; k < 4; ++k) { if (MOE1_FP8) hp[lane + k * 64] = pack4_fp8(x[k][0] * FP8_ASCALE, x[k][1] * FP8_ASCALE, x[k][2] * FP8_ASCALE, x[k][3] * FP8_ASCALE); else st_bf4((bf16_t*)(ws + WS_HA) + (size_t)r * DM + lane * 4 + k * 256, x[k]); *(f32x4*)(hrow + (wid * 4 + i) * HPF + lane * 4 + k * 256) = x[k]; } }
        if (tid < 32) base[tid] = (int)bres;
        __syncthreads();
        ROUTE_FLUSH();
        { const int fr = lane & 15, fq = lane >> 4; f32x4 acc00 = (f32x4){0.f, 0.f, 0.f, 0.f}, acc01 = acc00, acc10 = acc00, acc11 = acc00;
          const float* ap = hrow + fr * HPF + wid * 128 + fq;
#pragma unroll
          for (int ks = 0; ks < 32; ++ks) { const float a0 = ap[ks * 4], a1 = ap[16 * HPF + ks * 4];
              acc00 = __builtin_amdgcn_mfma_f32_16x16x4f32(a0, bw0[ks], acc00, 0, 0, 0); acc01 = __builtin_amdgcn_mfma_f32_16x16x4f32(a0, bw1[ks], acc01, 0, 0, 0);
              acc10 = __builtin_amdgcn_mfma_f32_16x16x4f32(a1, bw0[ks], acc10, 0, 0, 0); acc11 = __builtin_amdgcn_mfma_f32_16x16x4f32(a1, bw1[ks], acc11, 0, 0, 0); }
          __syncthreads();
          float* part = hrow + (wid * 32 + fq * 4) * 32;
#pragma unroll
          for (int r = 0; r < 4; ++r) { part[r * 32 + fr] = acc00[r]; part[r * 32 + 16 + fr] = acc01[r]; part[(16 + r) * 32 + fr] = acc10[r]; part[(16 + r) * 32 + 16 + fr] = acc11[r]; } }
        __syncthreads();
        int myl = 0, mye = 0; float myg = 0.f;
#pragma unroll
        for (int i = 0; i < 4; ++i) { const int rl = wid * 4 + i; float v = ((hrow[(0 * 32 + rl) * 32 + e] + hrow[(1 * 32 + rl) * 32 + e]) + (hrow[(2 * 32 + rl) * 32 + e] + hrow[(3 * 32 + rl) * 32 + e])) + ((hrow[(4 * 32 + rl) * 32 + e] + hrow[(5 * 32 + rl) * 32 + e]) + (hrow[(6 * 32 + rl) * 32 + e] + hrow[(7 * 32 + rl) * 32 + e])) + RB[e]; float tv[4]; int te[4];
#pragma unroll
            for (int k = 0; k < 4; ++k) { float best = v; int bi = e;
#pragma unroll
                for (int o = 16; o >= 1; o >>= 1) { const float ov = __shfl_xor(best, o); const int oi = __shfl_xor(bi, o); if (ov > best || (ov == best && oi < bi)) { best = ov; bi = oi; } }
                tv[k] = best; te[k] = bi; if (e == bi) v = -3.0e38f; }
            float ex[4], s = 0.f;
#pragma unroll
            for (int k = 0; k < 4; ++k) { ex[k] = __expf(tv[k] - tv[0]); s += ex[k]; }
            const float inv = 1.0f / s;
#pragma unroll
            for (int k = 0; k < 4; ++k) if (lane == i * 4 + k) { mye = te[k]; myg = ex[k] * inv; } }
        if (lane < 16) myl = atomicAdd(&hist[mye], 1);
        __syncthreads();
        if (tid < 32) bres = atomicAdd(&CNT[tid], (unsigned)hist[tid]);
        pe = mye; pl = myl; pg = myg; pr = u * 32 + wid * 4 + (lane >> 2);
    }
    if (tid < 32) base[tid] = (int)bres;
    __syncthreads();
    ROUTE_FLUSH();
#undef ROUTE_FLUSH
    __syncthreads();
}
__device__ __forceinline__ void moe_segments(unsigned char* ws, int* ps, int l) {
    const int tid = ltid();
    if (tid < 64) { const unsigned* CNT = (const unsigned*)(ws + WS_CTL) + CW_CNT + l * NE; const int e = tid & 31;
        const int n = (int)((__hip_atomic_load(CNT + e, __ATOMIC_RELAXED, __HIP_MEMORY_SCOPE_AGENT) + 255u) >> 8);
        int inc = n;
#pragma unroll
        for (int o = 1; o < 32; o <<= 1) { const int v = __shfl_up(inc, o); if ((tid & 31) >= o) inc += v; }
        const int exc = inc - n;
        if (tid < 32) { ps[e] = exc << 8; if (e == NE - 1) ps[NE] = inc << 8; for (int k = 0; k < n; ++k) ps[64 + exc + k] = e; } }
    __syncthreads();
}
static __device__ __forceinline__ void phase_combine(unsigned char* ws, const float* const* tab, unsigned char* lds_g, int l, int probe = 0) {
    int* ps = (int*)lds_g; moe_segments(ws, ps, l);
    const int tid = ltid(), lane = tid & 63, wid = tid >> 6;
    const float* MODl = (const float*)(ws + WS_MOD) + (size_t)l * 3 * NMOD;
    const int* TE = (const int*)(ws + WS_TOPE); const int* TR = (const int*)(ws + WS_TOPR); const bf16_t* O2 = (const bf16_t*)(ws + WS_OUT2);
    const int nu = ((l == DEPTH - 1) ? NLAT : NTOK) / 8; const int G = gridDim.x;
    typedef int i32x4 __attribute__((ext_vector_type(4)));
    static_assert(OUT2_FP8, "the wide-lane combine reads fp8 expert rows");
    int u = lbid(); if (u >= nu) { __syncthreads(); return; }
#define CB_IDX(E, R, uu) do { E = *(const i32x4*)(TE + (size_t)((uu) * 8 + wid) * 4); R = *(const i32x4*)(TR + (size_t)((uu) * 8 + wid) * 4); } while (0)
#define CB_LOAD(S, r, E, R) \
        const int mb##S = (r) < NLAT ? ((r) >> 14) : 2; \
        const unsigned char* O8##S = (const unsigned char*)O2 + lane * 16; const bf16_t* xp##S = (const bf16_t*)(ws + WS_XF) + (size_t)(r) * DM + lane * 16; \
        const u32x4 w0##S = *(const u32x4*)(O8##S + (size_t)(ps[E[0]] + R[0]) * DM), w1##S = *(const u32x4*)(O8##S + (size_t)(ps[E[1]] + R[1]) * DM), \
                    w2##S = *(const u32x4*)(O8##S + (size_t)(ps[E[2]] + R[2]) * DM), w3##S = *(const u32x4*)(O8##S + (size_t)(ps[E[3]] + R[3]) * DM); \
        const u32x4 xl##S = *(const u32x4*)xp##S, xh##S = *(const u32x4*)(xp##S + 8);
#define CB_FINISH(S, r) do { f32x4 x[4]; const float* gp = MODl + mb##S * NMOD + 5 * DM + lane * 16; bf16_t* xo = (bf16_t*)(ws + (probe ? WS_ACT : WS_XF)) + (size_t)(r) * DM + lane * 16; \
        const unsigned a0[4] = {w0##S.x, w0##S.y, w0##S.z, w0##S.w}, a1[4] = {w1##S.x, w1##S.y, w1##S.z, w1##S.w}, a2[4] = {w2##S.x, w2##S.y, w2##S.z, w2##S.w}, a3[4] = {w3##S.x, w3##S.y, w3##S.z, w3##S.w}; \
        const f32x4 xr[4] = {(f32x4){bflo(xl##S.x), bfhi(xl##S.x), bflo(xl##S.y), bfhi(xl##S.y)}, (f32x4){bflo(xl##S.z), bfhi(xl##S.z), bflo(xl##S.w), bfhi(xl##S.w)}, \
                             (f32x4){bflo(xh##S.x), bfhi(xh##S.x), bflo(xh##S.y), bfhi(xh##S.y)}, (f32x4){bflo(xh##S.z), bfhi(xh##S.z), bflo(xh##S.w), bfhi(xh##S.w)}}; \
        _Pragma("unroll") for (int k = 0; k < 4; ++k) { const f32x4 y = (up4_fp8(a0[k]) + up4_fp8(a1[k])) + (up4_fp8(a2[k]) + up4_fp8(a3[k])); \
            const f32x4 g = *(const f32x4*)(gp + k * 4) * (1.0f / OUT2_SCALE); x[k] = xr[k] + g * y; } \
        if (l + 1 < DEPTH) { st_bf8(xo, x[0], x[1]); st_bf8(xo + 8, x[2], x[3]);            \
            const float* MODn = MODl + 3 * NMOD; norm_mod_row<true>(x, tab[I_N1G] + (l + 1) * DM, MODn + mb##S * NMOD, MODn + mb##S * NMOD + DM, lane); \
            bf16_t* hp = (bf16_t*)(ws + (probe ? WS_ACT + SZ_XF : WS_HA)) + (size_t)sigma_row((r), (l + 1) & 1) * DM + lane * 16; \
            st_bf8(hp, x[0], x[1]); st_bf8(hp + 8, x[2], x[3]); } \
        else if ((r) < NLAT) { float ss = 0.f; \
            _Pragma("unroll") for (int k = 0; k < 4; ++k) ss += x[k][0] * x[k][0] + x[k][1] * x[k][1] + x[k][2] * x[k][2] + x[k][3] * x[k][3]; \
            ss = wave_sum(ss); const float rstd = rsqrtf(ss * (1.0f / DM) + EPS); \
            _Pragma("unroll") for (int k = 0; k < 4; ++k) { const int c = lane * 16 + k * 4; *(f32x4*)((probe ? (float*)(ws + WS_ACT + SZ_XF) : (float*)tab[N_INPUTS]) + (size_t)(r) * DM + c) = x[k] * rstd * *(const f32x4*)(tab[I_FG] + c); } } } while (0)
    i32x4 enA, rnA, enB, rnB; CB_IDX(enA, rnA, u); enB = enA; rnB = rnA; if (u + G < nu) CB_IDX(enB, rnB, u + G);
    for (; u < nu; u += 2 * G) { const bool two = u + G < nu; const int rA = u * 8 + wid, rB = (two ? u + G : u) * 8 + wid;
        CB_LOAD(A, rA, enA, rnA) CB_LOAD(B, rB, enB, rnB)
        if (u + 2 * G < nu) { CB_IDX(enA, rnA, u + 2 * G); enB = enA; rnB = rnA; if (u + 3 * G < nu) CB_IDX(enB, rnB, u + 3 * G); }
        CB_FINISH(A, rA);
        if (two) CB_FINISH(B, rB);
    }
#undef CB_IDX
#undef CB_LOAD
#undef CB_FINISH
    __syncthreads();
}

#define GAS __attribute__((address_space(1)))
template <class T> __device__ __forceinline__ T* launder(T* p) { unsigned long long v = (unsigned long long)p; asm volatile("" : "+s"(v)); GAS T* g = (GAS T*)v; return (T*)g; }
#define PHASE_FN static __device__ __forceinline__
#define G8_LDS(l) ((LAS unsigned char*)(l))
PHASE_FN void ph_inproj(unsigned char* ws, const float* const* tab, unsigned char* lds, int l) {
    g8::GridOrder S{(const char*)(ws + WS_HA), (const char*)(ws + WS_WIN) + (size_t)l * NIN * DM * 2, (size_t)256 * DM * 2, (size_t)256 * DM * 2, 130, 20, 130 * 20, (int)gridDim.x, lbid()};
    F8Inproj E{(bf16_t*)(ws + WS_UA), (bf16_t*)(ws + WS_Z), (unsigned char*)(ws + WS_ZG8)};
    g8::gemm_phase<true, false>(G8_LDS(lds), DM, DM * 2, DM * 2, S, E);
    if (l + 1 < DEPTH && (130 * 20) % (int)gridDim.x != 0 && (int)lbid() >= (130 * 20) % (int)gridDim.x) conv_steal(ws, tab, lds, l + 1, 1);
}
PHASE_FN void ph_s5e(unsigned char* ws, unsigned char* lds, int l) {
    S5Order S{(const char*)(ws + WS_UA), (const char*)(ws + WS_BT1) + (size_t)l * S5G * 256 * 1024 * 2, (size_t)UAROWS * UALD * 2, (size_t)256 * 1024 * 2, UALD * 2, 1024 * 2, 3, 1, (int)gridDim.x, lbid()};
    g8::Epi4<F8S5E> E{{(float*)(ws + WS_S5E)}};
    g8::gemm_phase<false, false>(G8_LDS(lds), 1024, UALD * 2, 1024 * 2, S, E);
}
PHASE_FN void ph_s5y(unsigned char* ws, unsigned char* lds, int l) {
    S5Order S{(const char*)(ws + WS_UA), (const char*)(ws + WS_BT2) + (size_t)l * S5G * 1024 * UALD * 2, (size_t)UAROWS * UALD * 2, (size_t)1024 * UALD * 2, UALD * 2, UALD * 2, (l == DEPTH - 1) ? 2 : 3, 4, (int)gridDim.x, lbid()};
    g8::Epi8<F8S5Y> E{{(bf16_t*)(ws + WS_Z5)}};
    g8::gemm_phase<true, false>(G8_LDS(lds), UALD, UALD * 2, UALD * 2, S, E);
}
PHASE_FN void ph_glu(unsigned char* ws, const float* const* tab, unsigned char* lds, int l) {
    const int probe_ = 0;
    const int nM = (l == DEPTH - 1) ? NLAT / 256 : NTOK / 256;
    g8::GridOrder S{(const char*)(ws + WS_Z5), (const char*)(ws + WS_WGLU) + (size_t)l * 512 * 512 * 2, (size_t)256 * 512 * 2, (size_t)256 * 512 * 2, nM, 2, nM * 2, (int)gridDim.x, lbid()};
    g8::Epi8<F8Glu> E{{(const bf16_t*)(ws + WS_Z5), (bf16_t*)(ws + WS_YCAT)}};
    g8::gemm_phase<true, false>(G8_LDS(lds), 512, 512 * 2, 512 * 2, S, E);
    if (l + 1 < DEPTH && !probe_ && (nM * 2) % (int)gridDim.x != 0 && (int)lbid() >= (nM * 2) % (int)gridDim.x) conv_steal(ws, tab, lds, l + 1, 1);
}
PHASE_FN void ph_up5(unsigned char* ws, const float* const* tab, unsigned char* lds, int l) {
    const int probe_ = 0;
    const int nM = (l == DEPTH - 1) ? NLAT / 256 : NTOK / 256;
    g8::GridOrder S{(const char*)(ws + WS_YCAT), (const char*)(ws + WS_WUP5) + (size_t)l * 1024 * 512 * 2, (size_t)256 * DM * 2, (size_t)256 * 512 * 2, nM, 4, nM * 4, (int)gridDim.x, lbid()};
    g8::Epi8<F8Up5> E{{(const bf16_t*)(ws + WS_Z), (bf16_t*)(ws + WS_MBUF), (const unsigned char*)(ws + WS_ZG8)}};
    g8::gemm_phase<true, false>(G8_LDS(lds), 512, DM * 2, 512 * 2, S, E);
    if (l + 1 < DEPTH && !probe_ && (nM * 4) % (int)gridDim.x != 0 && (int)lbid() >= (nM * 4) % (int)gridDim.x) conv_steal(ws, tab, lds, l + 1, 1);
}
PHASE_FN void ph_uph(unsigned char* ws, const float* const* tab, unsigned char* lds, int l, int probe = 0) {
    const int probe_ = probe;
    const int nM = (l == DEPTH - 1) ? NLAT / 256 : NTOK / 256;
    g8::GridOrder S{(const char*)(ws + WS_YCAT) + 512 * 2, (const char*)(ws + WS_WUPH) + (size_t)l * 1024 * 512 * 2, (size_t)256 * DM * 2, (size_t)256 * 512 * 2, nM, 4, nM * 4, (int)gridDim.x, lbid()};
    g8::Epi8<F8Uph> E{{(const bf16_t*)(ws + WS_Z), (bf16_t*)(ws + WS_MBUF), (bf16_t*)(ws + (probe ? WS_ACT : WS_MBUF)), (const unsigned char*)(ws + WS_ZG8)}};
    g8::gemm_phase<true, false>(G8_LDS(lds), 512, DM * 2, 512 * 2, S, E);
    if (l + 1 < DEPTH && !probe_ && (nM * 4) % (int)gridDim.x != 0 && (int)lbid() >= (nM * 4) % (int)gridDim.x) conv_steal(ws, tab, lds, l + 1, 1);
}
PHASE_FN void ph_out(unsigned char* ws, const float* const* tab, unsigned char* lds, int l, int probe = 0) {
    const int probe_ = probe;
    const int nM = (l == DEPTH - 1) ? NLAT / 256 : NTOK / 256;
    g8::GridOrder S{(const char*)(ws + WS_MBUF), (const char*)(ws + WS_WOUT) + (size_t)l * 1024 * 1024 * 2, (size_t)256 * DM * 2, (size_t)256 * DM * 2, nM, 4, nM * 4, (int)gridDim.x, lbid()};
    F8Out E{(bf16_t*)(ws + (probe ? WS_ACT : WS_XF)), (const float*)(ws + WS_MOD) + (size_t)l * 3 * NMOD, l & 1};
    g8::gemm_phase<true, false>(G8_LDS(lds), DM, DM * 2, DM * 2, S, E);
    if (l + 1 < DEPTH && !probe_ && (nM * 4) % (int)gridDim.x != 0 && (int)lbid() >= (nM * 4) % (int)gridDim.x) conv_steal(ws, tab, lds, l + 1, 2);
}
PHASE_FN void ph_moe1(unsigned char* ws, const float* const* tab, unsigned char* lds, int l) {
    int* ps = (int*)(lds + g8::STAGE_BYTES); moe_segments(ws, ps, l);
    constexpr unsigned EB = MOE1_FP8 ? 1u : 2u;
    MoeOrder S{(const char*)(ws + (MOE1_FP8 ? WS_HA8 : WS_HA)), (const char*)(ws + WS_W1) + (size_t)l * NE * 2048 * 1024 * EB, (const int*)(ws + WS_ROWTOK), ps + 64, 2048u * 1024u * EB, 8, ps[NE] >> 8, (int)gridDim.x, lbid(), true, 256 * DM * EB};
    F8Moe1 E{(bf16_t*)(ws + WS_ACT), tab[I_B1] + (size_t)l * NE * 2048};
    g8::gemm_phase<true, true, MOE1_FP8 != 0>(G8_LDS(lds), MOE1_FP8 ? DM / 2 : DM, DM * EB, DM * EB, S, E);
    if (l + 1 < DEPTH) { g8::Unit du; const int rounds = (S.ntile + 31) >> 5; if (rounds > 0 && !S.next(rounds - 1, du)) conv_steal(ws, tab, lds, l + 1, 1); }
}
PHASE_FN void ph_moe2(unsigned char* ws, const float* const* tab, unsigned char* lds, int l) {
    int* ps = (int*)(lds + g8::STAGE_BYTES); moe_segments(ws, ps, l);
    constexpr unsigned EB = MOE2_FP8 ? 1u : 2u;
    MoeOrder S{(const char*)(ws + WS_ACT), (const char*)(ws + WS_W2) + (size_t)l * NE * 1024 * 1024 * EB, (const int*)(ws + WS_ROWTOK), ps + 64, 1024u * 1024u * EB, 4, ps[NE] >> 8, (int)gridDim.x, lbid(), false, 256 * DM * EB};
    F8Moe2 E{(bf16_t*)(ws + WS_OUT2), tab[I_B2] + (size_t)l * NE * 1024, (const float*)(ws + WS_ROWGATE), ps};
    g8::gemm_phase<true, false, MOE2_FP8 != 0>(G8_LDS(lds), MOE2_FP8 ? DM / 2 : DM, DM * EB, DM * EB, S, E);
    if (l + 1 < DEPTH) { g8::Unit du; const int rounds = (S.ntile + 63) >> 6; if (rounds > 0 && !S.next(rounds - 1, du)) conv_steal(ws, tab, lds, l + 1, 1); }
}
PHASE_FN void ph_hgrn_local(unsigned char* ws, const float* const* tab, unsigned char* lds, int l) {
    hgrn_local_phase(ws, lds, l);
}
PHASE_FN void ph_carry(unsigned char* ws, const float* const* tab, int l) {
    for (int u = lbid(); u < 16 + 256; u += gridDim.x) { if (u < 16) s5_carry(ws, tab, l, u); else hgrn_carry2(ws, u - 16); }
}
PHASE_FN void ph_hgrn_out(unsigned char* ws, const float* const* tab, unsigned char* lds, int l) {
    hgrn_out_phase(ws, tab, lds, l);
}

constexpr int PH_PER_LAYER = 12;
constexpr int N_PHASES = 2 + DEPTH * PH_PER_LAYER;
__global__ void __launch_bounds__(NTHREADS, 2) mega(Params P) {
    extern __shared__ __attribute__((aligned(16))) unsigned char lds[];
    const int tid = threadIdx.x;
    LAS unsigned* xbw = (LAS unsigned*)(lds + LDS_BYTES - 16);
    if (tid < 4) xbw[tid] = 0u;
    unsigned char* ws = P.ws;
    const float** tabw = (const float**)(ws + WS_PTRS) + (size_t)blockIdx.x * 32;
    if (tid == 0) {
#pragma unroll
        for (int i = 0; i < N_INPUTS; ++i) tabw[i] = P.in[i];
        tabw[N_INPUTS] = P.out;
    }
    __syncthreads();
    const float* const* tab = (const float* const*)tabw;
    XcdBarrier bar; bar.bar = (unsigned*)(ws + WS_CTL) + CW_BAR; bar.x = 0; bar.st = nullptr;
    const int lo = P.ph_lo, hi = P.ph_hi;
    if (hi - lo > 1) bar = xcd_barrier_post((unsigned*)(ws + WS_CTL) + CW_BAR, (volatile LAS unsigned*)xbw);
#ifndef PROBE_DUP_MASK
#define PROBE_DUP_MASK 0
#endif
#define DUPON(j) ((PROBE_DUP_MASK >> (j)) & 1)
#define IN(k) (lo <= (k) && (k) < hi && ((ws = launder(ws)), (tab = launder(tab)), true))
#define SEAM(k) do { if ((k) + 1 < hi) xcd_barrier(bar); } while (0)

    if (IN(0)) { phase_prologue(ws, tab, lds, 0); if (DUPON(13)) { xcd_barrier(bar); ws = launder(ws); tab = launder(tab); phase_prologue(ws, tab, lds, 1); } SEAM(0); }
    if (IN(1)) { phase_norm1(ws, tab, lds, 0); SEAM(1); }
#define LAYER_BODY(l) do { const int pb = 2 + l * PH_PER_LAYER; \
        if (IN(pb + 0)) { { ph_inproj(ws, tab, lds, l); } if (DUPON(0)) { ws = launder(ws); tab = launder(tab); ph_inproj(ws, tab, lds, l); } SEAM(pb + 0); } \
        if (IN(pb + 1)) { { ph_s5e(ws, lds, l); ph_hgrn_local(ws, tab, lds, l); } if (DUPON(1)) { ws = launder(ws); tab = launder(tab); ph_s5e(ws, lds, l); ph_hgrn_local(ws, tab, lds, l); } SEAM(pb + 1); } \
        if (IN(pb + 2)) { { ph_carry(ws, tab, l); } if (DUPON(2)) { ws = launder(ws); tab = launder(tab); ph_carry(ws, tab, l); } SEAM(pb + 2); } \
        if (IN(pb + 3)) { { ph_s5y(ws, lds, l); ph_hgrn_out(ws, tab, lds, l); } if (DUPON(3)) { ws = launder(ws); tab = launder(tab); ph_s5y(ws, lds, l); ph_hgrn_out(ws, tab, lds, l); } SEAM(pb + 3); } \
        if (IN(pb + 4)) { { ph_glu(ws, tab, lds, l); } if (DUPON(4)) { ws = launder(ws); tab = launder(tab); ph_glu(ws, tab, lds, l); } SEAM(pb + 4); } \
        if (IN(pb + 5)) { { ph_up5(ws, tab, lds, l); } if (DUPON(5)) { ws = launder(ws); tab = launder(tab); ph_up5(ws, tab, lds, l); } SEAM(pb + 5); } \
        if (IN(pb + 6)) { ph_uph(ws, tab, lds, l); if (DUPON(6)) { ws = launder(ws); ph_uph(ws, tab, lds, l, 1); } SEAM(pb + 6); } \
        if (IN(pb + 7)) { ph_out(ws, tab, lds, l); if (DUPON(7)) { ws = launder(ws); ph_out(ws, tab, lds, l, 1); } SEAM(pb + 7); } \
        if (IN(pb + 8)) { phase_norm2_route(ws, tab, lds, l); if (DUPON(8)) { ws = launder(ws); tab = launder(tab); phase_norm2_route(ws, tab, lds, l, 1); } SEAM(pb + 8); } \
        if (IN(pb + 9)) { { ph_moe1(ws, tab, lds, l); } if (DUPON(10)) { ws = launder(ws); tab = launder(tab); ph_moe1(ws, tab, lds, l); } SEAM(pb + 9); } \
        if (IN(pb + 10)) { { ph_moe2(ws, tab, lds, l); } if (DUPON(11)) { ws = launder(ws); tab = launder(tab); ph_moe2(ws, tab, lds, l); } SEAM(pb + 10); } \
        if (IN(pb + 11)) { if (DUPON(12)) { phase_combine(ws, tab, lds, l, 1); ws = launder(ws); tab = launder(tab); } phase_combine(ws, tab, lds, l); if (l + 1 < DEPTH) conv_steal(ws, tab, lds, l + 1, 1 << 30); SEAM(pb + 11); } } while (0)
    LAYER_BODY(0); LAYER_BODY(1); LAYER_BODY(2); LAYER_BODY(3);
#undef LAYER_BODY
#undef IN
#undef SEAM
}

#ifndef MK_LAUNCH_PER_PHASE
#define MK_LAUNCH_PER_PHASE 0
#endif
extern "C" void kernel_launch(void* const* d_in, const int* in_sizes, int n_in, void* d_out, int out_size, void* d_ws, size_t ws_size, hipStream_t stream) {
    static int grid = 0;
    if (grid == 0) {
        if (n_in != N_INPUTS || out_size != NLAT * DM || ws_size < WS_END) { fprintf(stderr, "kernel_launch: unexpected problem (n_in %d, out %d, ws %zu < %zu)\n", n_in, out_size, ws_size, (size_t)WS_END); grid = -1; return; }
        int dev = 0, cus = 0, per_cu = 0;
        if (hipGetDevice(&dev) != hipSuccess || hipDeviceGetAttribute(&cus, hipDeviceAttributeMultiprocessorCount, dev) != hipSuccess) { grid = -1; return; }
        if (hipFuncSetAttribute((const void*)mega, hipFuncAttributeMaxDynamicSharedMemorySize, LDS_BYTES) != hipSuccess) { fprintf(stderr, "kernel_launch: hipFuncSetAttribute failed\n"); grid = -1; return; }
        if (hipOccupancyMaxActiveBlocksPerMultiprocessor(&per_cu, (const void*)mega, NTHREADS, LDS_BYTES) != hipSuccess || per_cu < 1) { fprintf(stderr, "kernel_launch: occupancy query says %d\n", per_cu); }
        (void)hipGetLastError();
        grid = cus;
    }
    if (grid < 0) return;
    (void)hipMemsetAsync((char*)d_ws + WS_CTL, 0, CTL_BYTES, stream);
    Params p{};
    for (int i = 0; i < N_INPUTS; ++i) p.in[i] = (const float*)d_in[i];
    p.out = (float*)d_out; p.ws = (unsigned char*)d_ws;
#if MK_LAUNCH_PER_PHASE
    for (int ph = 0; ph < N_PHASES; ++ph) { p.ph_lo = ph; p.ph_hi = ph + 1; hipLaunchKernelGGL(mega, dim3(grid), dim3(NTHREADS), LDS_BYTES, stream, p); }
#else
    p.ph_lo = 0; p.ph_hi = N_PHASES; hipLaunchKernelGGL(mega, dim3(grid), dim3(NTHREADS), LDS_BYTES, stream, p);
#endif
}
```

```cpp
#include <hip/hip_runtime.h>
#include <cstdio>
#include <cstdint>

typedef unsigned short bf16_t;
typedef short bf16x8 __attribute__((ext_vector_type(8)));
typedef float f32x4 __attribute__((ext_vector_type(4)));
typedef unsigned u32x2 __attribute__((ext_vector_type(2)));
typedef unsigned u32x4 __attribute__((ext_vector_type(4)));
typedef int i32x8 __attribute__((ext_vector_type(8)));
typedef int i32x4v __attribute__((ext_vector_type(4)));
#define MOE1_FP8 1
#define MOE2_FP8 1
constexpr float FP8_WSCALE = MOE1_FP8 ? 32.0f : 1.0f, FP8_ASCALE = MOE1_FP8 ? 4.0f : 1.0f;
#define LAS __attribute__((address_space(3)))

constexpr int DM = 1024, NB = 2, SEQ = 16384, DEPTH = 4, CTXL = 256;
constexpr int NLAT = NB * SEQ, NCTX = NB * CTXL, NTOK = NLAT + NCTX;
constexpr int CH = 64, NCHUNK = NTOK / CH;
constexpr int S5G = 32, S5H = 16, S5P = 64;
constexpr int HH = 4;
constexpr int NIN = 5120, ZC = NIN - 512;
constexpr int ZQ = 0, ZI = 512, ZFF = 1024, ZFB = 1536, ZG = 2048, Z6 = 2560, Z7 = 3584;
constexpr int NE = 32, TOPK = 4;
constexpr int NMOD = 6 * DM;
constexpr int UAROWS = 768, UALD = 1280;
constexpr int MAXROWS = NTOK * TOPK + NE * 256;
constexpr int NTHREADS = 512;
constexpr int LDS_BYTES = 147456;
constexpr float EPS = 1e-6f;

constexpr size_t al256(size_t x) { return (x + 255) & ~(size_t)255; }
constexpr size_t WS_CTL = 0;                 constexpr size_t CTL_BYTES = 1u << 20;
constexpr size_t WS_MOD = WS_CTL + CTL_BYTES;            constexpr size_t SZ_MOD = (size_t)DEPTH * 3 * NMOD * 4;
constexpr size_t WS_LB = al256(WS_MOD + SZ_MOD);         constexpr size_t SZ_LB = (size_t)2 * DEPTH * 512 * 4;
constexpr size_t WS_LAMT = al256(WS_LB + SZ_LB);         constexpr size_t SZ_LAMT = (size_t)DEPTH * 2 * S5G * S5P * 2 * 4;
constexpr size_t WS_KT = al256(WS_LAMT + SZ_LAMT);       constexpr size_t SZ_KT = (size_t)DEPTH * S5G * 2 * 64 * 256 * 4;
constexpr size_t WS_S5T = al256(WS_KT + SZ_KT);          constexpr size_t SZ_S5T = (size_t)DEPTH * S5G * (2 * 64 * 65 + 2 * 64 * 16 + 2 * 16 * 64) * 8;
constexpr size_t WS_BT1 = al256(WS_S5T + SZ_S5T);          constexpr size_t SZ_BT1 = (size_t)DEPTH * S5G * 256 * 1024 * 2;
constexpr size_t WS_BT2 = al256(WS_BT1 + SZ_BT1);        constexpr size_t SZ_BT2 = (size_t)DEPTH * S5G * 1024 * UALD * 2;
constexpr size_t WS_XF = al256(WS_BT2 + SZ_BT2);         constexpr size_t SZ_XF = (size_t)NTOK * DM * 4;
constexpr size_t WS_HA = al256(WS_XF + SZ_XF);           constexpr size_t SZ_HA = (size_t)NTOK * DM * 2;
constexpr size_t WS_UA = al256(WS_HA + SZ_HA);           constexpr size_t SZ_UA = (size_t)S5G * UAROWS * UALD * 2;
constexpr size_t WS_Z = al256(WS_UA + SZ_UA);            constexpr size_t SZ_Z = (size_t)NTOK * ZC * 2;
constexpr size_t WS_Z5 = al256(WS_Z + SZ_Z);             constexpr size_t SZ_Z5 = (size_t)NTOK * 512 * 2;
constexpr size_t WS_YCAT = al256(WS_Z5 + SZ_Z5);         constexpr size_t SZ_YCAT = (size_t)NTOK * DM * 2;
constexpr size_t WS_MBUF = al256(WS_YCAT + SZ_YCAT);     constexpr size_t SZ_MBUF = (size_t)NTOK * DM * 2;
constexpr size_t WS_S5E = al256(WS_MBUF + SZ_MBUF);      constexpr size_t SZ_S5E = (size_t)S5G * UAROWS * 256 * 4;
constexpr size_t WS_HKV = al256(WS_S5E + SZ_S5E);        constexpr size_t SZ_HKV = (size_t)NCHUNK * HH * 2 * 128 * 128 * 4;
constexpr size_t WS_HS = al256(WS_HKV + SZ_HKV);         constexpr size_t SZ_HS = SZ_HKV;
constexpr size_t WS_HTOT = al256(WS_HS + SZ_HS);         constexpr size_t SZ_HTOT = (size_t)NCHUNK * HH * 2 * 128 * 4;
constexpr size_t WS_TOPE = al256(WS_HTOT + SZ_HTOT);     constexpr size_t SZ_TOP = (size_t)NTOK * TOPK * 4;
constexpr size_t WS_TOPG = al256(WS_TOPE + SZ_TOP);
constexpr size_t WS_TOPR = al256(WS_TOPG + SZ_TOP);
constexpr size_t WS_POS = al256(WS_TOPR + SZ_TOP);
constexpr size_t WS_ROWTOK = al256(WS_POS + SZ_TOP);     constexpr size_t SZ_ROWS = (size_t)NE * NTOK * 4;
constexpr size_t WS_ROWGATE = al256(WS_ROWTOK + SZ_ROWS);
constexpr size_t WS_ACT = al256(WS_ROWGATE + SZ_ROWS);   constexpr size_t SZ_ACT = (size_t)MAXROWS * DM * 2;
constexpr size_t WS_OUT2 = al256(WS_ACT + SZ_ACT);
constexpr size_t WS_WIN = al256(WS_OUT2 + SZ_ACT);       constexpr size_t SZ_WIN = (size_t)DEPTH * NIN * DM * 2;
constexpr size_t WS_WGLU = al256(WS_WIN + SZ_WIN);       constexpr size_t SZ_WGLU = (size_t)DEPTH * 512 * 512 * 2;
constexpr size_t WS_WUP5 = al256(WS_WGLU + SZ_WGLU);     constexpr size_t SZ_WUP = (size_t)DEPTH * 1024 * 512 * 2;
constexpr size_t WS_WUPH = al256(WS_WUP5 + SZ_WUP);
constexpr size_t WS_WOUT = al256(WS_WUPH + SZ_WUP);      constexpr size_t SZ_WOUT = (size_t)DEPTH * 1024 * 1024 * 2;
constexpr size_t WS_W1 = al256(WS_WOUT + SZ_WOUT);       constexpr size_t SZ_W1 = (size_t)DEPTH * NE * 2048 * 1024 * 2;
constexpr size_t WS_W2 = al256(WS_W1 + SZ_W1);           constexpr size_t SZ_W2 = (size_t)DEPTH * NE * 1024 * 1024 * 2;
constexpr size_t WS_HA8 = al256(WS_W2 + SZ_W2);         constexpr size_t SZ_HA8 = (size_t)NTOK * DM;
constexpr size_t WS_ZG8 = al256(WS_HA8 + SZ_HA8);       constexpr size_t SZ_ZG8 = (size_t)NTOK * 2048;
constexpr size_t WS_END = al256(WS_ZG8 + SZ_ZG8);

constexpr int CW_BAR = 0;
constexpr int CW_WQ = 3584;
constexpr int CW_CNT = 4096;
constexpr int CW_WQ2 = 8192;
constexpr size_t WS_PTRS = WS_CTL + 65536;

enum { I_X = 0, I_C, I_CTX, I_CCTX, I_MODW, I_MODB, I_N1G, I_N2G, I_WIN, I_ARE, I_AIM, I_LOGDT, I_BRE, I_BIM, I_CRE, I_CIM, I_S5D, I_WGLU,
       I_LBL, I_HNG, I_WUP5, I_WUPH, I_WOUT, I_RW, I_RB, I_W1, I_B1, I_W2, I_B2, I_FG, N_INPUTS };

struct Params { const float* in[N_INPUTS]; float* out; unsigned char* ws; int ph_lo, ph_hi; };

typedef __bf16 bf16v2 __attribute__((ext_vector_type(2)));
typedef float f32v2 __attribute__((ext_vector_type(2)));
__device__ __forceinline__ unsigned pack2(float a, float b) { const f32v2 v = {a, b}; const bf16v2 r = __builtin_convertvector(v, bf16v2); return __builtin_bit_cast(unsigned, r); }
__device__ __forceinline__ bf16_t f2bf(float f) { return __builtin_bit_cast(unsigned short, (__bf16)f); }
__device__ __forceinline__ float sat_fp8(float x) { return __builtin_amdgcn_fmed3f(x, -448.0f, 448.0f); }
__device__ __forceinline__ unsigned pack4_fp8(float a, float b, float c, float d) { unsigned w = 0u; w = __builtin_amdgcn_cvt_pk_fp8_f32(sat_fp8(a), sat_fp8(b), w, false); w = __builtin_amdgcn_cvt_pk_fp8_f32(sat_fp8(c), sat_fp8(d), w, true); return w; }
__device__ __forceinline__ float bf2f(bf16_t b) { return __uint_as_float(((unsigned)b) << 16); }
__device__ __forceinline__ float bflo(unsigned w) { return __uint_as_float(w << 16); }
__device__ __forceinline__ float bfhi(unsigned w) { return __uint_as_float(w & 0xffff0000u); }
__device__ __forceinline__ f32x4 up4_fp8(unsigned w) { typedef float f32x2v __attribute__((ext_vector_type(2))); const f32x2v lo = __builtin_amdgcn_cvt_pk_f32_fp8(w, false), hi = __builtin_amdgcn_cvt_pk_f32_fp8(w, true); return (f32x4){lo.x, lo.y, hi.x, hi.y}; }
#ifndef ZG8_FP8
#define ZG8_FP8 1
#endif
constexpr float ZG8_SCALE = 16.0f;
__device__ __forceinline__ float sigmoidf_(float x) { return __builtin_amdgcn_rcpf(1.0f + __builtin_amdgcn_exp2f(-1.4426950408889634f * x)); }
__device__ __forceinline__ float ex2(float x) { return __builtin_amdgcn_exp2f(x); }
__device__ __forceinline__ float lg2(float x) { return __builtin_amdgcn_logf(x); }
__device__ __forceinline__ float sigf(float x) { return __builtin_amdgcn_rcpf(1.0f + ex2(-1.4426950408889634f * x)); }
__device__ __forceinline__ float gelu_tanh(float x) { const float y = 0.7978845608028654f * (x + 0.044715f * x * x * x); return x * __builtin_amdgcn_rcpf(1.0f + __builtin_amdgcn_exp2f(-2.8853900817779268f * y)); }
__device__ __forceinline__ float wave_sum(float v) {
#pragma unroll
    for (int o = 32; o >= 1; o >>= 1) v += __shfl_xor(v, o);
    return v;
}
__device__ __forceinline__ int sigma_row(int r, int odd) {
    if (r >= NLAT || !odd) return r;
    const int b = r >> 14, n = r & 16383; return (b << 14) + ((n & 63) << 8) + (n >> 6);
}
__device__ __forceinline__ int sigma_inv(int s, int odd) {
    if (s >= NLAT || !odd) return s;
    const int b = s >> 14, q = s & 16383; return (b << 14) + ((q & 255) << 6) + (q >> 8);
}

__device__ __forceinline__ int ltid() { int t = threadIdx.x; asm volatile("" : "+v"(t)); return t; }
__device__ __forceinline__ int lbid() { int t = blockIdx.x; asm volatile("" : "+s"(t)); return t; }
#define XB_TMO      128
#define XB_XCNT(j)  (256  + 64 * (j))
#define XB_XSUB(j)  (1280 + 64 * (j))
#define XB_XGEN(j)  (2304 + 64 * (j))
#define XB_TOP      3328
#define XB_TOPGEN   3392
#define XCD_BAR_WORDS 3456
#define XB_SPIN_CAP (1u << 22)
__device__ __forceinline__ unsigned xb_ld(unsigned* p)              { return __hip_atomic_load(p, __ATOMIC_RELAXED, __HIP_MEMORY_SCOPE_AGENT); }
__device__ __forceinline__ unsigned xb_add(unsigned* p, unsigned v) { return __hip_atomic_fetch_add(p, v, __ATOMIC_RELAXED, __HIP_MEMORY_SCOPE_AGENT); }
__device__ __forceinline__ unsigned xb_xcc_id() { return (unsigned)__builtin_amdgcn_s_getreg((3 << 11) | 20) & 0xFu; }
#define XB_SPIN(cond, bar) do { unsigned _sp = 0; while (cond) { __builtin_amdgcn_s_sleep(1); \
    if ((++_sp & 255u) == 0u) { if (xb_ld(&(bar)[XB_TMO])) break; if (_sp > XB_SPIN_CAP) { atomicAdd(&(bar)[XB_TMO], 1u); break; } } } } while (0)
struct XcdBarrier { unsigned* bar; unsigned x; volatile LAS unsigned* st; };
__device__ __forceinline__ XcdBarrier xcd_barrier_post(unsigned* bar, volatile LAS unsigned* st) {
    XcdBarrier b; b.bar = bar; b.x = xb_xcc_id(); b.st = st;
    if (threadIdx.x == 0) (void)xb_add(&bar[XB_XCNT(b.x)], 1u);
    return b;
}
__device__ __forceinline__ void xcd_barrier_complete(unsigned* bar, unsigned x, unsigned& nloc, unsigned& nx) {
    const unsigned G = gridDim.x * gridDim.y * gridDim.z;
    unsigned sum, cnt, mine, sp = 0u;
    for (;;) {
        sum = 0u; cnt = 0u; mine = 0u;
#pragma unroll
        for (unsigned j = 0; j < 16; ++j) { const unsigned c = xb_ld(&bar[XB_XCNT(j)]); sum += c; cnt += (c > 0u) ? 1u : 0u; mine = (j == x) ? c : mine; }
        if (sum == G) break;
        __builtin_amdgcn_s_sleep(1);
        if ((++sp & 255u) == 0u) { if (xb_ld(&bar[XB_TMO])) break; if (sp > XB_SPIN_CAP) { atomicAdd(&bar[XB_TMO], 1u); break; } }
    }
    nloc = mine > 0u ? mine : 1u; nx = cnt > 0u ? cnt : 1u;
}
__device__ __forceinline__ void xcd_barrier(const XcdBarrier& b) {
    asm volatile("s_waitcnt vmcnt(0)" ::: "memory");
    __syncthreads();
    if (threadIdx.x == 0) {
        unsigned* bar = b.bar;
        __builtin_amdgcn_s_waitcnt(0);
        unsigned nloc = b.st[0], nx = b.st[1];
        if (nloc == 0u) { xcd_barrier_complete(bar, b.x, nloc, nx); b.st[0] = nloc; b.st[1] = nx; }
        const unsigned old = xb_add(&bar[XB_XSUB(b.x)], 1u);
        const unsigned gen = old / nloc;
        if (old + 1u == (gen + 1u) * nloc) {
            __builtin_amdgcn_fence(__ATOMIC_RELEASE, "agent");
            asm volatile("s_waitcnt vmcnt(0)" ::: "memory");
            const unsigned og = xb_add(&bar[XB_TOP], 1u);
            const unsigned tg = og / nx;
            if (og + 1u == (tg + 1u) * nx) xb_add(&bar[XB_TOPGEN], 1u);
            else XB_SPIN(xb_ld(&bar[XB_TOPGEN]) == tg, bar);
            __builtin_amdgcn_fence(__ATOMIC_ACQUIRE, "agent");
            xb_add(&bar[XB_XGEN(b.x)], 1u);
            asm volatile("s_waitcnt vmcnt(0)" ::: "memory");
        } else {
            XB_SPIN(xb_ld(&bar[XB_XGEN(b.x)]) == gen, bar);
            __builtin_amdgcn_fence(__ATOMIC_ACQUIRE, "agent");
            asm volatile("s_waitcnt vmcnt(0)" ::: "memory");
        }
    }
    __syncthreads();
}

constexpr int G_ABUF = 32768, G_BBUF = 16384, G_BUF = G_ABUF + G_BBUF;
template <class Epi>
__device__ __forceinline__ void gemm256x128(unsigned char* lds_g, const bf16_t* A, long lda, const int* rowidx, const bf16_t* Bt, long ldb, int K, const Epi& epi) {
    LAS unsigned char* lds = (LAS unsigned char*)lds_g;
    const int tid = ltid(), lane = tid & 63, wid = tid >> 6, wr = wid >> 1, wc = wid & 1, fr = lane & 15, fq = lane >> 4;
    const int r0 = tid >> 3, cg = (tid & 7) ^ (r0 & 7);
    const int wvu = __builtin_amdgcn_readfirstlane(wid);
    const bf16_t* pa[4]; const bf16_t* pb[2];
#pragma unroll
    for (int i = 0; i < 4; ++i) { const int r = r0 + 64 * i; const long rr = rowidx ? (long)rowidx[r] : (long)r; pa[i] = A + rr * lda + cg * 8; }
#pragma unroll
    for (int i = 0; i < 2; ++i) { const int r = r0 + 64 * i; pb[i] = Bt + (long)r * ldb + cg * 8; }
    f32x4 acc[4][4];
#pragma unroll
    for (int m = 0; m < 4; ++m)
#pragma unroll
        for (int n = 0; n < 4; ++n) acc[m][n] = (f32x4){0.f, 0.f, 0.f, 0.f};
    const int nk = K >> 6;
#define G_STAGE(kt, buf) do { \
        _Pragma("unroll") for (int _i = 0; _i < 4; ++_i) __builtin_amdgcn_global_load_lds((const unsigned*)(pa[_i] + (size_t)(kt) * 64), (LAS unsigned*)(lds + (buf) * G_BUF + wvu * 1024 + _i * 8192), 16, 0, 0); \
        _Pragma("unroll") for (int _i = 0; _i < 2; ++_i) __builtin_amdgcn_global_load_lds((const unsigned*)(pb[_i] + (size_t)(kt) * 64), (LAS unsigned*)(lds + (buf) * G_BUF + G_ABUF + wvu * 1024 + _i * 8192), 16, 0, 0); } while (0)
    G_STAGE(0, 0);
    const int arow = wr * 64 + fr, brow = wc * 64 + fr, sw = fr & 7;
    for (int kt = 0; kt < nk; ++kt) {
        const int cur = kt & 1;
        if (kt + 1 < nk) { G_STAGE(kt + 1, cur ^ 1); asm volatile("s_waitcnt vmcnt(6)" ::: "memory"); }
        else asm volatile("s_waitcnt vmcnt(0)" ::: "memory");
        __builtin_amdgcn_s_barrier();
        asm volatile("" ::: "memory");
        const LAS unsigned char* ab = lds + cur * G_BUF; const LAS unsigned char* bb = ab + G_ABUF;
#pragma unroll
        for (int ks = 0; ks < 2; ++ks) {
            bf16x8 af[4], bfr[4];
            const int co = (((ks * 4 + fq) ^ sw) << 4);
#pragma unroll
            for (int m = 0; m < 4; ++m) af[m] = *(const LAS bf16x8*)(ab + (arow + m * 16) * 128 + co);
#pragma unroll
            for (int n = 0; n < 4; ++n) bfr[n] = *(const LAS bf16x8*)(bb + (brow + n * 16) * 128 + co);
#pragma unroll
            for (int m = 0; m < 4; ++m)
#pragma unroll
                for (int n = 0; n < 4; ++n) acc[m][n] = __builtin_amdgcn_mfma_f32_16x16x32_bf16(bfr[n], af[m], acc[m][n], 0, 0, 0);
        }
        asm volatile("s_waitcnt lgkmcnt(0)" ::: "memory");
        __builtin_amdgcn_s_barrier();
        asm volatile("" ::: "memory");
    }
#undef G_STAGE
    epi(acc, wr, wc, fr, fq);
}
template <class E> struct EpiFrag {
    E e;
    __device__ __forceinline__ void operator()(const f32x4 (&acc)[4][4], int wr, int wc, int fr, int fq) const {
#pragma unroll
        for (int m = 0; m < 4; ++m)
#pragma unroll
            for (int n = 0; n < 4; ++n) e.store(wr * 64 + m * 16 + fr, wc * 64 + n * 16 + fq * 4, acc[m][n]);
    }
};
__device__ __forceinline__ void st_bf4(bf16_t* p, f32x4 v) { u32x2 w; w.x = pack2(v[0], v[1]); w.y = pack2(v[2], v[3]); *(u32x2*)p = w; }
__device__ __forceinline__ f32x4 ld_bf4(const bf16_t* p) { const u32x2 w = *(const u32x2*)p; return (f32x4){bflo(w.x), bfhi(w.x), bflo(w.y), bfhi(w.y)}; }

struct EInproj { bf16_t* UA; bf16_t* Z; int m0, n0;
    __device__ __forceinline__ void store(int rl, int cl, f32x4 v) const { const int s = m0 + rl, c = n0 + cl;
        if (c < 512) { const int g = c >> 4, hi = c & 15, rho = s >> 6, j = s & 63; st_bf4(UA + ((size_t)(g * UAROWS + rho) * UALD + j * 16 + hi), v); }
        else st_bf4(Z + (size_t)s * ZC + (c - 512), v); } };
struct ES5E { float* E; int g, m0, n0;
    __device__ __forceinline__ void store(int rl, int cl, f32x4 v) const { const int rho = m0 + rl; if (rho < NCHUNK) *(f32x4*)(E + ((size_t)(g * UAROWS + rho) * 256 + n0 + cl)) = v; } };
struct ES5Y { bf16_t* Z5; int g, m0, n0;
    __device__ __forceinline__ void store(int rl, int cl, f32x4 v) const { const int rho = m0 + rl; if (rho < NCHUNK) { const int col = n0 + cl, j = col >> 4, ho = col & 15;
        f32x4 o; o[0] = gelu_tanh(v[0]); o[1] = gelu_tanh(v[1]); o[2] = gelu_tanh(v[2]); o[3] = gelu_tanh(v[3]); st_bf4(Z5 + ((size_t)(rho * 64 + j) * 512 + g * 16 + ho), o); } } };
struct EGlu { const bf16_t* Z5; bf16_t* Y; int m0, n0;
    __device__ __forceinline__ void store(int rl, int cl, f32x4 v) const { const size_t r = m0 + rl; const int c = n0 + cl; const f32x4 z = ld_bf4(Z5 + r * 512 + c);
        f32x4 o; o[0] = z[0] * sigmoidf_(v[0]); o[1] = z[1] * sigmoidf_(v[1]); o[2] = z[2] * sigmoidf_(v[2]); o[3] = z[3] * sigmoidf_(v[3]); st_bf4(Y + r * DM + c, o); } };
struct EUp5 { const bf16_t* Z; bf16_t* Mb; int m0, n0;
    __device__ __forceinline__ void store(int rl, int cl, f32x4 v) const { const size_t r = m0 + rl; const int c = n0 + cl; const f32x4 z = ld_bf4(Z + r * ZC + Z6 + c);
        f32x4 o; o[0] = sigmoidf_(z[0]) * v[0]; o[1] = sigmoidf_(z[1]) * v[1]; o[2] = sigmoidf_(z[2]) * v[2]; o[3] = sigmoidf_(z[3]) * v[3]; st_bf4(Mb + r * DM + c, o); } };
struct EUph { const bf16_t* Z; bf16_t* Mb; int m0, n0;
    __device__ __forceinline__ void store(int rl, int cl, f32x4 v) const { const size_t r = m0 + rl; const int c = n0 + cl; const f32x4 z = ld_bf4(Z + r * ZC + Z7 + c); const f32x4 p = ld_bf4(Mb + r * DM + c);
        f32x4 o; o[0] = p[0] + sigmoidf_(z[0]) * v[0]; o[1] = p[1] + sigmoidf_(z[1]) * v[1]; o[2] = p[2] + sigmoidf_(z[2]) * v[2]; o[3] = p[3] + sigmoidf_(z[3]) * v[3]; st_bf4(Mb + r * DM + c, o); } };
struct EOut { float* XF; const float* modl; int odd, m0, n0;
    __device__ __forceinline__ void store(int rl, int cl, f32x4 v) const { const int s = m0 + rl, c = n0 + cl; const int r = sigma_inv(s, odd); const int mb = r < NLAT ? (r >> 14) : 2;
        const f32x4 g = *(const f32x4*)(modl + mb * NMOD + 2 * DM + c); float* xp = XF + (size_t)r * DM + c; f32x4 x = *(f32x4*)xp; x += g * v; *(f32x4*)xp = x; } };
struct EMoe2 { bf16_t* O; const float* b2; const float* rgate; int m0, n0;
    __device__ __forceinline__ void store(int rl, int cl, f32x4 v) const { const size_t r = m0 + rl; const int c = n0 + cl; const float g = rgate[r]; const f32x4 b = *(const f32x4*)(b2 + c);
        f32x4 o = (v + b) * g; st_bf4(O + r * DM + c, o); } };
struct EMoe1 { bf16_t* ACT; const float* b1; int m0, pn;
    __device__ __forceinline__ void operator()(const f32x4 (&acc)[4][4], int wr, int wc, int fr, int fq) const {
#pragma unroll
        for (int m = 0; m < 4; ++m)
#pragma unroll
            for (int n = 0; n < 2; ++n) { const size_t r = m0 + wr * 64 + m * 16 + fr; const int ch = pn * 64 + wc * 32 + n * 16 + fq * 4;
                const f32x4 bg = *(const f32x4*)(b1 + ch), bu = *(const f32x4*)(b1 + 1024 + ch); f32x4 o;
#pragma unroll
                for (int j = 0; j < 4; ++j) { float g = acc[m][n][j] + bg[j], u = acc[m][n + 2][j] + bu[j]; g = fminf(g, 7.0f); u = fminf(fmaxf(u, -7.0f), 7.0f); o[j] = g * sigmoidf_(1.702f * g) * (u + 1.0f); }
                st_bf4(ACT + r * DM + ch, o); }
    }
};


#define PROBE_EPI2 0
template <class E> struct epi_dup { static constexpr bool v = false; };
template <class E> struct epi_nst { static constexpr int v = 0; };
namespace g8 {
constexpr int BM = 256, BK = 64, HALF = 128, HTB = HALF * BK * 2, STAGE_BYTES = 8 * HTB;
__device__ __forceinline__ int lds_byte(int r, int c) { const int st = (r >> 4) * 2 + (c >> 5), rr = r & 15, cc = c & 31, ob = rr * 64 + cc * 2; return st * 1024 + (ob ^ (((ob >> 9) & 1) << 5)); }
__device__ __forceinline__ void stage_rc(int b, int& R, int& C) { const int st = b / 1024, sb = b % 1024, swz = sb ^ (((sb >> 9) & 1) << 5); R = (st >> 1) * 16 + swz / 64; C = (st & 1) * 32 + (swz % 64) / 2; }
__device__ __forceinline__ int perm32(int rho) { const int n = rho >> 4, i = rho & 15; return 8 * (i >> 2) + 4 * n + (i & 3); }
struct Unit { const char* a; const char* b; int pm, pn, aux; };
__device__ __forceinline__ i32x8 cat8(bf16x8 lo, bf16x8 hi) { typedef int i32x4 __attribute__((ext_vector_type(4))); const i32x4 a = __builtin_bit_cast(i32x4, lo), b = __builtin_bit_cast(i32x4, hi); return (i32x8){a[0], a[1], a[2], a[3], b[0], b[1], b[2], b[3]}; }
#ifndef G8_SP2
#define G8_SP2 1
#endif
#ifndef G8_ALIGN_EPI
#define G8_ALIGN_EPI 1
#endif
template <bool PERM, bool GATHER, bool FP8 = false, class Sched, class Epi>
__device__ __forceinline__ void gemm_phase(LAS unsigned char* lds, const int K, const unsigned lda_b, const unsigned ldb_b, const Sched& S, const Epi& E) {
    const int tid = ltid(), wid = __builtin_amdgcn_readfirstlane(tid >> 6), lane = tid & 63, wr = wid >> 2, wc = wid & 3, fr = lane & 15, fq = lane >> 4;
    const int nt = K / BK; constexpr int NST = epi_nst<Epi>::v;
    int Rr[2], Cc[2]; unsigned voffB[2], voffA[2][2], voffN[2][2];
#pragma unroll
    for (int i = 0; i < 2; ++i) { stage_rc(tid * 16 + i * 8192, Rr[i], Cc[i]); const int Rb = PERM ? ((Rr[i] & ~31) + perm32(Rr[i] & 31)) : Rr[i];
        voffB[i] = (unsigned)Rb * ldb_b + (unsigned)Cc[i] * 2u; }
    const size_t kstep = (size_t)(BK * 2);
    const size_t hstepB = (size_t)HALF * ldb_b;
    const unsigned ldsw = (unsigned)wid * 1024u;
    const int aoff = lds_byte(wr * 64 + fr, FP8 ? fq * 16 : fq * 8), boff = lds_byte(wc * 32 + fr, FP8 ? fq * 16 : fq * 8);
    constexpr int aoff1 = FP8 ? 16 : 1024, boff1 = aoff1;
#define G8_SA(b, h) (((b) * 2 + (h)) * HTB)
#define G8_SB(b, h) ((4 + (b) * 2 + (h)) * HTB)
#define G8_STAGE(bufoff, gbase, voff) do { _Pragma("unroll") for (int _i = 0; _i < 2; ++_i) \
        __builtin_amdgcn_global_load_lds((const unsigned*)((const char*)(gbase) + (voff)[_i]), (LAS unsigned*)(lds + (bufoff) + ldsw + _i * 8192), 16, 0, 0); } while (0)
#define G8_CAT(p0, p1) __builtin_shufflevector(p0, p1, 0, 1, 2, 3, 4, 5, 6, 7)
#define G8_LO(v) __builtin_bit_cast(bf16x8, __builtin_shufflevector(v, v, 0, 1, 2, 3))
#define G8_HI(v) __builtin_bit_cast(bf16x8, __builtin_shufflevector(v, v, 4, 5, 6, 7))
#define G8_LDA(dst, b, h) do { _Pragma("unroll") for (int m = 0; m < 4; ++m) { const i32x4v p0 = *(const LAS i32x4v*)(lds + G8_SA(b, h) + aoff + m * 2048), p1 = *(const LAS i32x4v*)(lds + G8_SA(b, h) + aoff + m * 2048 + aoff1); dst[m] = G8_CAT(p0, p1); } } while (0)
#define G8_LDB(dst, b, h) do { _Pragma("unroll") for (int n = 0; n < 2; ++n) { const i32x4v p0 = *(const LAS i32x4v*)(lds + G8_SB(b, h) + boff + n * 2048), p1 = *(const LAS i32x4v*)(lds + G8_SB(b, h) + boff + n * 2048 + boff1); dst[n] = G8_CAT(p0, p1); } } while (0)
#define G8_MMA(ai, bj, At, Bt) do { __builtin_amdgcn_s_setprio(1); _Pragma("unroll") for (int m = 0; m < 4; ++m) _Pragma("unroll") for (int n = 0; n < 2; ++n) { \
        if constexpr (FP8) asm volatile("v_mfma_scale_f32_16x16x128_f8f6f4 %0, %1, %2, %0, %3, %3 op_sel_hi:[0,0,0]" : "+v"(acc[ai][bj][m][n]) : "v"(Bt[n]), "v"(At[m]), "v"(one_scale)); \
        else { acc[ai][bj][m][n] = __builtin_amdgcn_mfma_f32_16x16x32_bf16(G8_LO(Bt[n]), G8_LO(At[m]), acc[ai][bj][m][n], 0, 0, 0); \
               acc[ai][bj][m][n] = __builtin_amdgcn_mfma_f32_16x16x32_bf16(G8_HI(Bt[n]), G8_HI(At[m]), acc[ai][bj][m][n], 0, 0, 0); } } \
        __builtin_amdgcn_s_setprio(0); } while (0)
#define G8_WAIT_V(n) asm volatile("s_waitcnt vmcnt(" #n ")" ::: "memory")
#define G8_WAIT_L(n) asm volatile("s_waitcnt lgkmcnt(" #n ")" ::: "memory")
#define G8_WAIT_VR() do { if (NST > 0 && t == 0 && ui > 0) asm volatile("s_waitcnt vmcnt(%0)" :: "i"(8 + NST) : "memory"); else G8_WAIT_V(8); } while (0)
#define G8_BAR __builtin_amdgcn_s_barrier()
#define G8_SCHED __builtin_amdgcn_sched_barrier(0)
#define G8_AOFFS(dst, u) do { _Pragma("unroll") for (int _h = 0; _h < 2; ++_h) _Pragma("unroll") for (int _i = 0; _i < 2; ++_i) { \
        const unsigned _row = GATHER ? min((unsigned)S.rows(u)[_h * HALF + Rr[_i]], (unsigned)(NTOK - 1)) : (unsigned)(_h * HALF + Rr[_i]); dst[_h][_i] = _row * lda_b + (unsigned)Cc[_i] * 2u; } } while (0)
    Unit cur, nxt; int ui = 0;
    if (!S.next(0, cur)) return;
    f32x4 acc[2][2][4][2];
#pragma unroll
    for (int a = 0; a < 2; ++a)
#pragma unroll
        for (int b = 0; b < 2; ++b)
#pragma unroll
            for (int m = 0; m < 4; ++m)
#pragma unroll
                for (int n = 0; n < 2; ++n) acc[a][b][m][n] = (f32x4){0.f, 0.f, 0.f, 0.f};
    i32x8 At[4], B0[2], B1[2];
    int one_scale = 0x7f7f7f7f; asm volatile("" : "+v"(one_scale));
    const char* cA = cur.a; const char* cB = cur.b;
    G8_AOFFS(voffA, cur);
    if (!GATHER) {
#pragma unroll
        for (int _h = 0; _h < 2; ++_h)
#pragma unroll
            for (int _i = 0; _i < 2; ++_i) voffN[_h][_i] = voffA[_h][_i]; }
    if (G8_SP2) {
        G8_STAGE(G8_SB(0, 0), cB, voffB); G8_STAGE(G8_SB(0, 1), cB + hstepB, voffB); G8_STAGE(G8_SA(0, 0), cA, voffA[0]); G8_STAGE(G8_SA(0, 1), cA, voffA[1]);
        if (wr == 1) G8_BAR;
        G8_WAIT_V(2); G8_BAR;
        G8_STAGE(G8_SB(1, 0), cB + kstep, voffB); G8_STAGE(G8_SA(1, 0), cA + kstep, voffA[0]); G8_STAGE(G8_SB(1, 1), cB + hstepB + kstep, voffB);
        G8_WAIT_V(6); G8_BAR;
    } else {
    G8_STAGE(G8_SB(0, 0), cB, voffB); G8_STAGE(G8_SA(0, 0), cA, voffA[0]); G8_STAGE(G8_SB(0, 1), cB + hstepB, voffB); G8_STAGE(G8_SA(0, 1), cA, voffA[1]);
    if (wr == 1) G8_BAR;
    G8_WAIT_V(4); G8_BAR;
    G8_STAGE(G8_SB(1, 0), cB + kstep, voffB); G8_STAGE(G8_SA(1, 0), cA + kstep, voffA[0]); G8_STAGE(G8_SB(1, 1), cB + hstepB + kstep, voffB);
    G8_WAIT_V(6); G8_BAR;
    }
    for (;;) {
        const bool has_next = S.next(ui + 1, nxt);
        const char* nA = has_next ? nxt.a : cA; const char* nB = has_next ? nxt.b : cB;
        if (GATHER) { if (has_next) { G8_AOFFS(voffN, nxt); } else {
#pragma unroll
            for (int _h = 0; _h < 2; ++_h)
#pragma unroll
                for (int _i = 0; _i < 2; ++_i) voffN[_h][_i] = voffA[_h][_i]; } }
#pragma nounroll
        for (int t = 0; t < nt; t += 2) {
            const bool last = (t == nt - 2);
            const char* a1 = cA + (size_t)(t + 1) * kstep;
            const char* a2 = last ? nA : cA + (size_t)(t + 2) * kstep; const char* b2 = last ? nB : cB + (size_t)(t + 2) * kstep;
            const char* a3 = a2 + kstep; const char* b3 = b2 + kstep;
            unsigned vA0[2], vA1[2];
#pragma unroll
            for (int _i = 0; _i < 2; ++_i) { vA0[_i] = (GATHER && last) ? voffN[0][_i] : voffA[0][_i]; vA1[_i] = (GATHER && last) ? voffN[1][_i] : voffA[1][_i]; }
            if (G8_SP2) {
            G8_LDB(B0, 0, 0); G8_LDB(B1, 0, 1); G8_SCHED; G8_LDA(At, 0, 0); G8_STAGE(G8_SA(1, 1), a1, voffA[1]);
            G8_WAIT_VR(); G8_WAIT_L(0); G8_BAR; G8_MMA(0, 0, At, B0); G8_MMA(0, 1, At, B1); G8_BAR; G8_SCHED;
            G8_LDA(At, 0, 1); G8_STAGE(G8_SB(0, 0), b2, voffB); G8_STAGE(G8_SB(0, 1), b2 + hstepB, voffB); G8_STAGE(G8_SA(0, 0), a2, vA0);
            G8_WAIT_VR(); G8_WAIT_L(0); G8_BAR; G8_MMA(1, 0, At, B0); G8_MMA(1, 1, At, B1); G8_BAR; G8_SCHED;
            G8_LDB(B0, 1, 0); G8_LDB(B1, 1, 1); G8_SCHED; G8_LDA(At, 1, 0); G8_STAGE(G8_SA(0, 1), a2, vA1);
            G8_WAIT_V(8); G8_WAIT_L(0); G8_BAR; G8_MMA(0, 0, At, B0); G8_MMA(0, 1, At, B1); G8_BAR; G8_SCHED;
            G8_LDA(At, 1, 1); G8_STAGE(G8_SB(1, 0), b3, voffB); G8_STAGE(G8_SB(1, 1), b3 + hstepB, voffB); G8_STAGE(G8_SA(1, 0), a3, vA0);
            G8_WAIT_V(8); G8_WAIT_L(0); G8_BAR; G8_MMA(1, 0, At, B0); G8_MMA(1, 1, At, B1); G8_BAR; G8_SCHED;
            } else {
            G8_LDB(B0, 0, 0); G8_SCHED; G8_LDA(At, 0, 0); G8_STAGE(G8_SA(1, 1), a1, voffA[1]);
            G8_WAIT_L(8); G8_BAR; G8_WAIT_L(0); G8_MMA(0, 0, At, B0); G8_BAR; G8_SCHED;
            G8_LDB(B1, 0, 1); G8_STAGE(G8_SB(0, 0), b2, voffB);
            G8_BAR; G8_WAIT_L(0); G8_MMA(0, 1, At, B1); G8_BAR;
            G8_LDA(At, 0, 1); G8_STAGE(G8_SA(0, 0), a2, vA0);
            G8_BAR; G8_WAIT_L(0); G8_MMA(1, 0, At, B0); G8_BAR; G8_SCHED;
            G8_STAGE(G8_SB(0, 1), b2 + hstepB, voffB);
            G8_WAIT_V(6); G8_BAR; G8_MMA(1, 1, At, B1); G8_BAR;
            G8_LDB(B0, 1, 0); G8_SCHED; G8_LDA(At, 1, 0); G8_STAGE(G8_SA(0, 1), a2, vA1);
            G8_WAIT_L(8); G8_BAR; G8_WAIT_L(0); G8_MMA(0, 0, At, B0); G8_BAR; G8_SCHED;
            G8_LDB(B1, 1, 1); G8_STAGE(G8_SB(1, 0), b3, voffB);
            G8_BAR; G8_WAIT_L(0); G8_MMA(0, 1, At, B1); G8_BAR;
            G8_LDA(At, 1, 1); G8_STAGE(G8_SA(1, 0), a3, vA0);
            G8_BAR; G8_WAIT_L(0); G8_MMA(1, 0, At, B0); G8_BAR; G8_SCHED;
            G8_STAGE(G8_SB(1, 1), b3 + hstepB, voffB);
            G8_WAIT_V(6); G8_BAR; G8_MMA(1, 1, At, B1); G8_BAR;
            }
        }
        if (G8_ALIGN_EPI) { if (wr == 0) G8_BAR; }
        asm volatile("" ::: "memory");
        E(acc, cur, wr, wc, fr, fq);
#if PROBE_EPI2
        if (epi_dup<Epi>::v) { asm volatile("" ::: "memory"); E(acc, cur, wr, wc, fr, fq); }
#endif
        if (!has_next) break;
#pragma unroll
        for (int a = 0; a < 2; ++a)
#pragma unroll
            for (int b = 0; b < 2; ++b)
#pragma unroll
                for (int m = 0; m < 4; ++m)
#pragma unroll
                    for (int n = 0; n < 2; ++n) acc[a][b][m][n] = (f32x4){0.f, 0.f, 0.f, 0.f};
        cur = nxt; cA = nA; cB = nB; ++ui;
        if (GATHER) {
#pragma unroll
            for (int _h = 0; _h < 2; ++_h)
#pragma unroll
                for (int _i = 0; _i < 2; ++_i) voffA[_h][_i] = voffN[_h][_i]; }
        if (G8_ALIGN_EPI) { if (wr == 1) G8_BAR; }
    }
    G8_WAIT_V(0);
    if (!G8_ALIGN_EPI) { if (wr == 0) G8_BAR; }
    G8_BAR;
#undef G8_SA
#undef G8_SB
#undef G8_STAGE
#undef G8_LDA
#undef G8_CAT
#undef G8_LO
#undef G8_HI
#undef G8_LDB
#undef G8_MMA
#undef G8_WAIT_V
#undef G8_WAIT_L
#undef G8_WAIT_VR
#undef G8_BAR
#undef G8_SCHED
#undef G8_AOFFS
}
template <class E> struct Epi8 { E e;
    __device__ __forceinline__ void operator()(const f32x4 (&acc)[2][2][4][2], const Unit& u, int wr, int wc, int fr, int fq) const {
#pragma unroll
        for (int ai = 0; ai < 2; ++ai)
#pragma unroll
            for (int m = 0; m < 4; ++m) {
#pragma unroll
                for (int bj = 0; bj < 2; ++bj) e.store8(u, ai * 128 + wr * 64 + m * 16 + fr, bj * 128 + wc * 32 + fq * 8, acc[ai][bj][m][0], acc[ai][bj][m][1]);
                asm volatile("" ::: "memory"); } } };
template <class E> struct Epi4 { E e;
    __device__ __forceinline__ void operator()(const f32x4 (&acc)[2][2][4][2], const Unit& u, int wr, int wc, int fr, int fq) const {
#pragma unroll
        for (int ai = 0; ai < 2; ++ai)
#pragma unroll
            for (int m = 0; m < 4; ++m) {
#pragma unroll
                for (int bj = 0; bj < 2; ++bj)
#pragma unroll
                    for (int n = 0; n < 2; ++n) e.store4(u, ai * 128 + wr * 64 + m * 16 + fr, bj * 128 + wc * 32 + n * 16 + fq * 4, acc[ai][bj][m][n]);
                asm volatile("" ::: "memory"); } } };
struct GridOrder { const char* A; const char* B; size_t tstepA, tstepB; int nM, nN, nwg, G, c;
    __device__ __forceinline__ bool next(int i, Unit& u) const {
        const long L = (long)i * G + c; if (L >= nwg) return false;
        int wgid = (int)L; { const int q = nwg / 8, r = nwg % 8, xcd = wgid % 8, off = wgid / 8; wgid = (xcd < r ? xcd * (q + 1) : r * (q + 1) + (xcd - r) * q) + off; }
        const int nig = 8 * nN, gid = wgid / nig, fm = gid * 8, gsz = (nM - fm) < 8 ? (nM - fm) : 8;
        u.pm = fm + ((wgid % nig) % gsz); u.pn = (wgid % nig) / gsz; u.a = A + (size_t)u.pm * tstepA; u.b = B + (size_t)u.pn * tstepB; u.aux = 0; return true; }
    __device__ __forceinline__ const int* rows(const Unit&) const { return nullptr; } };
}
__device__ __forceinline__ void st_bf8(bf16_t* p, f32x4 a, f32x4 b) { u32x4 w; w.x = pack2(a[0], a[1]); w.y = pack2(a[2], a[3]); w.z = pack2(b[0], b[1]); w.w = pack2(b[2], b[3]); *(u32x4*)p = w; }
__device__ __forceinline__ void ld_bf8(const bf16_t* p, f32x4& a, f32x4& b) { const u32x4 w = *(const u32x4*)p; a = (f32x4){bflo(w.x), bfhi(w.x), bflo(w.y), bfhi(w.y)}; b = (f32x4){bflo(w.z), bfhi(w.z), bflo(w.w), bfhi(w.w)}; }
__device__ __forceinline__ f32x4 sig4(f32x4 z) { return (f32x4){sigmoidf_(z[0]), sigmoidf_(z[1]), sigmoidf_(z[2]), sigmoidf_(z[3])}; }

struct F8Inproj { bf16_t* UA; bf16_t* Z; unsigned char* ZG8;
    __device__ __forceinline__ void operator()(const f32x4 (&acc)[2][2][4][2], const g8::Unit& u, int wr, int wc, int fr, int fq) const {
        const int s0 = u.pm * 256 + wr * 64 + fr, c0 = wc * 32 + fq * 8;
        if (u.pn < 2) {
#pragma unroll
            for (int ai = 0; ai < 2; ++ai)
#pragma unroll
                for (int m = 0; m < 4; ++m) { const int s = s0 + ai * 128 + m * 16, rho = s >> 6, j = s & 63;
#pragma unroll
                    for (int bj = 0; bj < 2; ++bj) { const int c = u.pn * 256 + bj * 128 + c0, g = c >> 4, hi = c & 15;
                        st_bf8(UA + ((size_t)(g * UAROWS + rho) * UALD + j * 16 + hi), acc[ai][bj][m][0], acc[ai][bj][m][1]); }
                    asm volatile("" ::: "memory"); } }
        else if (ZG8_FP8 && u.pn >= (512 + Z6) / 256) { unsigned char* zp = ZG8 + (size_t)s0 * 2048 + (u.pn * 256 + c0 - 512 - Z6);
#pragma unroll
            for (int ai = 0; ai < 2; ++ai)
#pragma unroll
                for (int m = 0; m < 4; ++m) { unsigned char* zr = zp + (size_t)(ai * 128 + m * 16) * 2048;
#pragma unroll
                    for (int bj = 0; bj < 2; ++bj) { const f32x4 v0 = acc[ai][bj][m][0] * ZG8_SCALE, v1 = acc[ai][bj][m][1] * ZG8_SCALE; u32x2 w8; w8.x = pack4_fp8(v0[0], v0[1], v0[2], v0[3]); w8.y = pack4_fp8(v1[0], v1[1], v1[2], v1[3]);
                        *(u32x2*)(zr + bj * 128) = w8; } } }
        else { bf16_t* zp = Z + (size_t)s0 * ZC + (u.pn * 256 + c0 - 512);
#pragma unroll
            for (int ai = 0; ai < 2; ++ai)
#pragma unroll
                for (int m = 0; m < 4; ++m) { bf16_t* zr = zp + (size_t)(ai * 128 + m * 16) * ZC;
                    st_bf8(zr, acc[ai][0][m][0], acc[ai][0][m][1]); st_bf8(zr + 128, acc[ai][1][m][0], acc[ai][1][m][1]); } }
    } };
struct F8S5E { float* E;
    __device__ __forceinline__ void store4(const g8::Unit& u, int rl, int cl, f32x4 v) const { const int rho = u.pm * 256 + rl; if (rho < NCHUNK) *(f32x4*)(E + ((size_t)(u.aux * UAROWS + rho) * 256 + cl)) = v; } };
struct F8S5Y { bf16_t* Z5;
    __device__ __forceinline__ void store8(const g8::Unit& u, int rl, int cl, f32x4 v0, f32x4 v1) const { const int rho = u.pm * 256 + rl; if (rho < NCHUNK) { const int col = u.pn * 256 + cl, j = col >> 4, ho = col & 15;
        f32x4 a, b;
#pragma unroll
        for (int k = 0; k < 4; ++k) { a[k] = gelu_tanh(v0[k]); b[k] = gelu_tanh(v1[k]); }
        st_bf8(Z5 + ((size_t)(rho * 64 + j) * 512 + u.aux * 16 + ho), a, b); } } };
struct F8Glu { const bf16_t* Z5; bf16_t* Y;
    __device__ __forceinline__ void store8(const g8::Unit& u, int rl, int cl, f32x4 v0, f32x4 v1) const { const size_t r = u.pm * 256 + rl; const int c = u.pn * 256 + cl; f32x4 z0, z1; ld_bf8(Z5 + r * 512 + c, z0, z1);
        st_bf8(Y + r * DM + c, z0 * sig4(v0), z1 * sig4(v1)); } };
struct F8Up5 { const bf16_t* Z; bf16_t* Mb; const unsigned char* ZG8;
    __device__ __forceinline__ void store8(const g8::Unit& u, int rl, int cl, f32x4 v0, f32x4 v1) const { const size_t r = u.pm * 256 + rl; const int c = u.pn * 256 + cl; f32x4 z0, z1;
        if (ZG8_FP8) { const u32x2 w = *(const u32x2*)(ZG8 + r * 2048 + c); z0 = up4_fp8(w.x) * (1.0f / ZG8_SCALE); z1 = up4_fp8(w.y) * (1.0f / ZG8_SCALE); } else ld_bf8(Z + r * ZC + Z6 + c, z0, z1);
        st_bf8(Mb + r * DM + c, sig4(z0) * v0, sig4(z1) * v1); } };
struct F8Uph { const bf16_t* Z; bf16_t* Mb; bf16_t* Mo; const unsigned char* ZG8;
    __device__ __forceinline__ void store8(const g8::Unit& u, int rl, int cl, f32x4 v0, f32x4 v1) const { const size_t r = u.pm * 256 + rl; const int c = u.pn * 256 + cl; f32x4 z0, z1, p0, p1;
        if (ZG8_FP8) { const u32x2 w = *(const u32x2*)(ZG8 + r * 2048 + (Z7 - Z6) + c); z0 = up4_fp8(w.x) * (1.0f / ZG8_SCALE); z1 = up4_fp8(w.y) * (1.0f / ZG8_SCALE); } else ld_bf8(Z + r * ZC + Z7 + c, z0, z1);
        ld_bf8(Mb + r * DM + c, p0, p1);
        st_bf8(Mo + r * DM + c, p0 + sig4(z0) * v0, p1 + sig4(z1) * v1); } };
struct F8Out { bf16_t* XF; const float* modl; int odd;
    __device__ __forceinline__ void operator()(const f32x4 (&acc)[2][2][4][2], const g8::Unit& u, int wr, int wc, int fr, int fq) const {
        const int s0 = u.pm * 256 + wr * 64 + fr, c0 = u.pn * 256 + wc * 32 + fq * 8;
        const int mb = u.pm < NLAT / 256 ? (u.pm >> 6) : 2;
        const float* gp = modl + mb * NMOD + 2 * DM + c0; f32x4 g[2][2];
#pragma unroll
        for (int bj = 0; bj < 2; ++bj) { g[bj][0] = *(const f32x4*)(gp + bj * 128); g[bj][1] = *(const f32x4*)(gp + bj * 128 + 4); }
#pragma unroll
        for (int ai = 0; ai < 2; ++ai)
#pragma unroll
            for (int m = 0; m < 4; ++m) { const int r = sigma_inv(s0 + ai * 128 + m * 16, odd); bf16_t* xp = XF + (size_t)r * DM + c0;
#pragma unroll
                for (int bj = 0; bj < 2; ++bj) { f32x4 x0, x1; ld_bf8(xp + bj * 128, x0, x1); x0 += g[bj][0] * acc[ai][bj][m][0]; x1 += g[bj][1] * acc[ai][bj][m][1];
                    st_bf8(xp + bj * 128, x0, x1); }
                if (m & 1) asm volatile("" ::: "memory"); }
    } };
constexpr float M2S = MOE2_FP8 ? 1.0f / (FP8_WSCALE * FP8_ASCALE) : 1.0f;
#ifndef OUT2_FP8
#define OUT2_FP8 1
#endif
constexpr float OUT2_SCALE = 32.0f;

struct F8Moe2 { bf16_t* O; const float* b2; const float* rgate; const int* ps;
    __device__ __forceinline__ void operator()(const f32x4 (&acc)[2][2][4][2], const g8::Unit& u, int wr, int wc, int fr, int fq) const {
        const size_t r0 = (size_t)u.pm * 256 + wr * 64 + fr; const int c0 = u.pn * 256 + wc * 32 + fq * 8;
        const float* bp = b2 + (size_t)u.aux * 1024 + c0; f32x4 b[2][2];
#pragma unroll
        for (int bj = 0; bj < 2; ++bj) { b[bj][0] = *(const f32x4*)(bp + bj * 128); b[bj][1] = *(const f32x4*)(bp + bj * 128 + 4); }
        float gt[2][4]; const float* gr = rgate + (size_t)u.aux * NTOK + (u.pm * 256 - ps[u.aux]) + wr * 64 + fr;
#pragma unroll
        for (int ai = 0; ai < 2; ++ai)
#pragma unroll
            for (int m = 0; m < 4; ++m) gt[ai][m] = gr[ai * 128 + m * 16];
#pragma unroll
        for (int ai = 0; ai < 2; ++ai)
#pragma unroll
            for (int m = 0; m < 4; ++m) { bf16_t* op = O + (r0 + ai * 128 + m * 16) * DM + c0; const float g = gt[ai][m] * (OUT2_FP8 ? OUT2_SCALE : 1.0f);
#pragma unroll
                for (int bj = 0; bj < 2; ++bj) { const f32x4 v0 = (acc[ai][bj][m][0] * M2S + b[bj][0]) * g, v1 = (acc[ai][bj][m][1] * M2S + b[bj][1]) * g;
                    if (OUT2_FP8) { u32x2 w8; w8.x = pack4_fp8(v0[0], v0[1], v0[2], v0[3]); w8.y = pack4_fp8(v1[0], v1[1], v1[2], v1[3]);
                        *(u32x2*)((unsigned char*)O + (r0 + ai * 128 + m * 16) * DM + c0 + bj * 128) = w8; }
                    else st_bf8(op + bj * 128, v0, v1); } }
    } };
struct F8Moe1 { bf16_t* ACT; const float* b1;
    __device__ __forceinline__ void operator()(const f32x4 (&acc)[2][2][4][2], const g8::Unit& u, int wr, int wc, int fr, int fq) const {
        typedef float f32x2 __attribute__((ext_vector_type(2)));
        constexpr float SC = 1.0f / (FP8_WSCALE * FP8_ASCALE), AS = MOE2_FP8 ? FP8_ASCALE : 1.0f;
        const int ch = u.pn * 128 + wc * 32 + fq * 8; const float* bp = b1 + (size_t)u.aux * 2048 + ch; f32x4 bg[2], bu[2];
#pragma unroll
        for (int n = 0; n < 2; ++n) { bg[n] = *(const f32x4*)(bp + n * 4); bu[n] = (*(const f32x4*)(bp + 1024 + n * 4) + 1.0f) * AS; }
        bf16_t* ap = ACT + ((size_t)u.pm * 256 + wr * 64 + fr) * DM + ch;
#pragma unroll
        for (int ai = 0; ai < 2; ++ai)
#pragma unroll
            for (int m = 0; m < 4; ++m) { f32x2 o[2][2];
#pragma unroll
                for (int n = 0; n < 2; ++n)
#pragma unroll
                    for (int q = 0; q < 2; ++q) { const f32x2 ag = {acc[ai][0][m][n][2 * q], acc[ai][0][m][n][2 * q + 1]}, au = {acc[ai][1][m][n][2 * q], acc[ai][1][m][n][2 * q + 1]};
                        const f32x2 bg2 = {bg[n][2 * q], bg[n][2 * q + 1]}, bu2 = {bu[n][2 * q], bu[n][2 * q + 1]};
                        f32x2 g = ag * SC + bg2, uu = au * (SC * AS) + bu2;
                        g.x = fminf(g.x, 7.0f); g.y = fminf(g.y, 7.0f); uu.x = __builtin_amdgcn_fmed3f(uu.x, -6.0f * AS, 8.0f * AS); uu.y = __builtin_amdgcn_fmed3f(uu.y, -6.0f * AS, 8.0f * AS);
                        const f32x2 t = g * (-1.702f * 1.4426950408889634f); f32x2 e = {__builtin_amdgcn_exp2f(t.x), __builtin_amdgcn_exp2f(t.y)}; e = e + 1.0f;
                        const f32x2 r = {__builtin_amdgcn_rcpf(e.x), __builtin_amdgcn_rcpf(e.y)};
                        o[n][q] = g * r * uu; }
                if (MOE2_FP8) { u32x2 w8; unsigned w = 0u;
                    w = __builtin_amdgcn_cvt_pk_fp8_f32(o[0][0].x, o[0][0].y, w, false); w = __builtin_amdgcn_cvt_pk_fp8_f32(o[0][1].x, o[0][1].y, w, true); w8.x = w; w = 0u;
                    w = __builtin_amdgcn_cvt_pk_fp8_f32(o[1][0].x, o[1][0].y, w, false); w = __builtin_amdgcn_cvt_pk_fp8_f32(o[1][1].x, o[1][1].y, w, true); w8.y = w;
                    *(u32x2*)((unsigned char*)ACT + ((size_t)u.pm * 256 + wr * 64 + fr + ai * 128 + m * 16) * DM + ch) = w8; }
                else st_bf8(ap + (size_t)(ai * 128 + m * 16) * DM, (f32x4){o[0][0].x, o[0][0].y, o[0][1].x, o[0][1].y}, (f32x4){o[1][0].x, o[1][0].y, o[1][1].x, o[1][1].y}); }
    } };
template <> struct epi_nst<F8Inproj> { static constexpr int v = 16; };
template <> struct epi_nst<g8::Epi8<F8Glu>> { static constexpr int v = 16; };
template <> struct epi_nst<g8::Epi8<F8Up5>> { static constexpr int v = 16; };
template <> struct epi_nst<g8::Epi8<F8Uph>> { static constexpr int v = 16; };
template <> struct epi_nst<F8Out> { static constexpr int v = 16; };
template <> struct epi_nst<F8Moe1> { static constexpr int v = 8; };
template <> struct epi_nst<F8Moe2> { static constexpr int v = 16; };
struct S5Order { const char* A; const char* B; size_t gstepA, gstepB; unsigned lda_b, ldb_b; int MT, NT, G, c;
    __device__ __forceinline__ bool next(int i, g8::Unit& u) const { int g, r;
        if ((G & 7) == 0) { const int x = c & 7, per = G >> 3, e = i * per + (per - 1 - (c >> 3)); if (e >= 4 * MT * NT) return false; g = x + 8 * (e / (MT * NT)); r = e % (MT * NT); }
        else { const int L = i * G + (G - 1 - c); if (L >= S5G * MT * NT) return false; g = L / (MT * NT); r = L % (MT * NT); }
        const int mt = r / NT, nt = r % NT;
        u.pm = mt; u.pn = nt; u.aux = g; u.a = A + (size_t)g * gstepA + (size_t)mt * 256 * lda_b; u.b = B + (size_t)g * gstepB + (size_t)nt * 256 * ldb_b; return true; }
    __device__ __forceinline__ const int* rows(const g8::Unit&) const { return nullptr; } };
struct MoeOrder { const char* A; const char* B; const int* rowtok; const int* te; unsigned estepB; int NT, ntile, G, c; bool gather; unsigned tstepB = 256 * DM * 2;
    __device__ __forceinline__ bool next(int i, g8::Unit& u) const { const int x = c & 7, slot = c >> 3; int t, pn;
        if (G != 256) { const int L = i * G + c; t = L / NT; pn = L % NT; } else if (NT == 4) { t = i * 64 + x * 8 + (slot >> 2); pn = slot & 3; } else { t = i * 32 + (x >> 1) * 8 + (slot >> 2); pn = (x & 1) * 4 + (slot & 3); }
        if (t >= ntile) return false; const int e = te[t];
        u.pm = t; u.pn = pn; u.aux = e; u.a = gather ? A : A + (size_t)t * tstepB; u.b = B + (size_t)e * estepB + (size_t)pn * tstepB; return true; }
    __device__ __forceinline__ const int* rows(const g8::Unit& u) const { return rowtok + (size_t)u.aux * NTOK + (u.pm * 256 - te[u.aux - 64]); } };

template <bool WIDE = false>
__device__ __forceinline__ void norm_mod_row(f32x4 (&x)[4], const float* g, const float* shift, const float* scale, int lane) {
    float ss = 0.f;
#pragma unroll
    for (int k = 0; k < 4; ++k) ss += x[k][0] * x[k][0] + x[k][1] * x[k][1] + x[k][2] * x[k][2] + x[k][3] * x[k][3];
    ss = wave_sum(ss);
    const float rstd = rsqrtf(ss * (1.0f / DM) + EPS);
#pragma unroll
    for (int k = 0; k < 4; ++k) { const int c = WIDE ? lane * 16 + k * 4 : lane * 4 + k * 256; const f32x4 gg = *(const f32x4*)(g + c), sh = *(const f32x4*)(shift + c), sc = *(const f32x4*)(scale + c);
        x[k] = x[k] * rstd * gg * (sc + 1.0f) + sh; }
}

typedef float2 c32;
constexpr int S5T_PW = 2 * 64 * 65, S5T_BB = 2 * 64 * 16, S5T_CC = 2 * 16 * 64, S5T_ALL = S5T_PW + S5T_BB + S5T_CC;
static __device__ __forceinline__ void s5_stage1(unsigned char* ws, const float* const* tab, unsigned char* lds_g, int l, int g) {
    c32* pw = (c32*)lds_g;
    c32* bb = pw + S5T_PW;
    c32* cc = bb + S5T_BB;
    const int tid = ltid();
    const float* a_re = tab[I_ARE]; const float* a_im = tab[I_AIM]; const float* ldt = tab[I_LOGDT];
    for (int idx = tid; idx < S5T_PW; idx += NTHREADS) { const int n = idx % 65, p = (idx / 65) & 63, d = idx / (65 * 64);
        const int gi = (l * 2 + d) * S5G + g; const double are = a_re[gi * 64 + p], aim = a_im[gi * 64 + p], dt = exp((double)ldt[gi]);
        const double mag = exp(are * dt * n), ang = aim * dt * n; pw[idx] = make_float2((float)(mag * cos(ang)), (float)(mag * sin(ang))); }
    for (int idx = tid; idx < S5T_BB; idx += NTHREADS) { const int hi = idx & 15, p = (idx >> 4) & 63, d = idx >> 10;
        const int gi = (l * 2 + d) * S5G + g; const double are = a_re[gi * 64 + p], aim = a_im[gi * 64 + p], dt = exp((double)ldt[gi]);
        const double mag = exp(are * dt), lbr = mag * cos(aim * dt), lbi = mag * sin(aim * dt), den = are * are + aim * aim, nr = lbr - 1.0;
        const double qr = (nr * are + lbi * aim) / den, qi = (lbi * are - nr * aim) / den;
        const double br = tab[I_BRE][(size_t)(gi * 64 + p) * 16 + hi], bi = tab[I_BIM][(size_t)(gi * 64 + p) * 16 + hi];
        bb[idx] = make_float2((float)(qr * br - qi * bi), (float)(qr * bi + qi * br)); }
    for (int idx = tid; idx < S5T_CC; idx += NTHREADS) { const int p = idx & 63, ho = (idx >> 6) & 15, d = idx >> 10;
        const int gi = (l * 2 + d) * S5G + g; cc[idx] = make_float2(tab[I_CRE][(size_t)(gi * 16 + ho) * 64 + p], tab[I_CIM][(size_t)(gi * 16 + ho) * 64 + p]); }
    __syncthreads();
    c32* gsc = (c32*)(ws + WS_S5T) + (size_t)(l * S5G + g) * S5T_ALL;
    for (int idx = tid; idx < S5T_ALL; idx += NTHREADS) gsc[idx] = pw[idx];
    if (tid < 128) { const int d = tid >> 6, p = tid & 63; ((c32*)(ws + WS_LAMT))[((l * 2 + d) * S5G + g) * 64 + p] = pw[(d * 64 + p) * 65 + 64]; }
    { const int hi = tid & 15, ho = (tid >> 4) & 15, d = tid >> 8; float gr[64], gim[64];
#pragma unroll
      for (int p = 0; p < 64; ++p) { const c32 c = cc[(d * 16 + ho) * 64 + p], b = bb[(d * 64 + p) * 16 + hi]; gr[p] = c.x * b.x - c.y * b.y; gim[p] = c.x * b.y + c.y * b.x; }
      float* KT = (float*)(ws + WS_KT) + (size_t)(l * S5G + g) * 2 * 64 * 256 + d * 64 * 256 + ho * 16 + hi;
      for (int dl = 0; dl < 64; ++dl) { float s = 0.f;
#pragma unroll
          for (int p = 0; p < 64; ++p) { const c32 w = pw[(d * 64 + p) * 65 + dl]; s += gr[p] * w.x - gim[p] * w.y; if ((p & 15) == 15) asm volatile("" ::: "memory"); }
          KT[dl * 256] = s; } }
    __syncthreads();
}
static __device__ __forceinline__ void s5_stage2(unsigned char* ws, const float* const* tab, unsigned char* lds_g, int l, int g, int rq) {
    c32* pw = (c32*)lds_g; c32* bb = pw + S5T_PW; c32* cc = bb + S5T_BB;
    const int tid = ltid();
    const c32* gsc = (const c32*)(ws + WS_S5T) + (size_t)(l * S5G + g) * S5T_ALL;
    for (int idx = tid; idx < S5T_ALL; idx += NTHREADS) pw[idx] = gsc[idx];
    __syncthreads();
    const float* KT = (const float*)(ws + WS_KT) + (size_t)(l * S5G + g) * 2 * 64 * 256;
    const float* dsk = tab[I_S5D] + l * 512 + g * 16;
    bf16_t* BT2 = (bf16_t*)(ws + WS_BT2) + (size_t)(l * S5G + g) * 1024 * UALD;
    for (int ck = tid; ck < 256 * 160; ck += NTHREADS) { const int row = rq * 256 + ck / 160, c8 = ck % 160, j = row >> 4, ho = row & 15; float v[8];
        if (c8 < 128) { const int i = c8 >> 1, hi0 = (c8 & 1) * 8;
#pragma unroll
            for (int q = 0; q < 8; ++q) v[q] = 0.f;
            if (j >= i) { const f32x4 a = *(const f32x4*)(KT + ((0 * 64 + (j - i)) * 16 + ho) * 16 + hi0), b = *(const f32x4*)(KT + ((0 * 64 + (j - i)) * 16 + ho) * 16 + hi0 + 4);
#pragma unroll
                for (int q = 0; q < 4; ++q) { v[q] += a[q]; v[4 + q] += b[q]; } }
            if (i >= j) { const f32x4 a = *(const f32x4*)(KT + ((1 * 64 + (i - j)) * 16 + ho) * 16 + hi0), b = *(const f32x4*)(KT + ((1 * 64 + (i - j)) * 16 + ho) * 16 + hi0 + 4);
#pragma unroll
                for (int q = 0; q < 4; ++q) { v[q] += a[q]; v[4 + q] += b[q]; } }
            if (i == j) {
#pragma unroll
                for (int q = 0; q < 8; ++q) if (hi0 + q == ho) v[q] += dsk[ho]; } }
        else { const int kap0 = (c8 - 128) * 8, d = kap0 >> 7, ri = (kap0 >> 6) & 1, p0 = kap0 & 63, n = d == 0 ? j + 1 : 64 - j;
#pragma unroll
            for (int q = 0; q < 8; ++q) { const int p = p0 + q; const c32 c = cc[(d * 16 + ho) * 64 + p], w = pw[(d * 64 + p) * 65 + n];
                const float re = c.x * w.x - c.y * w.y, im = c.x * w.y + c.y * w.x; v[q] = ri == 0 ? re : -im; } }
        u32x4 o; o.x = pack2(v[0], v[1]); o.y = pack2(v[2], v[3]); o.z = pack2(v[4], v[5]); o.w = pack2(v[6], v[7]);
        *(u32x4*)(BT2 + (size_t)row * UALD + c8 * 8) = o; }
    bf16_t* BT1 = (bf16_t*)(ws + WS_BT1) + (size_t)(l * S5G + g) * 256 * 1024;
    for (int ck = tid; ck < 64 * 128; ck += NTHREADS) { const int kap = rq * 64 + (ck >> 7), c8 = ck & 127, d = kap >> 7, ri = (kap >> 6) & 1, p = kap & 63, i = c8 >> 1, hi0 = (c8 & 1) * 8;
        const int n = d == 0 ? 63 - i : i; const c32 w = pw[(d * 64 + p) * 65 + n]; float v[8];
#pragma unroll
        for (int q = 0; q < 8; ++q) { const c32 b = bb[(d * 64 + p) * 16 + hi0 + q]; const float re = w.x * b.x - w.y * b.y, im = w.x * b.y + w.y * b.x; v[q] = ri == 0 ? re : im; }
        u32x4 o; o.x = pack2(v[0], v[1]); o.y = pack2(v[2], v[3]); o.z = pack2(v[4], v[5]); o.w = pack2(v[6], v[7]);
        *(u32x4*)(BT1 + (size_t)kap * 1024 + c8 * 8) = o; }
    __syncthreads();
}

constexpr int CVP = 66;
template <int MAPW1>
__device__ __forceinline__ void conv_run(unsigned char* lds_g, const float* src, int K, int N, bf16_t* dst, int R0, int k0, int nst) {
    const int tid = ltid(), lane = tid & 63, w = tid >> 6;
    const int n4 = (w & 3) * 16 + (lane & 15), kpl = (lane >> 4) + 4 * (w >> 2);
    const int Rl = 4 * n4; const int R = R0 + Rl;
    const int sc = MAPW1 ? ((Rl & 128) ? 1024 : 0) + (R0 >> 8) * 128 + (Rl & 127) : R;
    const float* sp = src + (size_t)(k0 + 2 * kpl) * N + sc;
    f32x4 A[8], B[8];
#define CV_LOAD(X, kt) do { _Pragma("unroll") for (int p = 0; p < 4; ++p) { const float* q = sp + (size_t)((kt) * 64 + 16 * p) * N; X[2 * p] = *(const f32x4*)q; X[2 * p + 1] = *(const f32x4*)(q + N); } } while (0)
#define CV_EMIT(X, kt, buf) do { unsigned* T = (unsigned*)(lds_g + (buf) * 256 * CVP * 2); \
        _Pragma("unroll") for (int p = 0; p < 4; ++p) _Pragma("unroll") for (int i = 0; i < 4; ++i) T[(Rl + i) * (CVP / 2) + kpl + 8 * p] = pack2(X[2 * p][i], X[2 * p + 1][i]); \
        __syncthreads(); \
        _Pragma("unroll") for (int j = 0; j < 4; ++j) { const int piece = tid + j * 512, n = piece >> 3, c = piece & 7; const unsigned* tp = T + n * (CVP / 2) + c * 4; \
            u32x4 o; o.x = tp[0]; o.y = tp[1]; o.z = tp[2]; o.w = tp[3]; *(u32x4*)(dst + (size_t)(R0 + n) * K + k0 + (kt) * 64 + c * 8) = o; } } while (0)
    CV_LOAD(A, 0);
    for (int kt = 0; kt < nst; kt += 2) {
        if (kt + 1 < nst) CV_LOAD(B, kt + 1);
        CV_EMIT(A, kt, 0);
        if (kt + 1 < nst) { if (kt + 2 < nst) CV_LOAD(A, kt + 2); CV_EMIT(B, kt + 1, 1); }
    }
    __syncthreads();
#undef CV_LOAD
#undef CV_EMIT
}

template <int MAPW1>
__device__ __forceinline__ void conv_run8(unsigned char* lds_g, const float* src, int K, int N, unsigned char* dst, int R0, int k0, int nst) {
    const int tid = ltid(), lane = tid & 63, w = tid >> 6;
    const int n4 = (w & 3) * 16 + (lane & 15), kql = (lane >> 4) + 4 * (w >> 2);
    const int Rl = 4 * n4;
    const int sc = MAPW1 ? ((Rl & 128) ? 1024 : 0) + (R0 >> 8) * 128 + (Rl & 127) : R0 + Rl;
    const float* sp = src + (size_t)(k0 + 4 * kql) * N + sc;
    f32x4 A[8], B[8];
#define CV8_LOAD(X, kt) do { _Pragma("unroll") for (int p = 0; p < 2; ++p) _Pragma("unroll") for (int q = 0; q < 4; ++q) X[4 * p + q] = *(const f32x4*)(sp + (size_t)((kt) * 64 + 32 * p + q) * N); } while (0)
#define CV8_EMIT(X, kt, buf) do { unsigned* T = (unsigned*)(lds_g + (buf) * 256 * 17 * 4); \
        _Pragma("unroll") for (int p = 0; p < 2; ++p) _Pragma("unroll") for (int i = 0; i < 4; ++i) \
            T[(Rl + i) * 17 + kql + 8 * p] = pack4_fp8(X[4 * p][i] * FP8_WSCALE, X[4 * p + 1][i] * FP8_WSCALE, X[4 * p + 2][i] * FP8_WSCALE, X[4 * p + 3][i] * FP8_WSCALE); \
        __syncthreads(); \
        _Pragma("unroll") for (int j = 0; j < 2; ++j) { const int piece = tid + j * 512, n = piece >> 2, c = piece & 3; const unsigned* tp = T + n * 17 + c * 4; \
            u32x4 o; o.x = tp[0]; o.y = tp[1]; o.z = tp[2]; o.w = tp[3]; *(u32x4*)(dst + (size_t)(R0 + n) * K + k0 + (kt) * 64 + c * 16) = o; } } while (0)
    CV8_LOAD(A, 0);
    for (int kt = 0; kt < nst; kt += 2) {
        if (kt + 1 < nst) CV8_LOAD(B, kt + 1);
        CV8_EMIT(A, kt, 0);
        if (kt + 1 < nst) { if (kt + 2 < nst) CV8_LOAD(A, kt + 2); CV8_EMIT(B, kt + 1, 1); }
    }
    __syncthreads();
#undef CV8_LOAD
#undef CV8_EMIT
}

constexpr int CVK = 4;
constexpr int PQ_S5 = DEPTH * S5G, PQ_MOD = DEPTH * 96;
constexpr int CVI_WIN = (NIN / 256) * (DM / 64 / CVK), CVI_GLU = 2 * (512 / 64 / CVK), CVI_UP = 4 * (512 / 64 / CVK), CVI_OUT = 4 * (1024 / 64 / CVK);
constexpr int CVI_LAYER = CVI_WIN + CVI_GLU + 2 * CVI_UP + CVI_OUT;
constexpr int CVI_W1 = 8 * (1024 / 64 / CVK), CVI_W2 = 4 * (1024 / 64 / CVK);
constexpr int PQ_CONV = CVI_LAYER + NE * (CVI_W1 + CVI_W2);
constexpr int PQ_XF = NTOK / 256, PQ_LB = 1;
constexpr int PQ_TOTAL = PQ_S5 + PQ_MOD + PQ_CONV + PQ_XF + PQ_LB;

constexpr int CVI_PER_LAYER = CVI_LAYER + NE * (CVI_W1 + CVI_W2);
static __device__ __forceinline__ void conv_item(unsigned char* ws, const float* const* tab, unsigned char* lds_g, int l, int w) {
    if (w < CVI_WIN) { conv_run<0>(lds_g, tab[I_WIN] + (size_t)l * DM * NIN, DM, NIN, (bf16_t*)(ws + WS_WIN) + (size_t)l * NIN * DM, (w >> 2) * 256, (w & 3) * 64 * CVK, CVK); return; }
    w -= CVI_WIN;
    if (w < CVI_GLU) { conv_run<0>(lds_g, tab[I_WGLU] + (size_t)l * 512 * 512, 512, 512, (bf16_t*)(ws + WS_WGLU) + (size_t)l * 512 * 512, (w >> 1) * 256, (w & 1) * 64 * CVK, CVK); return; }
    w -= CVI_GLU;
    if (w < CVI_UP) { conv_run<0>(lds_g, tab[I_WUP5] + (size_t)l * 512 * 1024, 512, 1024, (bf16_t*)(ws + WS_WUP5) + (size_t)l * 1024 * 512, (w >> 1) * 256, (w & 1) * 64 * CVK, CVK); return; }
    w -= CVI_UP;
    if (w < CVI_UP) { conv_run<0>(lds_g, tab[I_WUPH] + (size_t)l * 512 * 1024, 512, 1024, (bf16_t*)(ws + WS_WUPH) + (size_t)l * 1024 * 512, (w >> 1) * 256, (w & 1) * 64 * CVK, CVK); return; }
    w -= CVI_UP;
    if (w < CVI_OUT) { conv_run<0>(lds_g, tab[I_WOUT] + (size_t)l * 1024 * 1024, 1024, 1024, (bf16_t*)(ws + WS_WOUT) + (size_t)l * 1024 * 1024, (w >> 2) * 256, (w & 3) * 64 * CVK, CVK); return; }
    w -= CVI_OUT;
    const int le = l * NE + w / (CVI_W1 + CVI_W2); w = w % (CVI_W1 + CVI_W2);
    if (w < CVI_W1) { if (MOE1_FP8) conv_run8<1>(lds_g, tab[I_W1] + (size_t)le * 1024 * 2048, 1024, 2048, (unsigned char*)(ws + WS_W1) + (size_t)le * 2048 * 1024, (w >> 2) * 256, (w & 3) * 64 * CVK, CVK);
        else conv_run<1>(lds_g, tab[I_W1] + (size_t)le * 1024 * 2048, 1024, 2048, (bf16_t*)(ws + WS_W1) + (size_t)le * 2048 * 1024, (w >> 2) * 256, (w & 3) * 64 * CVK, CVK); }
    else { w -= CVI_W1; if (MOE2_FP8) conv_run8<0>(lds_g, tab[I_W2] + (size_t)le * 1024 * 1024, 1024, 1024, (unsigned char*)(ws + WS_W2) + (size_t)le * 1024 * 1024, (w >> 2) * 256, (w & 3) * 64 * CVK, CVK);
        else conv_run<0>(lds_g, tab[I_W2] + (size_t)le * 1024 * 1024, 1024, 1024, (bf16_t*)(ws + WS_W2) + (size_t)le * 1024 * 1024, (w >> 2) * 256, (w & 3) * 64 * CVK, CVK); }
}
static __device__ __forceinline__ void conv_steal(unsigned char* ws, const float* const* tab, unsigned char* lds_g, int L, int nmax) {
    int* wq = (int*)(lds_g + LDS_BYTES - 64);
    unsigned* ctr = (unsigned*)(ws + WS_CTL) + CW_WQ2 + (L * 8) * 64;
    int x = lbid() & 7, tries = 0;
    for (int n = 0; n < nmax && tries < 8; ) {
        __syncthreads();
        if (ltid() == 0) *wq = (int)atomicAdd(ctr + x * 64, 1u);
        __syncthreads();
        const int v = *wq * 8 + x;
        if (v >= CVI_PER_LAYER) { x = (x + 1) & 7; ++tries; if (nmax < 8) break; continue; }
        conv_item(ws, tab, lds_g, L, v); ++n;
    }
    __syncthreads();
}
static __device__ __forceinline__ void phase_prologue(unsigned char* ws, const float* const* tab, unsigned char* lds_g, int qslot) {
    const int tid = ltid(), lane = tid & 63, wid = tid >> 6;
    float* lsf = (float*)lds_g;
    int* wq = (int*)(lds_g + LDS_BYTES - 64);
    unsigned* ctr = (unsigned*)(ws + WS_CTL) + CW_WQ + 64 * (qslot ? 5 : 0);
    for (;;) {
        __syncthreads();
        if (tid == 0) *wq = (int)atomicAdd(ctr, 1u);
        __syncthreads();
        int v = *wq;
        if (v >= PQ_TOTAL) break;
        if (v < PQ_S5) { s5_stage1(ws, tab, lds_g, v / S5G, v % S5G); continue; }
        v -= PQ_S5;
        if (v < PQ_MOD) {
            const int l = v / 96, j = (v % 96) * 64 + (tid & 63), ks = tid >> 6;
            const float* mw = tab[I_MODW] + (size_t)l * DM * NMOD; float a0 = 0.f, a1 = 0.f, a2 = 0.f;
#pragma unroll 8
            for (int k = ks * 128; k < ks * 128 + 128; ++k) { const float w = mw[(size_t)k * NMOD + j]; const float c0 = tab[I_C][k], c1 = tab[I_C][DM + k], c2 = tab[I_CCTX][k];
                a0 += c0 * sigmoidf_(c0) * w; a1 += c1 * sigmoidf_(c1) * w; a2 += c2 * sigmoidf_(c2) * w; }
            lsf[(ks * 3 + 0) * 64 + (tid & 63)] = a0; lsf[(ks * 3 + 1) * 64 + (tid & 63)] = a1; lsf[(ks * 3 + 2) * 64 + (tid & 63)] = a2;
            __syncthreads();
            if (tid < 192) { const int r = tid >> 6, c = tid & 63; float s = 0.f;
#pragma unroll
                for (int k = 0; k < 8; ++k) s += lsf[(k * 3 + r) * 64 + c];
                const int jj = (v % 96) * 64 + c; ((float*)(ws + WS_MOD))[(size_t)(l * 3 + r) * NMOD + jj] = s + tab[I_MODB][l * NMOD + jj]; }
            continue; }
        v -= PQ_MOD;
        if (v < PQ_CONV) { conv_item(ws, tab, lds_g, 0, v); continue; }
        v -= PQ_CONV;
        if (v < PQ_XF) {
#pragma unroll 4
            for (int rr = 0; rr < 32; ++rr) { const int r = v * 256 + rr * 8 + wid; const float* sp = r < NLAT ? tab[I_X] + (size_t)r * DM : tab[I_CTX] + (size_t)(r - NLAT) * DM;
#pragma unroll
                for (int k = 0; k < 4; ++k) st_bf4((bf16_t*)(ws + WS_XF) + (size_t)r * DM + lane * 4 + k * 256, *(const f32x4*)(sp + lane * 4 + k * 256)); }
            continue; }
        {
#pragma unroll
            for (int hh = 0; hh < 2; ++hh) { const int idx = hh * 512 + tid, d = idx >> 9, ch = idx & 511; const float* lg = tab[I_LBL] + (size_t)d * (DEPTH + 1) * 512 + ch;
                float e[DEPTH + 1], mx = -1e30f, s = 0.f;
#pragma unroll
                for (int k = 0; k <= DEPTH; ++k) { e[k] = lg[k * 512]; mx = fmaxf(mx, e[k]); }
#pragma unroll
                for (int k = 0; k <= DEPTH; ++k) { e[k] = expf(e[k] - mx); s += e[k]; }
                float cum = 0.f;
#pragma unroll
                for (int k = 0; k < DEPTH; ++k) { cum += e[k] / s; ((float*)(ws + WS_LB))[(d * DEPTH + k) * 512 + ch] = cum; } } }
    }
}

static __device__ __forceinline__ void phase_norm1(unsigned char* ws, const float* const* tab, unsigned char* lds_g, int l) {
    if (l == 0) for (int u = lbid(); u < DEPTH * S5G * 4; u += gridDim.x) s5_stage2(ws, tab, lds_g, u / (S5G * 4), (u >> 2) & (S5G - 1), u & 3);
    const int tid = ltid(), lane = tid & 63, wid = tid >> 6; const int odd = l & 1;
    const float* MODl = (const float*)(ws + WS_MOD) + (size_t)l * 3 * NMOD;
    for (int u = lbid(); u < NTOK / 8; u += gridDim.x) { const int r = u * 8 + wid; const int mb = r < NLAT ? (r >> 14) : 2;
        f32x4 x[4];
#pragma unroll
        for (int k = 0; k < 4; ++k) x[k] = *(const f32x4*)((r < NLAT ? tab[I_X] + (size_t)r * DM : tab[I_CTX] + (size_t)(r - NLAT) * DM) + lane * 4 + k * 256);
        norm_mod_row(x, tab[I_N1G] + l * DM, MODl + mb * NMOD, MODl + mb * NMOD + DM, lane);
        bf16_t* hp = (bf16_t*)(ws + WS_HA) + (size_t)sigma_row(r, odd) * DM;
#pragma unroll
        for (int k = 0; k < 4; ++k) st_bf4(hp + lane * 4 + k * 256, x[k]); }
}

__device__ __forceinline__ int chunk_at(int b, int d, int s) {
    if (s < 4) return 512 + b * 4 + (d ? 3 - s : s);
    const int c = s - 4; return b * 256 + (d ? 255 - c : c);
}

constexpr int HP = 136, HPT = 72;
__device__ __forceinline__ bf16x8 lds_frag(const bf16_t* p) { return *(const bf16x8*)p; }
__device__ __forceinline__ void deal3(int c, int c1, int c2, int n0, int n1, int n2, int total, int& first, int& last) {
    int s = c < c1 ? c * n0 : (c < c2 ? c1 * n0 + (c - c1) * n1 : c1 * n0 + (c2 - c1) * n1 + (c - c2) * n2);
    int n = c < c1 ? n0 : (c < c2 ? n1 : n2);
    first = s; last = s + n; if (last > total) last = total; if (first > total) first = total;
}
__device__ __forceinline__ void hgrn_local_phase(unsigned char* ws, unsigned char* lds_g, int l) {
    bf16_t* KT = (bf16_t*)lds_g;
    bf16_t* VT = KT + 2 * 128 * HPT;
    float* qs = (float*)(VT + 128 * HPT);
    const int tid = ltid(), lane = tid & 63, wid = tid >> 6, dk = tid & 127, qt = tid >> 7, fr = lane & 15, fq = lane >> 4, G = gridDim.x;
    const int nunits = NCHUNK * HH;
    int u, uend; if (G == 256) deal3(lbid(), 128, 160, 9, 8, 7, nunits, u, uend); else { const int per = (nunits + G - 1) / G; u = lbid() * per; uend = u + per < nunits ? u + per : nunits; }
    if (u >= uend) return;
    const bf16_t* Zb = (const bf16_t*)(ws + WS_Z);
    unsigned short rf[2][16]; u32x4 vraw[2];
#define HL_LOADRAW(uu) do { const int rho_ = (uu) >> 2, h_ = (uu) & 3; const bf16_t* Zr = Zb + (size_t)rho_ * 64 * ZC + h_ * 128; \
        _Pragma("unroll") for (int jj = 0; jj < 16; ++jj) { const bf16_t* zj = Zr + (size_t)jj * ZC; rf[0][jj] = zj[loff + ZFF]; rf[1][jj] = zj[loff + ZFB]; } \
        _Pragma("unroll") for (int k = 0; k < 2; ++k) { const int idx = tid + k * 512, s = idx >> 4, dvg = idx & 15; vraw[k] = *(const u32x4*)(Zr + (size_t)s * ZC + ZI + dvg * 8); } } while (0)
    const int loff = qt * 16 * ZC + dk;
    HL_LOADRAW(u);
    for (; u < uend; ++u) {
        const int rho = u >> 2, h = u & 3;
        float lf[2][16], kk[2][16];
#pragma unroll
        for (int d = 0; d < 2; ++d) { const float lb = ((const float*)(ws + WS_LB))[(d * DEPTH + l) * 512 + h * 128 + dk]; float qsum = 1.f;
#pragma unroll
            for (int jj = 0; jj < 16; ++jj) { const float f = bf2f(rf[d][jj]); const float sg = sigf(f);
                lf[d][jj] = lb + (1.0f - lb) * sg; kk[d][jj] = (1.0f - lb) * (1.0f - sg); qsum *= lf[d][jj]; }
            qs[(d * 4 + qt) * 128 + dk] = qsum; }
#pragma unroll
        for (int k = 0; k < 2; ++k) { const int idx = tid + k * 512, s = idx >> 4, dvg = idx & 15; const unsigned ww[4] = {vraw[k].x, vraw[k].y, vraw[k].z, vraw[k].w};
#pragma unroll
            for (int i = 0; i < 4; ++i) { VT[(dvg * 8 + 2 * i) * HPT + s] = (bf16_t)(ww[i] & 0xffffu); VT[(dvg * 8 + 2 * i + 1) * HPT + s] = (bf16_t)(ww[i] >> 16); } }
        if (u + 1 < uend) HL_LOADRAW(u + 1);
        __syncthreads();
#pragma unroll
        for (int d = 0; d < 2; ++d) { float after = 1.f, tot = 0.f;
#pragma unroll
            for (int k = 0; k < 4; ++k) { const float s = qs[(d * 4 + k) * 128 + dk]; tot += lg2(s); if (d == 0 ? (k > qt) : (k < qt)) after *= s; }
            float kh[16];
            if (d == 0) { float run = after;
#pragma unroll
                for (int jj = 15; jj >= 0; --jj) { kh[jj] = kk[d][jj] * run; run *= lf[d][jj]; } }
            else { float run = after;
#pragma unroll
                for (int jj = 0; jj < 16; ++jj) { kh[jj] = kk[d][jj] * run; run *= lf[d][jj]; } }
            u32x4 o0, o1; o0.x = pack2(kh[0], kh[1]); o0.y = pack2(kh[2], kh[3]); o0.z = pack2(kh[4], kh[5]); o0.w = pack2(kh[6], kh[7]);
            o1.x = pack2(kh[8], kh[9]); o1.y = pack2(kh[10], kh[11]); o1.z = pack2(kh[12], kh[13]); o1.w = pack2(kh[14], kh[15]);
            bf16_t* kp = KT + (d * 128 + dk) * HPT + qt * 16; *(u32x4*)kp = o0; *(u32x4*)(kp + 8) = o1;
            if (qt == 0) ((float*)(ws + WS_HTOT))[((size_t)(rho * HH + h) * 2 + d) * 128 + dk] = tot; }
        __syncthreads();
#pragma unroll
        for (int d = 0; d < 2; ++d) { f32x4 acc[8];
#pragma unroll
            for (int n = 0; n < 8; ++n) acc[n] = (f32x4){0.f, 0.f, 0.f, 0.f};
#pragma unroll
            for (int ks = 0; ks < 2; ++ks) { const bf16x8 a = lds_frag(KT + (d * 128 + wid * 16 + fr) * HPT + ks * 32 + fq * 8);
#pragma unroll
                for (int n = 0; n < 8; ++n) { const bf16x8 b = lds_frag(VT + (n * 16 + fr) * HPT + ks * 32 + fq * 8); acc[n] = __builtin_amdgcn_mfma_f32_16x16x32_bf16(a, b, acc[n], 0, 0, 0); } }
            unsigned char* KV = (unsigned char*)(ws + WS_HKV) + ((size_t)(rho * HH + h) * 2 + d) * 16384;
#pragma unroll
            for (int n = 0; n < 8; ++n) *(unsigned*)(KV + (n * 16 + fr) * 128 + wid * 16 + fq * 4) = pack4_fp8(acc[n][0], acc[n][1], acc[n][2], acc[n][3]); }
        __syncthreads();
    }
#undef HL_LOADRAW
}
__device__ __forceinline__ void hgrn_carry2(unsigned char* ws, int u) {
    const int eb = u & 15, d = (u >> 4) & 1, h = (u >> 5) & 3, b = u >> 7; const int e2 = eb * 512 + ltid(), dkp = e2 & 63;
    const unsigned short* KV = (const unsigned short*)(ws + WS_HKV); const float* TOT = (const float*)(ws + WS_HTOT); unsigned* HS = (unsigned*)(ws + WS_HS);
    float S0 = 0.f, S1 = 0.f;
    for (int s0 = 0; s0 < 260; s0 += 13) { unsigned kv[13]; float t0[13], t1[13]; unsigned si[13];
#pragma unroll
        for (int k = 0; k < 13; ++k) { si[k] = (unsigned)((chunk_at(b, d, s0 + k) * HH + h) * 2 + d); kv[k] = KV[(size_t)si[k] * 8192 + e2]; const float2 tt = *(const float2*)(TOT + (size_t)si[k] * 128 + 2 * dkp); t0[k] = tt.x; t1[k] = tt.y; }
#pragma unroll
        for (int k = 0; k < 13; ++k) { typedef float f32x2v __attribute__((ext_vector_type(2))); const f32x2v kf = __builtin_amdgcn_cvt_pk_f32_fp8(kv[k], false);
            HS[(size_t)si[k] * 8192 + e2] = pack2(S0, S1); S0 = ex2(t0[k]) * S0 + kf.x; S1 = ex2(t1[k]) * S1 + kf.y; } }
}
__device__ __forceinline__ void hgrn_out_phase(unsigned char* ws, const float* const* tab, unsigned char* lds_g, int l) {
    bf16_t* Qa = (bf16_t*)lds_g;
    bf16_t* Qi = Qa + 64 * HP;
    bf16_t* Kd = Qi + 32 * HP;
    bf16_t* Ko = Kd + 64 * HP;
    bf16_t* ST = Ko + 32 * HP;
    bf16_t* VT = ST + 128 * HP;
    bf16_t* Pm = VT + 128 * HPT;
    float* qs = (float*)(Pm + 64 * HPT);
    float* ssq = qs + 1024;
    const int tid = ltid(), lane = tid & 63, wid = tid >> 6, fr = lane & 15, fq = lane >> 4, G = gridDim.x;
    const int dp2 = 2 * lane, rg = __builtin_amdgcn_readfirstlane(wid);
    const int nunits = (l == DEPTH - 1 ? NLAT / CH : NCHUNK) * HH;
    int u, uend;
    if (G == 256 && l == DEPTH - 1) { u = lbid() * 8; uend = u + 8; }
    else if (G == 256) { const int c = lbid(); if (c < 128) deal3(c, 64, 128, 10, 9, 0, nunits, u, uend); else { deal3(c - 128, 96, 128, 7, 6, 0, nunits - 1216, u, uend); u += 1216; uend += 1216; } }
    else { const int per = (nunits + G - 1) / G; u = lbid() * per; uend = u + per < nunits ? u + per : nunits; }
    if (u >= uend) return;
    const bf16_t* Zb = (const bf16_t*)(ws + WS_Z);
    const int tt0 = wid >> 2, st = wid & 3;
    const int ot = wid & 3, oh = wid >> 2;
    unsigned rq[8], rf[2][8];
#define HO_LOADRAW(uu) do { const int rho_ = (uu) >> 2, h_ = (uu) & 3; const bf16_t* Zr = Zb + (size_t)rho_ * 64 * ZC + h_ * 128 + (size_t)(rg * 8) * ZC; \
        _Pragma("unroll") for (int jj = 0; jj < 8; ++jj) { const bf16_t* zj = Zr + (size_t)jj * ZC; rq[jj] = *(const unsigned*)(zj + ZQ + dp2); rf[0][jj] = *(const unsigned*)(zj + ZFF + dp2); rf[1][jj] = *(const unsigned*)(zj + ZFB + dp2); } } while (0)
    u32x4 vraw[2], sraw[4];
#define HO_LOADVS(uu) do { const int rho_ = (uu) >> 2, h_ = (uu) & 3; const bf16_t* Zv = Zb + (size_t)rho_ * 64 * ZC + ZI + h_ * 128; \
        _Pragma("unroll") for (int k = 0; k < 2; ++k) { const int idx = tid + k * 512, s_ = idx >> 4, dvg = idx & 15; vraw[k] = *(const u32x4*)(Zv + (size_t)s_ * ZC + dvg * 8); } \
        const u32x4* sp_ = (const u32x4*)((const bf16_t*)(ws + WS_HS) + ((size_t)(rho_ * HH + h_) * 2) * 16384); \
        _Pragma("unroll") for (int k = 0; k < 4; ++k) sraw[k] = sp_[tid + k * 512]; } while (0)
    HO_LOADRAW(u); HO_LOADVS(u);
    for (; u < uend; ++u) {
        const int rho = u >> 2, h = u & 3;
        const bf16_t* Z = Zb + (size_t)rho * 64 * ZC;
        u32x4 sbw[4]; u32x2 graw[4];
        const u32x4* sp0 = (const u32x4*)((const bf16_t*)(ws + WS_HS) + ((size_t)(rho * HH + h) * 2) * 16384);
        float qv0[8], qv1[8];
#pragma unroll
        for (int jj = 0; jj < 8; ++jj) { qv0[jj] = bflo(rq[jj]); qv1[jj] = bfhi(rq[jj]); }
        f32x4 O[4], Pk[2];
#pragma unroll
        for (int n = 0; n < 4; ++n) O[n] = (f32x4){0.f, 0.f, 0.f, 0.f};
        Pk[0] = Pk[1] = (f32x4){0.f, 0.f, 0.f, 0.f};
#pragma unroll
        for (int d = 0; d < 2; ++d) {
            const float2 lb2 = *(const float2*)((const float*)(ws + WS_LB) + (d * DEPTH + l) * 512 + h * 128 + dp2);
            float g0[8], g1[8], k0[8], k1[8], pr0 = 1.f, pr1 = 1.f;
#pragma unroll
            for (int jj = 0; jj < 8; ++jj) { const float s0 = sigf(bflo(rf[d][jj])), s1 = sigf(bfhi(rf[d][jj]));
                g0[jj] = lb2.x + (1.0f - lb2.x) * s0; k0[jj] = (1.0f - lb2.x) * (1.0f - s0); pr0 *= g0[jj];
                g1[jj] = lb2.y + (1.0f - lb2.y) * s1; k1[jj] = (1.0f - lb2.y) * (1.0f - s1); pr1 *= g1[jj]; }
            if (d == 1) __syncthreads();
            *(float2*)(qs + rg * 128 + dp2) = make_float2(pr0, pr1);
#pragma unroll
            for (int k = 0; k < 4; ++k) { const int idx = tid + k * 512, r = idx >> 4, c = idx & 15; *(u32x4*)(ST + r * HP + c * 8) = d == 0 ? sraw[k] : sbw[k]; }
            if (d == 0) {
#pragma unroll
                for (int k = 0; k < 4; ++k) sbw[k] = sp0[2048 + tid + k * 512];
#pragma unroll
                for (int n = 0; n < 4; ++n) graw[n] = *(const u32x2*)(Z + (size_t)(ot * 16 + fr) * ZC + ZG + h * 128 + (oh * 4 + n) * 16 + fq * 4); }
            if (d == 0) {
#pragma unroll
                for (int k = 0; k < 2; ++k) { const int idx = tid + k * 512, s = idx >> 4, dvg = idx & 15; const unsigned ww[4] = {vraw[k].x, vraw[k].y, vraw[k].z, vraw[k].w};
#pragma unroll
                    for (int i = 0; i < 4; ++i) { VT[(dvg * 8 + 2 * i) * HPT + s] = (bf16_t)(ww[i] & 0xffffu); VT[(dvg * 8 + 2 * i + 1) * HPT + s] = (bf16_t)(ww[i] >> 16); } } }
            __syncthreads();
            float b10 = 1.f, b11 = 1.f, R0 = 1.f, R1 = 1.f;
#pragma unroll
            for (int g = 0; g < 8; ++g) { const float2 gp = *(const float2*)(qs + g * 128 + dp2);
                const bool first = d == 0 ? (g < 4) : (g >= 4);
                const bool before = d == 0 ? (g >= (rg & ~3) && g < rg) : (g > rg && g <= (rg | 3));
                if (first) { b10 *= gp.x; b11 *= gp.y; }
                if (before) { R0 *= gp.x; R1 *= gp.y; } }
            const bool later = d == 0 ? (rg >= 4) : (rg < 4);
            float Ri0 = __builtin_amdgcn_rcpf(R0), Ri1 = __builtin_amdgcn_rcpf(R1);
#pragma unroll
            for (int jx = 0; jx < 8; ++jx) { const int jj = d == 0 ? jx : 7 - jx; const int j = rg * 8 + jj;
                R0 *= g0[jj]; R1 *= g1[jj]; Ri0 *= __builtin_amdgcn_rcpf(g0[jj]); Ri1 *= __builtin_amdgcn_rcpf(g1[jj]);
                const float qa0 = qv0[jj] * R0, qa1 = qv1[jj] * R1, kd0 = k0[jj] * Ri0, kd1 = k1[jj] * Ri1;
                *(unsigned*)(Qa + j * HP + dp2) = pack2(qa0, qa1); *(unsigned*)(Kd + j * HP + dp2) = pack2(kd0, kd1);
                if (later) *(unsigned*)(Qi + (j & 31) * HP + dp2) = pack2(qa0 * b10, qa1 * b11); else *(unsigned*)(Ko + (j & 31) * HP + dp2) = pack2(kd0 * b10, kd1 * b11); }
            if (d == 1) { asm volatile("" ::: "memory"); if (u + 1 < uend) { HO_LOADRAW(u + 1); HO_LOADVS(u + 1); } }
            __syncthreads();
#pragma unroll
            for (int pp = 0; pp < 2; ++pp) { const int tt = tt0 + 2 * pp; const bool need = d == 0 ? (st <= tt) : (st >= tt);
                if (need) { const bool same = (tt >> 1) == (st >> 1); const bf16_t* Kt = same ? Kd + (st * 16) * HP : Ko + ((st & 1) * 16) * HP; f32x4 D = (f32x4){0.f, 0.f, 0.f, 0.f};
#pragma unroll
                    for (int ks = 0; ks < 4; ++ks) D = __builtin_amdgcn_mfma_f32_16x16x32_bf16(lds_frag(Kt + fr * HP + ks * 32 + fq * 8), lds_frag(Qa + (tt * 16 + fr) * HP + ks * 32 + fq * 8), D, 0, 0, 0);
                    if (tt == st) {
#pragma unroll
                        for (int r = 0; r < 4; ++r) { const int sl = fq * 4 + r; const bool keep = d == 0 ? (sl <= fr) : (sl >= fr); if (!keep) D[r] = 0.f; } }
                    Pk[pp] += D; } }
            if (d == 1) {
#pragma unroll
                for (int pp = 0; pp < 2; ++pp) { const int tt = tt0 + 2 * pp; st_bf4(Pm + (tt * 16 + fr) * HPT + st * 16 + fq * 4, Pk[pp]); } }
            { const bool useQi = d == 0 ? (ot >= 2) : (ot < 2); const bf16_t* Qx = useQi ? Qi + ((ot & 1) * 16) * HP : Qa + (ot * 16) * HP;
#pragma unroll
              for (int ks = 0; ks < 4; ++ks) { const bf16x8 bq = lds_frag(Qx + fr * HP + ks * 32 + fq * 8);
#pragma unroll
                for (int n = 0; n < 4; ++n) O[n] = __builtin_amdgcn_mfma_f32_16x16x32_bf16(lds_frag(ST + ((oh * 4 + n) * 16 + fr) * HP + ks * 32 + fq * 8), bq, O[n], 0, 0, 0); } }
        }
        __syncthreads();
#pragma unroll
        for (int ks = 0; ks < 2; ++ks) { const bf16x8 bp = lds_frag(Pm + (ot * 16 + fr) * HPT + ks * 32 + fq * 8);
#pragma unroll
            for (int n = 0; n < 4; ++n) O[n] = __builtin_amdgcn_mfma_f32_16x16x32_bf16(lds_frag(VT + ((oh * 4 + n) * 16 + fr) * HPT + ks * 32 + fq * 8), bp, O[n], 0, 0, 0); }
        float ss = 0.f;
#pragma unroll
        for (int n = 0; n < 4; ++n) ss += O[n][0] * O[n][0] + O[n][1] * O[n][1] + O[n][2] * O[n][2] + O[n][3] * O[n][3];
        ss += __shfl_xor(ss, 16); ss += __shfl_xor(ss, 32);
        if (fq == 0) ssq[oh * 64 + ot * 16 + fr] = ss;
        __syncthreads();
        const int t = ot * 16 + fr; const float rstd = rsqrtf((ssq[t] + ssq[64 + t]) * (1.0f / 128.0f) + EPS);
        const float* ng = tab[I_HNG] + l * 128;
        bf16_t* Y = (bf16_t*)(ws + WS_YCAT) + (size_t)(rho * 64 + t) * DM + 512 + h * 128;
#pragma unroll
        for (int n = 0; n < 4; ++n) { const int dv = (oh * 4 + n) * 16 + fq * 4; const f32x4 g = (f32x4){bflo(graw[n].x), bfhi(graw[n].x), bflo(graw[n].y), bfhi(graw[n].y)}; const f32x4 w = *(const f32x4*)(ng + dv); f32x4 o;
#pragma unroll
            for (int r = 0; r < 4; ++r) o[r] = O[n][r] * rstd * w[r] * g[r] * sigmoidf_(g[r]);
            st_bf4(Y + dv, o); }
        __syncthreads();
    }
#undef HO_LOADRAW
#undef HO_LOADVS
}

__device__ __forceinline__ void s5_carry(unsigned char* ws, const float* const* tab, int l, int u) {
    const int idx = u * 512 + ltid(), p = idx & 63, d = (idx >> 6) & 1, g = (idx >> 7) & 31, b = idx >> 12;
    const float2 lam = ((const float2*)(ws + WS_LAMT))[((l * 2 + d) * S5G + g) * 64 + p];
    const float* E = (const float*)(ws + WS_S5E) + (size_t)g * UAROWS * 256 + d * 128 + p;
    bf16_t* X = (bf16_t*)(ws + WS_UA) + (size_t)g * UAROWS * UALD + 1024 + d * 128 + p;
    float xr = 0.f, xi = 0.f;
    for (int s0 = 0; s0 < 260; s0 += 4) { float er[4], ei[4]; int rho[4];
#pragma unroll
        for (int k = 0; k < 4; ++k) { rho[k] = chunk_at(b, d, s0 + k); er[k] = E[(size_t)rho[k] * 256]; ei[k] = E[(size_t)rho[k] * 256 + 64]; }
#pragma unroll
        for (int k = 0; k < 4; ++k) { X[(size_t)rho[k] * UALD] = f2bf(xr); X[(size_t)rho[k] * UALD + 64] = f2bf(xi);
            const float nr = lam.x * xr - lam.y * xi + er[k], ni = lam.x * xi + lam.y * xr + ei[k]; xr = nr; xi = ni; } }
}

static __device__ __forceinline__ void phase_norm2_route(unsigned char* ws, const float* const* tab, unsigned char* lds_g, int l, int probe = 0) {
    constexpr int HPF = 1028;
    float* hrow = (float*)lds_g;
    int* hist = (int*)(hrow + 32 * HPF);
    int* base = hist + 32;
    const int tid = ltid(), lane = tid & 63, wid = tid >> 6, e = lane & 31;
    const float* MODl = (const float*)(ws + WS_MOD) + (size_t)l * 3 * NMOD;
    const float* RW = tab[I_RW] + (size_t)l * DM * NE; const float* RB = tab[I_RB] + l * NE;
    unsigned* CNT = (unsigned*)(ws + WS_CTL) + CW_CNT + (l + (probe ? DEPTH : 0)) * NE;
    const size_t pofs = probe ? (WS_ACT - WS_TOPE) : 0;
    float bw0[32], bw1[32];
    { const int fr = lane & 15, fq = lane >> 4; const float* bp = RW + (size_t)(wid * 128 + fq) * NE + fr;
#pragma unroll
      for (int ks = 0; ks < 32; ++ks) { bw0[ks] = bp[(size_t)ks * 4 * NE]; bw1[ks] = bp[(size_t)ks * 4 * NE + 16]; } }
    int pe = 0, pl = 0, pr = -1; float pg = 0.f; unsigned bres = 0u;
#define ROUTE_FLUSH() do { if (lane < 16 && pr >= 0) { const size_t o = (size_t)pr * 4 + (lane & 3); const int rk = base[pe] + pl; \
            ((int*)(ws + pofs + WS_TOPE))[o] = pe; ((int*)(ws + pofs + WS_TOPR))[o] = rk; \
            if (!probe) { ((int*)(ws + WS_ROWTOK))[(size_t)pe * NTOK + rk] = pr; ((float*)(ws + WS_ROWGATE))[(size_t)pe * NTOK + rk] = pg; } } } while (0)
    for (int u = lbid(); u < ((l == DEPTH - 1) ? NLAT : NTOK) / 32; u += gridDim.x) {
        if (tid < 32) hist[tid] = 0;
#pragma unroll
        for (int i = 0; i < 4; ++i) { const int r = u * 32 + wid * 4 + i; const int mb = r < NLAT ? (r >> 14) : 2;
            f32x4 x[4];
#pragma unroll
            for (int k = 0; k < 4; ++k) x[k] = ld_bf4((const bf16_t*)(ws + WS_XF) + (size_t)r * DM + lane * 4 + k * 256);
            norm_mod_row(x, tab[I_N2G] + l * DM, MODl + mb * NMOD + 3 * DM, MODl + mb * NMOD + 4 * DM, lane);
            unsigned* hp = (unsigned*)(ws + WS_HA8 + (size_t)r * DM);
#pragma unroll
            for (int k = 0; k < 4; ++k) { if (MOE1_FP8) hp[lane + k * 64] = pack4_fp8(x[k][0] * FP8_ASCALE, x[k][1] * FP8_ASCALE, x[k][2] * FP8_ASCALE, x[k][3] * FP8_ASCALE); else st_bf4((bf16_t*)(ws + WS_HA) + (size_t)r * DM + lane * 4 + k * 256, x[k]); *(f32x4*)(hrow + (wid * 4 + i) * HPF + lane * 4 + k * 256) = x[k]; } }
        if (tid < 32) base[tid] = (int)bres;
        __syncthreads();
        ROUTE_FLUSH();
        { const int fr = lane & 15, fq = lane >> 4; f32x4 acc00 = (f32x4){0.f, 0.f, 0.f, 0.f}, acc01 = acc00, acc10 = acc00, acc11 = acc00;
          const float* ap = hrow + fr * HPF + wid * 128 + fq;
#pragma unroll
          for (int ks = 0; ks < 32; ++ks) { const float a0 = ap[ks * 4], a1 = ap[16 * HPF + ks * 4];
              acc00 = __builtin_amdgcn_mfma_f32_16x16x4f32(a0, bw0[ks], acc00, 0, 0, 0); acc01 = __builtin_amdgcn_mfma_f32_16x16x4f32(a0, bw1[ks], acc01, 0, 0, 0);
              acc10 = __builtin_amdgcn_mfma_f32_16x16x4f32(a1, bw0[ks], acc10, 0, 0, 0); acc11 = __builtin_amdgcn_mfma_f32_16x16x4f32(a1, bw1[ks], acc11, 0, 0, 0); }
          __syncthreads();
          float* part = hrow + (wid * 32 + fq * 4) * 32;
#pragma unroll
          for (int r = 0; r < 4; ++r) { part[r * 32 + fr] = acc00[r]; part[r * 32 + 16 + fr] = acc01[r]; part[(16 + r) * 32 + fr] = acc10[r]; part[(16 + r) * 32 + 16 + fr] = acc11[r]; } }
        __syncthreads();
        int myl = 0, mye = 0; float myg = 0.f;
#pragma unroll
        for (int i = 0; i < 4; ++i) { const int rl = wid * 4 + i; float v = ((hrow[(0 * 32 + rl) * 32 + e] + hrow[(1 * 32 + rl) * 32 + e]) + (hrow[(2 * 32 + rl) * 32 + e] + hrow[(3 * 32 + rl) * 32 + e])) + ((hrow[(4 * 32 + rl) * 32 + e] + hrow[(5 * 32 + rl) * 32 + e]) + (hrow[(6 * 32 + rl) * 32 + e] + hrow[(7 * 32 + rl) * 32 + e])) + RB[e]; float tv[4]; int te[4];
#pragma unroll
            for (int k = 0; k < 4; ++k) { float best = v; int bi = e;
#pragma unroll
                for (int o = 16; o >= 1; o >>= 1) { const float ov = __shfl_xor(best, o); const int oi = __shfl_xor(bi, o); if (ov > best || (ov == best && oi < bi)) { best = ov; bi = oi; } }
                tv[k] = best; te[k] = bi; if (e == bi) v = -3.0e38f; }
            float ex[4], s = 0.f;
#pragma unroll
            for (int k = 0; k < 4; ++k) { ex[k] = __expf(tv[k] - tv[0]); s += ex[k]; }
            const float inv = 1.0f / s;
#pragma unroll
            for (int k = 0; k < 4; ++k) if (lane == i * 4 + k) { mye = te[k]; myg = ex[k] * inv; } }
        if (lane < 16) myl = atomicAdd(&hist[mye], 1);
        __syncthreads();
        if (tid < 32) bres = atomicAdd(&CNT[tid], (unsigned)hist[tid]);
        pe = mye; pl = myl; pg = myg; pr = u * 32 + wid * 4 + (lane >> 2);
    }
    if (tid < 32) base[tid] = (int)bres;
    __syncthreads();
    ROUTE_FLUSH();
#undef ROUTE_FLUSH
    __syncthreads();
}
__device__ __forceinline__ void moe_segments(unsigned char* ws, int* ps, int l) {
    const int tid = ltid();
    if (tid < 64) { const unsigned* CNT = (const unsigned*)(ws + WS_CTL) + CW_CNT + l * NE; const int e = tid & 31;
        const int n = (int)((__hip_atomic_load(CNT + e, __ATOMIC_RELAXED, __HIP_MEMORY_SCOPE_AGENT) + 255u) >> 8);
        int inc = n;
#pragma unroll
        for (int o = 1; o < 32; o <<= 1) { const int v = __shfl_up(inc, o); if ((tid & 31) >= o) inc += v; }
        const int exc = inc - n;
        if (tid < 32) { ps[e] = exc << 8; if (e == NE - 1) ps[NE] = inc << 8; for (int k = 0; k < n; ++k) ps[64 + exc + k] = e; } }
    __syncthreads();
}
static __device__ __forceinline__ void phase_combine(unsigned char* ws, const float* const* tab, unsigned char* lds_g, int l, int probe = 0) {
    int* ps = (int*)lds_g; moe_segments(ws, ps, l);
    const int tid = ltid(), lane = tid & 63, wid = tid >> 6;
    const float* MODl = (const float*)(ws + WS_MOD) + (size_t)l * 3 * NMOD;
    const int* TE = (const int*)(ws + WS_TOPE); const int* TR = (const int*)(ws + WS_TOPR); const bf16_t* O2 = (const bf16_t*)(ws + WS_OUT2);
    const int nu = ((l == DEPTH - 1) ? NLAT : NTOK) / 8; const int G = gridDim.x;
    typedef int i32x4 __attribute__((ext_vector_type(4)));
    int u = lbid(); if (u >= nu) { __syncthreads(); return; }
    i32x4 en = *(const i32x4*)(TE + (size_t)(u * 8 + wid) * 4), rn = *(const i32x4*)(TR + (size_t)(u * 8 + wid) * 4);
    for (; u < nu; u += G) { const int r = u * 8 + wid; const int mb = r < NLAT ? (r >> 14) : 2;
        const int p0 = ps[en[0]] + rn[0], p1 = ps[en[1]] + rn[1], p2 = ps[en[2]] + rn[2], p3 = ps[en[3]] + rn[3];
        if (u + G < nu) { en = *(const i32x4*)(TE + (size_t)((u + G) * 8 + wid) * 4); rn = *(const i32x4*)(TR + (size_t)((u + G) * 8 + wid) * 4); }
        static_assert(OUT2_FP8, "the wide-lane combine reads fp8 expert rows");
        const bf16_t* xp = (const bf16_t*)(ws + WS_XF) + (size_t)r * DM + lane * 16; bf16_t* xo = (bf16_t*)(ws + (probe ? WS_ACT : WS_XF)) + (size_t)r * DM + lane * 16; f32x4 x[4];
        { const unsigned char* O8 = (const unsigned char*)O2 + lane * 16;
          const u32x4 w0 = *(const u32x4*)(O8 + (size_t)p0 * DM), w1 = *(const u32x4*)(O8 + (size_t)p1 * DM), w2 = *(const u32x4*)(O8 + (size_t)p2 * DM), w3 = *(const u32x4*)(O8 + (size_t)p3 * DM);
          f32x4 xa, xb, xc, xd; ld_bf8(xp, xa, xb); ld_bf8(xp + 8, xc, xd);
          const float* gp = MODl + mb * NMOD + 5 * DM + lane * 16;
          const unsigned a0[4] = {w0.x, w0.y, w0.z, w0.w}, a1[4] = {w1.x, w1.y, w1.z, w1.w}, a2[4] = {w2.x, w2.y, w2.z, w2.w}, a3[4] = {w3.x, w3.y, w3.z, w3.w};
          const f32x4 xr[4] = {xa, xb, xc, xd};
#pragma unroll
          for (int k = 0; k < 4; ++k) { const f32x4 y = (up4_fp8(a0[k]) + up4_fp8(a1[k])) + (up4_fp8(a2[k]) + up4_fp8(a3[k]));
              const f32x4 g = *(const f32x4*)(gp + k * 4) * (1.0f / OUT2_SCALE); x[k] = xr[k] + g * y; }
          if (l + 1 < DEPTH) { st_bf8(xo, x[0], x[1]); st_bf8(xo + 8, x[2], x[3]); } }
        if (l + 1 < DEPTH) { const float* MODn = MODl + 3 * NMOD;
            norm_mod_row<true>(x, tab[I_N1G] + (l + 1) * DM, MODn + mb * NMOD, MODn + mb * NMOD + DM, lane);
            bf16_t* hp = (bf16_t*)(ws + (probe ? WS_ACT + SZ_XF : WS_HA)) + (size_t)sigma_row(r, (l + 1) & 1) * DM + lane * 16;
            st_bf8(hp, x[0], x[1]); st_bf8(hp + 8, x[2], x[3]); }
        else if (r < NLAT) { float ss = 0.f;
#pragma unroll
            for (int k = 0; k < 4; ++k) ss += x[k][0] * x[k][0] + x[k][1] * x[k][1] + x[k][2] * x[k][2] + x[k][3] * x[k][3];
            ss = wave_sum(ss); const float rstd = rsqrtf(ss * (1.0f / DM) + EPS);
#pragma unroll
            for (int k = 0; k < 4; ++k) { const int c = lane * 16 + k * 4; *(f32x4*)((probe ? (float*)(ws + WS_ACT + SZ_XF) : (float*)tab[N_INPUTS]) + (size_t)r * DM + c) = x[k] * rstd * *(const f32x4*)(tab[I_FG] + c); } }
    }
    __syncthreads();
}

#define GAS __attribute__((address_space(1)))
template <class T> __device__ __forceinline__ T* launder(T* p) { unsigned long long v = (unsigned long long)p; asm volatile("" : "+s"(v)); GAS T* g = (GAS T*)v; return (T*)g; }
#define PHASE_FN static __device__ __forceinline__
#define G8_LDS(l) ((LAS unsigned char*)(l))
PHASE_FN void ph_inproj(unsigned char* ws, const float* const* tab, unsigned char* lds, int l) {
    g8::GridOrder S{(const char*)(ws + WS_HA), (const char*)(ws + WS_WIN) + (size_t)l * NIN * DM * 2, (size_t)256 * DM * 2, (size_t)256 * DM * 2, 130, 20, 130 * 20, (int)gridDim.x, lbid()};
    F8Inproj E{(bf16_t*)(ws + WS_UA), (bf16_t*)(ws + WS_Z), (unsigned char*)(ws + WS_ZG8)};
    g8::gemm_phase<true, false>(G8_LDS(lds), DM, DM * 2, DM * 2, S, E);
    if (l + 1 < DEPTH && (130 * 20) % (int)gridDim.x != 0 && (int)lbid() >= (130 * 20) % (int)gridDim.x) conv_steal(ws, tab, lds, l + 1, 1);
}
PHASE_FN void ph_s5e(unsigned char* ws, unsigned char* lds, int l) {
    S5Order S{(const char*)(ws + WS_UA), (const char*)(ws + WS_BT1) + (size_t)l * S5G * 256 * 1024 * 2, (size_t)UAROWS * UALD * 2, (size_t)256 * 1024 * 2, UALD * 2, 1024 * 2, 3, 1, (int)gridDim.x, lbid()};
    g8::Epi4<F8S5E> E{{(float*)(ws + WS_S5E)}};
    g8::gemm_phase<false, false>(G8_LDS(lds), 1024, UALD * 2, 1024 * 2, S, E);
}
PHASE_FN void ph_s5y(unsigned char* ws, unsigned char* lds, int l) {
    S5Order S{(const char*)(ws + WS_UA), (const char*)(ws + WS_BT2) + (size_t)l * S5G * 1024 * UALD * 2, (size_t)UAROWS * UALD * 2, (size_t)1024 * UALD * 2, UALD * 2, UALD * 2, (l == DEPTH - 1) ? 2 : 3, 4, (int)gridDim.x, lbid()};
    g8::Epi8<F8S5Y> E{{(bf16_t*)(ws + WS_Z5)}};
    g8::gemm_phase<true, false>(G8_LDS(lds), UALD, UALD * 2, UALD * 2, S, E);
}
PHASE_FN void ph_glu(unsigned char* ws, const float* const* tab, unsigned char* lds, int l) {
    const int probe_ = 0;
    const int nM = (l == DEPTH - 1) ? NLAT / 256 : NTOK / 256;
    g8::GridOrder S{(const char*)(ws + WS_Z5), (const char*)(ws + WS_WGLU) + (size_t)l * 512 * 512 * 2, (size_t)256 * 512 * 2, (size_t)256 * 512 * 2, nM, 2, nM * 2, (int)gridDim.x, lbid()};
    g8::Epi8<F8Glu> E{{(const bf16_t*)(ws + WS_Z5), (bf16_t*)(ws + WS_YCAT)}};
    g8::gemm_phase<true, false>(G8_LDS(lds), 512, 512 * 2, 512 * 2, S, E);
    if (l + 1 < DEPTH && !probe_ && (nM * 2) % (int)gridDim.x != 0 && (int)lbid() >= (nM * 2) % (int)gridDim.x) conv_steal(ws, tab, lds, l + 1, 1);
}
PHASE_FN void ph_up5(unsigned char* ws, const float* const* tab, unsigned char* lds, int l) {
    const int probe_ = 0;
    const int nM = (l == DEPTH - 1) ? NLAT / 256 : NTOK / 256;
    g8::GridOrder S{(const char*)(ws + WS_YCAT), (const char*)(ws + WS_WUP5) + (size_t)l * 1024 * 512 * 2, (size_t)256 * DM * 2, (size_t)256 * 512 * 2, nM, 4, nM * 4, (int)gridDim.x, lbid()};
    g8::Epi8<F8Up5> E{{(const bf16_t*)(ws + WS_Z), (bf16_t*)(ws + WS_MBUF), (const unsigned char*)(ws + WS_ZG8)}};
    g8::gemm_phase<true, false>(G8_LDS(lds), 512, DM * 2, 512 * 2, S, E);
    if (l + 1 < DEPTH && !probe_ && (nM * 4) % (int)gridDim.x != 0 && (int)lbid() >= (nM * 4) % (int)gridDim.x) conv_steal(ws, tab, lds, l + 1, 1);
}
PHASE_FN void ph_uph(unsigned char* ws, const float* const* tab, unsigned char* lds, int l, int probe = 0) {
    const int probe_ = probe;
    const int nM = (l == DEPTH - 1) ? NLAT / 256 : NTOK / 256;
    g8::GridOrder S{(const char*)(ws + WS_YCAT) + 512 * 2, (const char*)(ws + WS_WUPH) + (size_t)l * 1024 * 512 * 2, (size_t)256 * DM * 2, (size_t)256 * 512 * 2, nM, 4, nM * 4, (int)gridDim.x, lbid()};
    g8::Epi8<F8Uph> E{{(const bf16_t*)(ws + WS_Z), (bf16_t*)(ws + WS_MBUF), (bf16_t*)(ws + (probe ? WS_ACT : WS_MBUF)), (const unsigned char*)(ws + WS_ZG8)}};
    g8::gemm_phase<true, false>(G8_LDS(lds), 512, DM * 2, 512 * 2, S, E);
    if (l + 1 < DEPTH && !probe_ && (nM * 4) % (int)gridDim.x != 0 && (int)lbid() >= (nM * 4) % (int)gridDim.x) conv_steal(ws, tab, lds, l + 1, 1);
}
PHASE_FN void ph_out(unsigned char* ws, const float* const* tab, unsigned char* lds, int l, int probe = 0) {
    const int probe_ = probe;
    const int nM = (l == DEPTH - 1) ? NLAT / 256 : NTOK / 256;
    g8::GridOrder S{(const char*)(ws + WS_MBUF), (const char*)(ws + WS_WOUT) + (size_t)l * 1024 * 1024 * 2, (size_t)256 * DM * 2, (size_t)256 * DM * 2, nM, 4, nM * 4, (int)gridDim.x, lbid()};
    F8Out E{(bf16_t*)(ws + (probe ? WS_ACT : WS_XF)), (const float*)(ws + WS_MOD) + (size_t)l * 3 * NMOD, l & 1};
    g8::gemm_phase<true, false>(G8_LDS(lds), DM, DM * 2, DM * 2, S, E);
    if (l + 1 < DEPTH && !probe_ && (nM * 4) % (int)gridDim.x != 0 && (int)lbid() >= (nM * 4) % (int)gridDim.x) conv_steal(ws, tab, lds, l + 1, 2);
}
PHASE_FN void ph_moe1(unsigned char* ws, const float* const* tab, unsigned char* lds, int l) {
    int* ps = (int*)(lds + g8::STAGE_BYTES); moe_segments(ws, ps, l);
    constexpr unsigned EB = MOE1_FP8 ? 1u : 2u;
    MoeOrder S{(const char*)(ws + (MOE1_FP8 ? WS_HA8 : WS_HA)), (const char*)(ws + WS_W1) + (size_t)l * NE * 2048 * 1024 * EB, (const int*)(ws + WS_ROWTOK), ps + 64, 2048u * 1024u * EB, 8, ps[NE] >> 8, (int)gridDim.x, lbid(), true, 256 * DM * EB};
    F8Moe1 E{(bf16_t*)(ws + WS_ACT), tab[I_B1] + (size_t)l * NE * 2048};
    g8::gemm_phase<true, true, MOE1_FP8 != 0>(G8_LDS(lds), MOE1_FP8 ? DM / 2 : DM, DM * EB, DM * EB, S, E);
    if (l + 1 < DEPTH) { g8::Unit du; const int rounds = (S.ntile + 31) >> 5; if (rounds > 0 && !S.next(rounds - 1, du)) conv_steal(ws, tab, lds, l + 1, 1); }
}
PHASE_FN void ph_moe2(unsigned char* ws, const float* const* tab, unsigned char* lds, int l) {
    int* ps = (int*)(lds + g8::STAGE_BYTES); moe_segments(ws, ps, l);
    constexpr unsigned EB = MOE2_FP8 ? 1u : 2u;
    MoeOrder S{(const char*)(ws + WS_ACT), (const char*)(ws + WS_W2) + (size_t)l * NE * 1024 * 1024 * EB, (const int*)(ws + WS_ROWTOK), ps + 64, 1024u * 1024u * EB, 4, ps[NE] >> 8, (int)gridDim.x, lbid(), false, 256 * DM * EB};
    F8Moe2 E{(bf16_t*)(ws + WS_OUT2), tab[I_B2] + (size_t)l * NE * 1024, (const float*)(ws + WS_ROWGATE), ps};
    g8::gemm_phase<true, false, MOE2_FP8 != 0>(G8_LDS(lds), MOE2_FP8 ? DM / 2 : DM, DM * EB, DM * EB, S, E);
    if (l + 1 < DEPTH) { g8::Unit du; const int rounds = (S.ntile + 63) >> 6; if (rounds > 0 && !S.next(rounds - 1, du)) conv_steal(ws, tab, lds, l + 1, 1); }
}
PHASE_FN void ph_hgrn_local(unsigned char* ws, const float* const* tab, unsigned char* lds, int l) {
    hgrn_local_phase(ws, lds, l);
}
PHASE_FN void ph_carry(unsigned char* ws, const float* const* tab, int l) {
    for (int u = lbid(); u < 16 + 256; u += gridDim.x) { if (u < 16) s5_carry(ws, tab, l, u); else hgrn_carry2(ws, u - 16); }
}
PHASE_FN void ph_hgrn_out(unsigned char* ws, const float* const* tab, unsigned char* lds, int l) {
    hgrn_out_phase(ws, tab, lds, l);
}

constexpr int PH_PER_LAYER = 12;
constexpr int N_PHASES = 2 + DEPTH * PH_PER_LAYER;
__global__ void __launch_bounds__(NTHREADS, 2) mega(Params P) {
    extern __shared__ __attribute__((aligned(16))) unsigned char lds[];
    const int tid = threadIdx.x;
    LAS unsigned* xbw = (LAS unsigned*)(lds + LDS_BYTES - 16);
    if (tid < 4) xbw[tid] = 0u;
    unsigned char* ws = P.ws;
    const float** tabw = (const float**)(ws + WS_PTRS) + (size_t)blockIdx.x * 32;
    if (tid == 0) {
#pragma unroll
        for (int i = 0; i < N_INPUTS; ++i) tabw[i] = P.in[i];
        tabw[N_INPUTS] = P.out;
    }
    __syncthreads();
    const float* const* tab = (const float* const*)tabw;
    XcdBarrier bar; bar.bar = (unsigned*)(ws + WS_CTL) + CW_BAR; bar.x = 0; bar.st = nullptr;
    const int lo = P.ph_lo, hi = P.ph_hi;
    if (hi - lo > 1) bar = xcd_barrier_post((unsigned*)(ws + WS_CTL) + CW_BAR, (volatile LAS unsigned*)xbw);
#ifndef PROBE_DUP_MASK
#define PROBE_DUP_MASK 0
#endif
#define DUPON(j) ((PROBE_DUP_MASK >> (j)) & 1)
#define IN(k) (lo <= (k) && (k) < hi && ((ws = launder(ws)), (tab = launder(tab)), true))
#define SEAM(k) do { if ((k) + 1 < hi) xcd_barrier(bar); } while (0)

    if (IN(0)) { phase_prologue(ws, tab, lds, 0); if (DUPON(13)) { xcd_barrier(bar); ws = launder(ws); tab = launder(tab); phase_prologue(ws, tab, lds, 1); } SEAM(0); }
    if (IN(1)) { phase_norm1(ws, tab, lds, 0); SEAM(1); }
#define LAYER_BODY(l) do { const int pb = 2 + l * PH_PER_LAYER; \
        if (IN(pb + 0)) { { ph_inproj(ws, tab, lds, l); } if (DUPON(0)) { ws = launder(ws); tab = launder(tab); ph_inproj(ws, tab, lds, l); } SEAM(pb + 0); } \
        if (IN(pb + 1)) { { ph_s5e(ws, lds, l); ph_hgrn_local(ws, tab, lds, l); } if (DUPON(1)) { ws = launder(ws); tab = launder(tab); ph_s5e(ws, lds, l); ph_hgrn_local(ws, tab, lds, l); } SEAM(pb + 1); } \
        if (IN(pb + 2)) { { ph_carry(ws, tab, l); } if (DUPON(2)) { ws = launder(ws); tab = launder(tab); ph_carry(ws, tab, l); } SEAM(pb + 2); } \
        if (IN(pb + 3)) { { ph_s5y(ws, lds, l); ph_hgrn_out(ws, tab, lds, l); } if (DUPON(3)) { ws = launder(ws); tab = launder(tab); ph_s5y(ws, lds, l); ph_hgrn_out(ws, tab, lds, l); } SEAM(pb + 3); } \
        if (IN(pb + 4)) { { ph_glu(ws, tab, lds, l); } if (DUPON(4)) { ws = launder(ws); tab = launder(tab); ph_glu(ws, tab, lds, l); } SEAM(pb + 4); } \
        if (IN(pb + 5)) { { ph_up5(ws, tab, lds, l); } if (DUPON(5)) { ws = launder(ws); tab = launder(tab); ph_up5(ws, tab, lds, l); } SEAM(pb + 5); } \
        if (IN(pb + 6)) { ph_uph(ws, tab, lds, l); if (DUPON(6)) { ws = launder(ws); ph_uph(ws, tab, lds, l, 1); } SEAM(pb + 6); } \
        if (IN(pb + 7)) { ph_out(ws, tab, lds, l); if (DUPON(7)) { ws = launder(ws); ph_out(ws, tab, lds, l, 1); } SEAM(pb + 7); } \
        if (IN(pb + 8)) { phase_norm2_route(ws, tab, lds, l); if (DUPON(8)) { ws = launder(ws); tab = launder(tab); phase_norm2_route(ws, tab, lds, l, 1); } SEAM(pb + 8); } \
        if (IN(pb + 9)) { { ph_moe1(ws, tab, lds, l); } if (DUPON(10)) { ws = launder(ws); tab = launder(tab); ph_moe1(ws, tab, lds, l); } SEAM(pb + 9); } \
        if (IN(pb + 10)) { { ph_moe2(ws, tab, lds, l); } if (DUPON(11)) { ws = launder(ws); tab = launder(tab); ph_moe2(ws, tab, lds, l); } SEAM(pb + 10); } \
        if (IN(pb + 11)) { if (DUPON(12)) { phase_combine(ws, tab, lds, l, 1); ws = launder(ws); tab = launder(tab); } phase_combine(ws, tab, lds, l); if (l + 1 < DEPTH) conv_steal(ws, tab, lds, l + 1, 1 << 30); SEAM(pb + 11); } } while (0)
    LAYER_BODY(0); LAYER_BODY(1); LAYER_BODY(2); LAYER_BODY(3);
#undef LAYER_BODY
#undef IN
#undef SEAM
}

#ifndef MK_LAUNCH_PER_PHASE
#define MK_LAUNCH_PER_PHASE 0
#endif
extern "C" void kernel_launch(void* const* d_in, const int* in_sizes, int n_in, void* d_out, int out_size, void* d_ws, size_t ws_size, hipStream_t stream) {
    static int grid = 0;
    if (grid == 0) {
        if (n_in != N_INPUTS || out_size != NLAT * DM || ws_size < WS_END) { fprintf(stderr, "kernel_launch: unexpected problem (n_in %d, out %d, ws %zu < %zu)\n", n_in, out_size, ws_size, (size_t)WS_END); grid = -1; return; }
        int dev = 0, cus = 0, per_cu = 0;
        if (hipGetDevice(&dev) != hipSuccess || hipDeviceGetAttribute(&cus, hipDeviceAttributeMultiprocessorCount, dev) != hipSuccess) { grid = -1; return; }
        if (hipFuncSetAttribute((const void*)mega, hipFuncAttributeMaxDynamicSharedMemorySize, LDS_BYTES) != hipSuccess) { fprintf(stderr, "kernel_launch: hipFuncSetAttribute failed\n"); grid = -1; return; }
        if (hipOccupancyMaxActiveBlocksPerMultiprocessor(&per_cu, (const void*)mega, NTHREADS, LDS_BYTES) != hipSuccess || per_cu < 1) { fprintf(stderr, "kernel_launch: occupancy query says %d\n", per_cu); }
        (void)hipGetLastError();
        grid = cus;
    }
    if (grid < 0) return;
    (void)hipMemsetAsync((char*)d_ws + WS_CTL, 0, CTL_BYTES, stream);
    Params p{};
    for (int i = 0; i < N_INPUTS; ++i) p.in[i] = (const float*)d_in[i];
    p.out = (float*)d_out; p.ws = (unsigned char*)d_ws;
#if MK_LAUNCH_PER_PHASE
    for (int ph = 0; ph < N_PHASES; ++ph) { p.ph_lo = ph; p.ph_hi = ph + 1; hipLaunchKernelGGL(mega, dim3(grid), dim3(NTHREADS), LDS_BYTES, stream, p); }
#else
    p.ph_lo = 0; p.ph_hi = N_PHASES; hipLaunchKernelGGL(mega, dim3(grid), dim3(NTHREADS), LDS_BYTES, stream, p);
#endif
}
```

```cpp
#include <hip/hip_runtime.h>
#include <cstdio>
#include <cstdint>

typedef unsigned short bf16_t;
typedef short bf16x8 __attribute__((ext_vector_type(8)));
typedef float f32x4 __attribute__((ext_vector_type(4)));
typedef unsigned u32x2 __attribute__((ext_vector_type(2)));
typedef unsigned u32x4 __attribute__((ext_vector_type(4)));
typedef int i32x8 __attribute__((ext_vector_type(8)));
typedef int i32x4v __attribute__((ext_vector_type(4)));
#define MOE1_FP8 1
#define MOE2_FP8 1
constexpr float FP8_WSCALE = MOE1_FP8 ? 32.0f : 1.0f, FP8_ASCALE = MOE1_FP8 ? 4.0f : 1.0f;
#define LAS __attribute__((address_space(3)))

constexpr int DM = 1024, NB = 2, SEQ = 16384, DEPTH = 4, CTXL = 256;
constexpr int NLAT = NB * SEQ, NCTX = NB * CTXL, NTOK = NLAT + NCTX;
constexpr int CH = 64, NCHUNK = NTOK / CH;
constexpr int S5G = 32, S5H = 16, S5P = 64;
constexpr int HH = 4;
constexpr int NIN = 5120, ZC = NIN - 512;
constexpr int ZQ = 0, ZI = 512, ZFF = 1024, ZFB = 1536, ZG = 2048, Z6 = 2560, Z7 = 3584;
constexpr int NE = 32, TOPK = 4;
constexpr int NMOD = 6 * DM;
constexpr int UAROWS = 768, UALD = 1280;
constexpr int MAXROWS = NTOK * TOPK + NE * 256;
constexpr int NTHREADS = 512;
constexpr int LDS_BYTES = 147456;
constexpr float EPS = 1e-6f;

constexpr size_t al256(size_t x) { return (x + 255) & ~(size_t)255; }
constexpr size_t WS_CTL = 0;                 constexpr size_t CTL_BYTES = 1u << 20;
constexpr size_t WS_MOD = WS_CTL + CTL_BYTES;            constexpr size_t SZ_MOD = (size_t)DEPTH * 3 * NMOD * 4;
constexpr size_t WS_LB = al256(WS_MOD + SZ_MOD);         constexpr size_t SZ_LB = (size_t)2 * DEPTH * 512 * 4;
constexpr size_t WS_LAMT = al256(WS_LB + SZ_LB);         constexpr size_t SZ_LAMT = (size_t)DEPTH * 2 * S5G * S5P * 2 * 4;
constexpr size_t WS_KT = al256(WS_LAMT + SZ_LAMT);       constexpr size_t SZ_KT = (size_t)DEPTH * S5G * 2 * 64 * 256 * 4;
constexpr size_t WS_S5T = al256(WS_KT + SZ_KT);          constexpr size_t SZ_S5T = (size_t)DEPTH * S5G * (2 * 64 * 65 + 2 * 64 * 16 + 2 * 16 * 64) * 8;
constexpr size_t WS_BT1 = al256(WS_S5T + SZ_S5T);          constexpr size_t SZ_BT1 = (size_t)DEPTH * S5G * 256 * 1024 * 2;
constexpr size_t WS_BT2 = al256(WS_BT1 + SZ_BT1);        constexpr size_t SZ_BT2 = (size_t)DEPTH * S5G * 1024 * UALD * 2;
constexpr size_t WS_XF = al256(WS_BT2 + SZ_BT2);         constexpr size_t SZ_XF = (size_t)NTOK * DM * 4;
constexpr size_t WS_HA = al256(WS_XF + SZ_XF);           constexpr size_t SZ_HA = (size_t)NTOK * DM * 2;
constexpr size_t WS_UA = al256(WS_HA + SZ_HA);           constexpr size_t SZ_UA = (size_t)S5G * UAROWS * UALD * 2;
constexpr size_t WS_Z = al256(WS_UA + SZ_UA);            constexpr size_t SZ_Z = (size_t)NTOK * ZC * 2;
constexpr size_t WS_Z5 = al256(WS_Z + SZ_Z);             constexpr size_t SZ_Z5 = (size_t)NTOK * 512 * 2;
constexpr size_t WS_YCAT = al256(WS_Z5 + SZ_Z5);         constexpr size_t SZ_YCAT = (size_t)NTOK * DM * 2;
constexpr size_t WS_MBUF = al256(WS_YCAT + SZ_YCAT);     constexpr size_t SZ_MBUF = (size_t)NTOK * DM * 2;
constexpr size_t WS_S5E = al256(WS_MBUF + SZ_MBUF);      constexpr size_t SZ_S5E = (size_t)S5G * UAROWS * 256 * 4;
constexpr size_t WS_HKV = al256(WS_S5E + SZ_S5E);        constexpr size_t SZ_HKV = (size_t)NCHUNK * HH * 2 * 128 * 128 * 4;
constexpr size_t WS_HS = al256(WS_HKV + SZ_HKV);         constexpr size_t SZ_HS = SZ_HKV;
constexpr size_t WS_HTOT = al256(WS_HS + SZ_HS);         constexpr size_t SZ_HTOT = (size_t)NCHUNK * HH * 2 * 128 * 4;
constexpr size_t WS_TOPE = al256(WS_HTOT + SZ_HTOT);     constexpr size_t SZ_TOP = (size_t)NTOK * TOPK * 4;
constexpr size_t WS_TOPG = al256(WS_TOPE + SZ_TOP);
constexpr size_t WS_TOPR = al256(WS_TOPG + SZ_TOP);
constexpr size_t WS_POS = al256(WS_TOPR + SZ_TOP);
constexpr size_t WS_ROWTOK = al256(WS_POS + SZ_TOP);     constexpr size_t SZ_ROWS = (size_t)NE * NTOK * 4;
constexpr size_t WS_ROWGATE = al256(WS_ROWTOK + SZ_ROWS);
constexpr size_t WS_ACT = al256(WS_ROWGATE + SZ_ROWS);   constexpr size_t SZ_ACT = (size_t)MAXROWS * DM * 2;
constexpr size_t WS_OUT2 = al256(WS_ACT + SZ_ACT);
constexpr size_t WS_WIN = al256(WS_OUT2 + SZ_ACT);       constexpr size_t SZ_WIN = (size_t)DEPTH * NIN * DM * 2;
constexpr size_t WS_WGLU = al256(WS_WIN + SZ_WIN);       constexpr size_t SZ_WGLU = (size_t)DEPTH * 512 * 512 * 2;
constexpr size_t WS_WUP5 = al256(WS_WGLU + SZ_WGLU);     constexpr size_t SZ_WUP = (size_t)DEPTH * 1024 * 512 * 2;
constexpr size_t WS_WUPH = al256(WS_WUP5 + SZ_WUP);
constexpr size_t WS_WOUT = al256(WS_WUPH + SZ_WUP);      constexpr size_t SZ_WOUT = (size_t)DEPTH * 1024 * 1024 * 2;
constexpr size_t WS_W1 = al256(WS_WOUT + SZ_WOUT);       constexpr size_t SZ_W1 = (size_t)DEPTH * NE * 2048 * 1024 * 2;
constexpr size_t WS_W2 = al256(WS_W1 + SZ_W1);           constexpr size_t SZ_W2 = (size_t)DEPTH * NE * 1024 * 1024 * 2;
constexpr size_t WS_HA8 = al256(WS_W2 + SZ_W2);         constexpr size_t SZ_HA8 = (size_t)NTOK * DM;
constexpr size_t WS_ZG8 = al256(WS_HA8 + SZ_HA8);       constexpr size_t SZ_ZG8 = (size_t)NTOK * 2048;
constexpr size_t WS_END = al256(WS_ZG8 + SZ_ZG8);

constexpr int CW_BAR = 0;
constexpr int CW_WQ = 3584;
constexpr int CW_CNT = 4096;
constexpr int CW_WQ2 = 8192;
constexpr size_t WS_PTRS = WS_CTL + 65536;

enum { I_X = 0, I_C, I_CTX, I_CCTX, I_MODW, I_MODB, I_N1G, I_N2G, I_WIN, I_ARE, I_AIM, I_LOGDT, I_BRE, I_BIM, I_CRE, I_CIM, I_S5D, I_WGLU,
       I_LBL, I_HNG, I_WUP5, I_WUPH, I_WOUT, I_RW, I_RB, I_W1, I_B1, I_W2, I_B2, I_FG, N_INPUTS };

struct Params { const float* in[N_INPUTS]; float* out; unsigned char* ws; int ph_lo, ph_hi; };

typedef __bf16 bf16v2 __attribute__((ext_vector_type(2)));
typedef float f32v2 __attribute__((ext_vector_type(2)));
__device__ __forceinline__ unsigned pack2(float a, float b) { const f32v2 v = {a, b}; const bf16v2 r = __builtin_convertvector(v, bf16v2); return __builtin_bit_cast(unsigned, r); }
__device__ __forceinline__ bf16_t f2bf(float f) { return __builtin_bit_cast(unsigned short, (__bf16)f); }
__device__ __forceinline__ float sat_fp8(float x) { return __builtin_amdgcn_fmed3f(x, -448.0f, 448.0f); }
__device__ __forceinline__ unsigned pack4_fp8(float a, float b, float c, float d) { unsigned w = 0u; w = __builtin_amdgcn_cvt_pk_fp8_f32(sat_fp8(a), sat_fp8(b), w, false); w = __builtin_amdgcn_cvt_pk_fp8_f32(sat_fp8(c), sat_fp8(d), w, true); return w; }
__device__ __forceinline__ float bf2f(bf16_t b) { return __uint_as_float(((unsigned)b) << 16); }
__device__ __forceinline__ float bflo(unsigned w) { return __uint_as_float(w << 16); }
__device__ __forceinline__ float bfhi(unsigned w) { return __uint_as_float(w & 0xffff0000u); }
__device__ __forceinline__ f32x4 up4_fp8(unsigned w) { typedef float f32x2v __attribute__((ext_vector_type(2))); const f32x2v lo = __builtin_amdgcn_cvt_pk_f32_fp8(w, false), hi = __builtin_amdgcn_cvt_pk_f32_fp8(w, true); return (f32x4){lo.x, lo.y, hi.x, hi.y}; }
constexpr float HS_SCALE = 32.0f, KV_SCALE = 16.0f;
__device__ __forceinline__ u32x2 fp8x4_to_bf16x4(unsigned w, float sc) { const f32x4 v = up4_fp8(w) * sc; u32x2 o; o.x = pack2(v[0], v[1]); o.y = pack2(v[2], v[3]); return o; }
#ifndef ZG8_FP8
#define ZG8_FP8 1
#endif
constexpr float ZG8_SCALE = 16.0f;
__device__ __forceinline__ float sigmoidf_(float x) { return __builtin_amdgcn_rcpf(1.0f + __builtin_amdgcn_exp2f(-1.4426950408889634f * x)); }
__device__ __forceinline__ float ex2(float x) { return __builtin_amdgcn_exp2f(x); }
__device__ __forceinline__ float lg2(float x) { return __builtin_amdgcn_logf(x); }
__device__ __forceinline__ float sigf(float x) { return __builtin_amdgcn_rcpf(1.0f + ex2(-1.4426950408889634f * x)); }
__device__ __forceinline__ float gelu_tanh(float x) { const float y = 0.7978845608028654f * (x + 0.044715f * x * x * x); return x * __builtin_amdgcn_rcpf(1.0f + __builtin_amdgcn_exp2f(-2.8853900817779268f * y)); }
__device__ __forceinline__ float wave_sum(float v) {
#pragma unroll
    for (int o = 32; o >= 1; o >>= 1) v += __shfl_xor(v, o);
    return v;
}
__device__ __forceinline__ int sigma_row(int r, int odd) {
    if (r >= NLAT || !odd) return r;
    const int b = r >> 14, n = r & 16383; return (b << 14) + ((n & 63) << 8) + (n >> 6);
}
__device__ __forceinline__ int sigma_inv(int s, int odd) {
    if (s >= NLAT || !odd) return s;
    const int b = s >> 14, q = s & 16383; return (b << 14) + ((q & 255) << 6) + (q >> 8);
}

__device__ __forceinline__ int ltid() { int t = threadIdx.x; asm volatile("" : "+v"(t)); return t; }
__device__ __forceinline__ int lbid() { int t = blockIdx.x; asm volatile("" : "+s"(t)); return t; }
#define XB_TMO      128
#define XB_XCNT(j)  (256  + 64 * (j))
#define XB_XSUB(j)  (1280 + 64 * (j))
#define XB_XGEN(j)  (2304 + 64 * (j))
#define XB_TOP      3328
#define XB_TOPGEN   3392
#define XCD_BAR_WORDS 3456
#define XB_SPIN_CAP (1u << 22)
__device__ __forceinline__ unsigned xb_ld(unsigned* p)              { return __hip_atomic_load(p, __ATOMIC_RELAXED, __HIP_MEMORY_SCOPE_AGENT); }
__device__ __forceinline__ unsigned xb_add(unsigned* p, unsigned v) { return __hip_atomic_fetch_add(p, v, __ATOMIC_RELAXED, __HIP_MEMORY_SCOPE_AGENT); }
__device__ __forceinline__ unsigned xb_xcc_id() { return (unsigned)__builtin_amdgcn_s_getreg((3 << 11) | 20) & 0xFu; }
#define XB_SPIN(cond, bar) do { unsigned _sp = 0; while (cond) { __builtin_amdgcn_s_sleep(1); \
    if ((++_sp & 255u) == 0u) { if (xb_ld(&(bar)[XB_TMO])) break; if (_sp > XB_SPIN_CAP) { atomicAdd(&(bar)[XB_TMO], 1u); break; } } } } while (0)
struct XcdBarrier { unsigned* bar; unsigned x; volatile LAS unsigned* st; };
__device__ __forceinline__ XcdBarrier xcd_barrier_post(unsigned* bar, volatile LAS unsigned* st) {
    XcdBarrier b; b.bar = bar; b.x = xb_xcc_id(); b.st = st;
    if (threadIdx.x == 0) (void)xb_add(&bar[XB_XCNT(b.x)], 1u);
    return b;
}
__device__ __forceinline__ void xcd_barrier_complete(unsigned* bar, unsigned x, unsigned& nloc, unsigned& nx) {
    const unsigned G = gridDim.x * gridDim.y * gridDim.z;
    unsigned sum, cnt, mine, sp = 0u;
    for (;;) {
        sum = 0u; cnt = 0u; mine = 0u;
#pragma unroll
        for (unsigned j = 0; j < 16; ++j) { const unsigned c = xb_ld(&bar[XB_XCNT(j)]); sum += c; cnt += (c > 0u) ? 1u : 0u; mine = (j == x) ? c : mine; }
        if (sum == G) break;
        __builtin_amdgcn_s_sleep(1);
        if ((++sp & 255u) == 0u) { if (xb_ld(&bar[XB_TMO])) break; if (sp > XB_SPIN_CAP) { atomicAdd(&bar[XB_TMO], 1u); break; } }
    }
    nloc = mine > 0u ? mine : 1u; nx = cnt > 0u ? cnt : 1u;
}
__device__ __forceinline__ void xcd_barrier(const XcdBarrier& b) {
    asm volatile("s_waitcnt vmcnt(0)" ::: "memory");
    __syncthreads();
    if (threadIdx.x == 0) {
        unsigned* bar = b.bar;
        __builtin_amdgcn_s_waitcnt(0);
        unsigned nloc = b.st[0], nx = b.st[1];
        if (nloc == 0u) { xcd_barrier_complete(bar, b.x, nloc, nx); b.st[0] = nloc; b.st[1] = nx; }
        const unsigned old = xb_add(&bar[XB_XSUB(b.x)], 1u);
        const unsigned gen = old / nloc;
        if (old + 1u == (gen + 1u) * nloc) {
            __builtin_amdgcn_fence(__ATOMIC_RELEASE, "agent");
            asm volatile("s_waitcnt vmcnt(0)" ::: "memory");
            const unsigned og = xb_add(&bar[XB_TOP], 1u);
            const unsigned tg = og / nx;
            if (og + 1u == (tg + 1u) * nx) xb_add(&bar[XB_TOPGEN], 1u);
            else XB_SPIN(xb_ld(&bar[XB_TOPGEN]) == tg, bar);
            __builtin_amdgcn_fence(__ATOMIC_ACQUIRE, "agent");
            xb_add(&bar[XB_XGEN(b.x)], 1u);
            asm volatile("s_waitcnt vmcnt(0)" ::: "memory");
        } else {
            XB_SPIN(xb_ld(&bar[XB_XGEN(b.x)]) == gen, bar);
            __builtin_amdgcn_fence(__ATOMIC_ACQUIRE, "agent");
            asm volatile("s_waitcnt vmcnt(0)" ::: "memory");
        }
    }
    __syncthreads();
}

constexpr int G_ABUF = 32768, G_BBUF = 16384, G_BUF = G_ABUF + G_BBUF;
template <class Epi>
__device__ __forceinline__ void gemm256x128(unsigned char* lds_g, const bf16_t* A, long lda, const int* rowidx, const bf16_t* Bt, long ldb, int K, const Epi& epi) {
    LAS unsigned char* lds = (LAS unsigned char*)lds_g;
    const int tid = ltid(), lane = tid & 63, wid = tid >> 6, wr = wid >> 1, wc = wid & 1, fr = lane & 15, fq = lane >> 4;
    const int r0 = tid >> 3, cg = (tid & 7) ^ (r0 & 7);
    const int wvu = __builtin_amdgcn_readfirstlane(wid);
    const bf16_t* pa[4]; const bf16_t* pb[2];
#pragma unroll
    for (int i = 0; i < 4; ++i) { const int r = r0 + 64 * i; const long rr = rowidx ? (long)rowidx[r] : (long)r; pa[i] = A + rr * lda + cg * 8; }
#pragma unroll
    for (int i = 0; i < 2; ++i) { const int r = r0 + 64 * i; pb[i] = Bt + (long)r * ldb + cg * 8; }
    f32x4 acc[4][4];
#pragma unroll
    for (int m = 0; m < 4; ++m)
#pragma unroll
        for (int n = 0; n < 4; ++n) acc[m][n] = (f32x4){0.f, 0.f, 0.f, 0.f};
    const int nk = K >> 6;
#define G_STAGE(kt, buf) do { \
        _Pragma("unroll") for (int _i = 0; _i < 4; ++_i) __builtin_amdgcn_global_load_lds((const unsigned*)(pa[_i] + (size_t)(kt) * 64), (LAS unsigned*)(lds + (buf) * G_BUF + wvu * 1024 + _i * 8192), 16, 0, 0); \
        _Pragma("unroll") for (int _i = 0; _i < 2; ++_i) __builtin_amdgcn_global_load_lds((const unsigned*)(pb[_i] + (size_t)(kt) * 64), (LAS unsigned*)(lds + (buf) * G_BUF + G_ABUF + wvu * 1024 + _i * 8192), 16, 0, 0); } while (0)
    G_STAGE(0, 0);
    const int arow = wr * 64 + fr, brow = wc * 64 + fr, sw = fr & 7;
    for (int kt = 0; kt < nk; ++kt) {
        const int cur = kt & 1;
        if (kt + 1 < nk) { G_STAGE(kt + 1, cur ^ 1); asm volatile("s_waitcnt vmcnt(6)" ::: "memory"); }
        else asm volatile("s_waitcnt vmcnt(0)" ::: "memory");
        __builtin_amdgcn_s_barrier();
        asm volatile("" ::: "memory");
        const LAS unsigned char* ab = lds + cur * G_BUF; const LAS unsigned char* bb = ab + G_ABUF;
#pragma unroll
        for (int ks = 0; ks < 2; ++ks) {
            bf16x8 af[4], bfr[4];
            const int co = (((ks * 4 + fq) ^ sw) << 4);
#pragma unroll
            for (int m = 0; m < 4; ++m) af[m] = *(const LAS bf16x8*)(ab + (arow + m * 16) * 128 + co);
#pragma unroll
            for (int n = 0; n < 4; ++n) bfr[n] = *(const LAS bf16x8*)(bb + (brow + n * 16) * 128 + co);
#pragma unroll
            for (int m = 0; m < 4; ++m)
#pragma unroll
                for (int n = 0; n < 4; ++n) acc[m][n] = __builtin_amdgcn_mfma_f32_16x16x32_bf16(bfr[n], af[m], acc[m][n], 0, 0, 0);
        }
        asm volatile("s_waitcnt lgkmcnt(0)" ::: "memory");
        __builtin_amdgcn_s_barrier();
        asm volatile("" ::: "memory");
    }
#undef G_STAGE
    epi(acc, wr, wc, fr, fq);
}
template <class E> struct EpiFrag {
    E e;
    __device__ __forceinline__ void operator()(const f32x4 (&acc)[4][4], int wr, int wc, int fr, int fq) const {
#pragma unroll
        for (int m = 0; m < 4; ++m)
#pragma unroll
            for (int n = 0; n < 4; ++n) e.store(wr * 64 + m * 16 + fr, wc * 64 + n * 16 + fq * 4, acc[m][n]);
    }
};
__device__ __forceinline__ void st_bf4(bf16_t* p, f32x4 v) { u32x2 w; w.x = pack2(v[0], v[1]); w.y = pack2(v[2], v[3]); *(u32x2*)p = w; }
__device__ __forceinline__ f32x4 ld_bf4(const bf16_t* p) { const u32x2 w = *(const u32x2*)p; return (f32x4){bflo(w.x), bfhi(w.x), bflo(w.y), bfhi(w.y)}; }

struct EInproj { bf16_t* UA; bf16_t* Z; int m0, n0;
    __device__ __forceinline__ void store(int rl, int cl, f32x4 v) const { const int s = m0 + rl, c = n0 + cl;
        if (c < 512) { const int g = c >> 4, hi = c & 15, rho = s >> 6, j = s & 63; st_bf4(UA + ((size_t)(g * UAROWS + rho) * UALD + j * 16 + hi), v); }
        else st_bf4(Z + (size_t)s * ZC + (c - 512), v); } };
struct ES5E { float* E; int g, m0, n0;
    __device__ __forceinline__ void store(int rl, int cl, f32x4 v) const { const int rho = m0 + rl; if (rho < NCHUNK) *(f32x4*)(E + ((size_t)(g * UAROWS + rho) * 256 + n0 + cl)) = v; } };
struct ES5Y { bf16_t* Z5; int g, m0, n0;
    __device__ __forceinline__ void store(int rl, int cl, f32x4 v) const { const int rho = m0 + rl; if (rho < NCHUNK) { const int col = n0 + cl, j = col >> 4, ho = col & 15;
        f32x4 o; o[0] = gelu_tanh(v[0]); o[1] = gelu_tanh(v[1]); o[2] = gelu_tanh(v[2]); o[3] = gelu_tanh(v[3]); st_bf4(Z5 + ((size_t)(rho * 64 + j) * 512 + g * 16 + ho), o); } } };
struct EGlu { const bf16_t* Z5; bf16_t* Y; int m0, n0;
    __device__ __forceinline__ void store(int rl, int cl, f32x4 v) const { const size_t r = m0 + rl; const int c = n0 + cl; const f32x4 z = ld_bf4(Z5 + r * 512 + c);
        f32x4 o; o[0] = z[0] * sigmoidf_(v[0]); o[1] = z[1] * sigmoidf_(v[1]); o[2] = z[2] * sigmoidf_(v[2]); o[3] = z[3] * sigmoidf_(v[3]); st_bf4(Y + r * DM + c, o); } };
struct EUp5 { const bf16_t* Z; bf16_t* Mb; int m0, n0;
    __device__ __forceinline__ void store(int rl, int cl, f32x4 v) const { const size_t r = m0 + rl; const int c = n0 + cl; const f32x4 z = ld_bf4(Z + r * ZC + Z6 + c);
        f32x4 o; o[0] = sigmoidf_(z[0]) * v[0]; o[1] = sigmoidf_(z[1]) * v[1]; o[2] = sigmoidf_(z[2]) * v[2]; o[3] = sigmoidf_(z[3]) * v[3]; st_bf4(Mb + r * DM + c, o); } };
struct EUph { const bf16_t* Z; bf16_t* Mb; int m0, n0;
    __device__ __forceinline__ void store(int rl, int cl, f32x4 v) const { const size_t r = m0 + rl; const int c = n0 + cl; const f32x4 z = ld_bf4(Z + r * ZC + Z7 + c); const f32x4 p = ld_bf4(Mb + r * DM + c);
        f32x4 o; o[0] = p[0] + sigmoidf_(z[0]) * v[0]; o[1] = p[1] + sigmoidf_(z[1]) * v[1]; o[2] = p[2] + sigmoidf_(z[2]) * v[2]; o[3] = p[3] + sigmoidf_(z[3]) * v[3]; st_bf4(Mb + r * DM + c, o); } };
struct EOut { float* XF; const float* modl; int odd, m0, n0;
    __device__ __forceinline__ void store(int rl, int cl, f32x4 v) const { const int s = m0 + rl, c = n0 + cl; const int r = sigma_inv(s, odd); const int mb = r < NLAT ? (r >> 14) : 2;
        const f32x4 g = *(const f32x4*)(modl + mb * NMOD + 2 * DM + c); float* xp = XF + (size_t)r * DM + c; f32x4 x = *(f32x4*)xp; x += g * v; *(f32x4*)xp = x; } };
struct EMoe2 { bf16_t* O; const float* b2; const float* rgate; int m0, n0;
    __device__ __forceinline__ void store(int rl, int cl, f32x4 v) const { const size_t r = m0 + rl; const int c = n0 + cl; const float g = rgate[r]; const f32x4 b = *(const f32x4*)(b2 + c);
        f32x4 o = (v + b) * g; st_bf4(O + r * DM + c, o); } };
struct EMoe1 { bf16_t* ACT; const float* b1; int m0, pn;
    __device__ __forceinline__ void operator()(const f32x4 (&acc)[4][4], int wr, int wc, int fr, int fq) const {
#pragma unroll
        for (int m = 0; m < 4; ++m)
#pragma unroll
            for (int n = 0; n < 2; ++n) { const size_t r = m0 + wr * 64 + m * 16 + fr; const int ch = pn * 64 + wc * 32 + n * 16 + fq * 4;
                const f32x4 bg = *(const f32x4*)(b1 + ch), bu = *(const f32x4*)(b1 + 1024 + ch); f32x4 o;
#pragma unroll
                for (int j = 0; j < 4; ++j) { float g = acc[m][n][j] + bg[j], u = acc[m][n + 2][j] + bu[j]; g = fminf(g, 7.0f); u = fminf(fmaxf(u, -7.0f), 7.0f); o[j] = g * sigmoidf_(1.702f * g) * (u + 1.0f); }
                st_bf4(ACT + r * DM + ch, o); }
    }
};


#define PROBE_EPI2 0
template <class E> struct epi_dup { static constexpr bool v = false; };
template <class E> struct epi_nst { static constexpr int v = 0; };
namespace g8 {
constexpr int BM = 256, BK = 64, HALF = 128, HTB = HALF * BK * 2, STAGE_BYTES = 8 * HTB;
__device__ __forceinline__ int lds_byte(int r, int c) { const int st = (r >> 4) * 2 + (c >> 5), rr = r & 15, cc = c & 31, ob = rr * 64 + cc * 2; return st * 1024 + (ob ^ (((ob >> 9) & 1) << 5)); }
__device__ __forceinline__ void stage_rc(int b, int& R, int& C) { const int st = b / 1024, sb = b % 1024, swz = sb ^ (((sb >> 9) & 1) << 5); R = (st >> 1) * 16 + swz / 64; C = (st & 1) * 32 + (swz % 64) / 2; }
__device__ __forceinline__ int perm32(int rho) { const int n = rho >> 4, i = rho & 15; return 8 * (i >> 2) + 4 * n + (i & 3); }
struct Unit { const char* a; const char* b; int pm, pn, aux; };
__device__ __forceinline__ i32x8 cat8(bf16x8 lo, bf16x8 hi) { typedef int i32x4 __attribute__((ext_vector_type(4))); const i32x4 a = __builtin_bit_cast(i32x4, lo), b = __builtin_bit_cast(i32x4, hi); return (i32x8){a[0], a[1], a[2], a[3], b[0], b[1], b[2], b[3]}; }
#ifndef G8_SP2
#define G8_SP2 1
#endif
#ifndef G8_ALIGN_EPI
#define G8_ALIGN_EPI 1
#endif
template <bool PERM, bool GATHER, bool FP8 = false, class Sched, class Epi>
__device__ __forceinline__ void gemm_phase(LAS unsigned char* lds, const int K, const unsigned lda_b, const unsigned ldb_b, const Sched& S, const Epi& E) {
    const int tid = ltid(), wid = __builtin_amdgcn_readfirstlane(tid >> 6), lane = tid & 63, wr = wid >> 2, wc = wid & 3, fr = lane & 15, fq = lane >> 4;
    const int nt = K / BK; constexpr int NST = epi_nst<Epi>::v;
    int Rr[2], Cc[2]; unsigned voffB[2], voffA[2][2], voffN[2][2];
#pragma unroll
    for (int i = 0; i < 2; ++i) { stage_rc(tid * 16 + i * 8192, Rr[i], Cc[i]); const int Rb = PERM ? ((Rr[i] & ~31) + perm32(Rr[i] & 31)) : Rr[i];
        voffB[i] = (unsigned)Rb * ldb_b + (unsigned)Cc[i] * 2u; }
    const size_t kstep = (size_t)(BK * 2);
    const size_t hstepB = (size_t)HALF * ldb_b;
    const unsigned ldsw = (unsigned)wid * 1024u;
    const int aoff = lds_byte(wr * 64 + fr, FP8 ? fq * 16 : fq * 8), boff = lds_byte(wc * 32 + fr, FP8 ? fq * 16 : fq * 8);
    constexpr int aoff1 = FP8 ? 16 : 1024, boff1 = aoff1;
#define G8_SA(b, h) (((b) * 2 + (h)) * HTB)
#define G8_SB(b, h) ((4 + (b) * 2 + (h)) * HTB)
#define G8_STAGE(bufoff, gbase, voff) do { _Pragma("unroll") for (int _i = 0; _i < 2; ++_i) \
        __builtin_amdgcn_global_load_lds((const unsigned*)((const char*)(gbase) + (voff)[_i]), (LAS unsigned*)(lds + (bufoff) + ldsw + _i * 8192), 16, 0, 0); } while (0)
#define G8_CAT(p0, p1) __builtin_shufflevector(p0, p1, 0, 1, 2, 3, 4, 5, 6, 7)
#define G8_LO(v) __builtin_bit_cast(bf16x8, __builtin_shufflevector(v, v, 0, 1, 2, 3))
#define G8_HI(v) __builtin_bit_cast(bf16x8, __builtin_shufflevector(v, v, 4, 5, 6, 7))
#define G8_LDA(dst, b, h) do { _Pragma("unroll") for (int m = 0; m < 4; ++m) { const i32x4v p0 = *(const LAS i32x4v*)(lds + G8_SA(b, h) + aoff + m * 2048), p1 = *(const LAS i32x4v*)(lds + G8_SA(b, h) + aoff + m * 2048 + aoff1); dst[m] = G8_CAT(p0, p1); } } while (0)
#define G8_LDB(dst, b, h) do { _Pragma("unroll") for (int n = 0; n < 2; ++n) { const i32x4v p0 = *(const LAS i32x4v*)(lds + G8_SB(b, h) + boff + n * 2048), p1 = *(const LAS i32x4v*)(lds + G8_SB(b, h) + boff + n * 2048 + boff1); dst[n] = G8_CAT(p0, p1); } } while (0)
#define G8_MMA(ai, bj, At, Bt) do { __builtin_amdgcn_s_setprio(1); _Pragma("unroll") for (int m = 0; m < 4; ++m) _Pragma("unroll") for (int n = 0; n < 2; ++n) { \
        if constexpr (FP8) asm volatile("v_mfma_scale_f32_16x16x128_f8f6f4 %0, %1, %2, %0, %3, %3 op_sel_hi:[0,0,0]" : "+v"(acc[ai][bj][m][n]) : "v"(Bt[n]), "v"(At[m]), "v"(one_scale)); \
        else { acc[ai][bj][m][n] = __builtin_amdgcn_mfma_f32_16x16x32_bf16(G8_LO(Bt[n]), G8_LO(At[m]), acc[ai][bj][m][n], 0, 0, 0); \
               acc[ai][bj][m][n] = __builtin_amdgcn_mfma_f32_16x16x32_bf16(G8_HI(Bt[n]), G8_HI(At[m]), acc[ai][bj][m][n], 0, 0, 0); } } \
        __builtin_amdgcn_s_setprio(0); } while (0)
#define G8_WAIT_V(n) asm volatile("s_waitcnt vmcnt(" #n ")" ::: "memory")
#define G8_WAIT_L(n) asm volatile("s_waitcnt lgkmcnt(" #n ")" ::: "memory")
#define G8_WAIT_VR() do { if (NST > 0 && t == 0 && ui > 0) asm volatile("s_waitcnt vmcnt(%0)" :: "i"(8 + NST) : "memory"); else G8_WAIT_V(8); } while (0)
#define G8_BAR __builtin_amdgcn_s_barrier()
#define G8_SCHED __builtin_amdgcn_sched_barrier(0)
#define G8_AOFFS(dst, u) do { _Pragma("unroll") for (int _h = 0; _h < 2; ++_h) _Pragma("unroll") for (int _i = 0; _i < 2; ++_i) { \
        const unsigned _row = GATHER ? min((unsigned)S.rows(u)[_h * HALF + Rr[_i]], (unsigned)(NTOK - 1)) : (unsigned)(_h * HALF + Rr[_i]); dst[_h][_i] = _row * lda_b + (unsigned)Cc[_i] * 2u; } } while (0)
    Unit cur, nxt; int ui = 0;
    if (!S.next(0, cur)) return;
    f32x4 acc[2][2][4][2];
#pragma unroll
    for (int a = 0; a < 2; ++a)
#pragma unroll
        for (int b = 0; b < 2; ++b)
#pragma unroll
            for (int m = 0; m < 4; ++m)
#pragma unroll
                for (int n = 0; n < 2; ++n) acc[a][b][m][n] = (f32x4){0.f, 0.f, 0.f, 0.f};
    i32x8 At[4], B0[2], B1[2];
    int one_scale = 0x7f7f7f7f; asm volatile("" : "+v"(one_scale));
    const char* cA = cur.a; const char* cB = cur.b;
    G8_AOFFS(voffA, cur);
    if (!GATHER) {
#pragma unroll
        for (int _h = 0; _h < 2; ++_h)
#pragma unroll
            for (int _i = 0; _i < 2; ++_i) voffN[_h][_i] = voffA[_h][_i]; }
    if (G8_SP2) {
        G8_STAGE(G8_SB(0, 0), cB, voffB); G8_STAGE(G8_SB(0, 1), cB + hstepB, voffB); G8_STAGE(G8_SA(0, 0), cA, voffA[0]); G8_STAGE(G8_SA(0, 1), cA, voffA[1]);
        if (wr == 1) G8_BAR;
        G8_WAIT_V(2); G8_BAR;
        G8_STAGE(G8_SB(1, 0), cB + kstep, voffB); G8_STAGE(G8_SA(1, 0), cA + kstep, voffA[0]); G8_STAGE(G8_SB(1, 1), cB + hstepB + kstep, voffB);
        G8_WAIT_V(6); G8_BAR;
    } else {
    G8_STAGE(G8_SB(0, 0), cB, voffB); G8_STAGE(G8_SA(0, 0), cA, voffA[0]); G8_STAGE(G8_SB(0, 1), cB + hstepB, voffB); G8_STAGE(G8_SA(0, 1), cA, voffA[1]);
    if (wr == 1) G8_BAR;
    G8_WAIT_V(4); G8_BAR;
    G8_STAGE(G8_SB(1, 0), cB + kstep, voffB); G8_STAGE(G8_SA(1, 0), cA + kstep, voffA[0]); G8_STAGE(G8_SB(1, 1), cB + hstepB + kstep, voffB);
    G8_WAIT_V(6); G8_BAR;
    }
    for (;;) {
        const bool has_next = S.next(ui + 1, nxt);
        const char* nA = has_next ? nxt.a : cA; const char* nB = has_next ? nxt.b : cB;
        if (GATHER) { if (has_next) { G8_AOFFS(voffN, nxt); } else {
#pragma unroll
            for (int _h = 0; _h < 2; ++_h)
#pragma unroll
                for (int _i = 0; _i < 2; ++_i) voffN[_h][_i] = voffA[_h][_i]; } }
#pragma nounroll
        for (int t = 0; t < nt; t += 2) {
            const bool last = (t == nt - 2);
            const char* a1 = cA + (size_t)(t + 1) * kstep;
            const char* a2 = last ? nA : cA + (size_t)(t + 2) * kstep; const char* b2 = last ? nB : cB + (size_t)(t + 2) * kstep;
            const char* a3 = a2 + kstep; const char* b3 = b2 + kstep;
            unsigned vA0[2], vA1[2];
#pragma unroll
            for (int _i = 0; _i < 2; ++_i) { vA0[_i] = (GATHER && last) ? voffN[0][_i] : voffA[0][_i]; vA1[_i] = (GATHER && last) ? voffN[1][_i] : voffA[1][_i]; }
            if (G8_SP2) {
            G8_LDB(B0, 0, 0); G8_LDB(B1, 0, 1); G8_SCHED; G8_LDA(At, 0, 0); G8_STAGE(G8_SA(1, 1), a1, voffA[1]);
            G8_WAIT_VR(); G8_WAIT_L(0); G8_BAR; G8_MMA(0, 0, At, B0); G8_MMA(0, 1, At, B1); G8_BAR; G8_SCHED;
            G8_LDA(At, 0, 1); G8_STAGE(G8_SB(0, 0), b2, voffB); G8_STAGE(G8_SB(0, 1), b2 + hstepB, voffB); G8_STAGE(G8_SA(0, 0), a2, vA0);
            G8_WAIT_VR(); G8_WAIT_L(0); G8_BAR; G8_MMA(1, 0, At, B0); G8_MMA(1, 1, At, B1); G8_BAR; G8_SCHED;
            G8_LDB(B0, 1, 0); G8_LDB(B1, 1, 1); G8_SCHED; G8_LDA(At, 1, 0); G8_STAGE(G8_SA(0, 1), a2, vA1);
            G8_WAIT_V(8); G8_WAIT_L(0); G8_BAR; G8_MMA(0, 0, At, B0); G8_MMA(0, 1, At, B1); G8_BAR; G8_SCHED;
            G8_LDA(At, 1, 1); G8_STAGE(G8_SB(1, 0), b3, voffB); G8_STAGE(G8_SB(1, 1), b3 + hstepB, voffB); G8_STAGE(G8_SA(1, 0), a3, vA0);
            G8_WAIT_V(8); G8_WAIT_L(0); G8_BAR; G8_MMA(1, 0, At, B0); G8_MMA(1, 1, At, B1); G8_BAR; G8_SCHED;
            } else {
            G8_LDB(B0, 0, 0); G8_SCHED; G8_LDA(At, 0, 0); G8_STAGE(G8_SA(1, 1), a1, voffA[1]);
            G8_WAIT_L(8); G8_BAR; G8_WAIT_L(0); G8_MMA(0, 0, At, B0); G8_BAR; G8_SCHED;
            G8_LDB(B1, 0, 1); G8_STAGE(G8_SB(0, 0), b2, voffB);
            G8_BAR; G8_WAIT_L(0); G8_MMA(0, 1, At, B1); G8_BAR;
            G8_LDA(At, 0, 1); G8_STAGE(G8_SA(0, 0), a2, vA0);
            G8_BAR; G8_WAIT_L(0); G8_MMA(1, 0, At, B0); G8_BAR; G8_SCHED;
            G8_STAGE(G8_SB(0, 1), b2 + hstepB, voffB);
            G8_WAIT_V(6); G8_BAR; G8_MMA(1, 1, At, B1); G8_BAR;
            G8_LDB(B0, 1, 0); G8_SCHED; G8_LDA(At, 1, 0); G8_STAGE(G8_SA(0, 1), a2, vA1);
            G8_WAIT_L(8); G8_BAR; G8_WAIT_L(0); G8_MMA(0, 0, At, B0); G8_BAR; G8_SCHED;
            G8_LDB(B1, 1, 1); G8_STAGE(G8_SB(1, 0), b3, voffB);
            G8_BAR; G8_WAIT_L(0); G8_MMA(0, 1, At, B1); G8_BAR;
            G8_LDA(At, 1, 1); G8_STAGE(G8_SA(1, 0), a3, vA0);
            G8_BAR; G8_WAIT_L(0); G8_MMA(1, 0, At, B0); G8_BAR; G8_SCHED;
            G8_STAGE(G8_SB(1, 1), b3 + hstepB, voffB);
            G8_WAIT_V(6); G8_BAR; G8_MMA(1, 1, At, B1); G8_BAR;
            }
        }
        if (G8_ALIGN_EPI) { if (wr == 0) G8_BAR; }
        asm volatile("" ::: "memory");
        E(acc, cur, wr, wc, fr, fq);
#if PROBE_EPI2
        if (epi_dup<Epi>::v) { asm volatile("" ::: "memory"); E(acc, cur, wr, wc, fr, fq); }
#endif
        if (!has_next) break;
#pragma unroll
        for (int a = 0; a < 2; ++a)
#pragma unroll
            for (int b = 0; b < 2; ++b)
#pragma unroll
                for (int m = 0; m < 4; ++m)
#pragma unroll
                    for (int n = 0; n < 2; ++n) acc[a][b][m][n] = (f32x4){0.f, 0.f, 0.f, 0.f};
        cur = nxt; cA = nA; cB = nB; ++ui;
        if (GATHER) {
#pragma unroll
            for (int _h = 0; _h < 2; ++_h)
#pragma unroll
                for (int _i = 0; _i < 2; ++_i) voffA[_h][_i] = voffN[_h][_i]; }
        if (G8_ALIGN_EPI) { if (wr == 1) G8_BAR; }
    }
    G8_WAIT_V(0);
    if (!G8_ALIGN_EPI) { if (wr == 0) G8_BAR; }
    G8_BAR;
#undef G8_SA
#undef G8_SB
#undef G8_STAGE
#undef G8_LDA
#undef G8_CAT
#undef G8_LO
#undef G8_HI
#undef G8_LDB
#undef G8_MMA
#undef G8_WAIT_V
#undef G8_WAIT_L
#undef G8_WAIT_VR
#undef G8_BAR
#undef G8_SCHED
#undef G8_AOFFS
}
template <class E> struct Epi8 { E e;
    __device__ __forceinline__ void operator()(const f32x4 (&acc)[2][2][4][2], const Unit& u, int wr, int wc, int fr, int fq) const {
#pragma unroll
        for (int ai = 0; ai < 2; ++ai)
#pragma unroll
            for (int m = 0; m < 4; ++m) {
#pragma unroll
                for (int bj = 0; bj < 2; ++bj) e.store8(u, ai * 128 + wr * 64 + m * 16 + fr, bj * 128 + wc * 32 + fq * 8, acc[ai][bj][m][0], acc[ai][bj][m][1]);
                asm volatile("" ::: "memory"); } } };
template <class E> struct Epi4 { E e;
    __device__ __forceinline__ void operator()(const f32x4 (&acc)[2][2][4][2], const Unit& u, int wr, int wc, int fr, int fq) const {
#pragma unroll
        for (int ai = 0; ai < 2; ++ai)
#pragma unroll
            for (int m = 0; m < 4; ++m) {
#pragma unroll
                for (int bj = 0; bj < 2; ++bj)
#pragma unroll
                    for (int n = 0; n < 2; ++n) e.store4(u, ai * 128 + wr * 64 + m * 16 + fr, bj * 128 + wc * 32 + n * 16 + fq * 4, acc[ai][bj][m][n]);
                asm volatile("" ::: "memory"); } } };
struct GridOrder { const char* A; const char* B; size_t tstepA, tstepB; int nM, nN, nwg, G, c;
    __device__ __forceinline__ bool next(int i, Unit& u) const {
        const long L = (long)i * G + c; if (L >= nwg) return false;
        int wgid = (int)L; { const int q = nwg / 8, r = nwg % 8, xcd = wgid % 8, off = wgid / 8; wgid = (xcd < r ? xcd * (q + 1) : r * (q + 1) + (xcd - r) * q) + off; }
        const int nig = 8 * nN, gid = wgid / nig, fm = gid * 8, gsz = (nM - fm) < 8 ? (nM - fm) : 8;
        u.pm = fm + ((wgid % nig) % gsz); u.pn = (wgid % nig) / gsz; u.a = A + (size_t)u.pm * tstepA; u.b = B + (size_t)u.pn * tstepB; u.aux = 0; return true; }
    __device__ __forceinline__ const int* rows(const Unit&) const { return nullptr; } };
}
__device__ __forceinline__ void st_bf8(bf16_t* p, f32x4 a, f32x4 b) { u32x4 w; w.x = pack2(a[0], a[1]); w.y = pack2(a[2], a[3]); w.z = pack2(b[0], b[1]); w.w = pack2(b[2], b[3]); *(u32x4*)p = w; }
__device__ __forceinline__ void ld_bf8(const bf16_t* p, f32x4& a, f32x4& b) { const u32x4 w = *(const u32x4*)p; a = (f32x4){bflo(w.x), bfhi(w.x), bflo(w.y), bfhi(w.y)}; b = (f32x4){bflo(w.z), bfhi(w.z), bflo(w.w), bfhi(w.w)}; }
__device__ __forceinline__ f32x4 sig4(f32x4 z) { return (f32x4){sigmoidf_(z[0]), sigmoidf_(z[1]), sigmoidf_(z[2]), sigmoidf_(z[3])}; }

struct F8Inproj { bf16_t* UA; bf16_t* Z; unsigned char* ZG8;
    __device__ __forceinline__ void operator()(const f32x4 (&acc)[2][2][4][2], const g8::Unit& u, int wr, int wc, int fr, int fq) const {
        const int s0 = u.pm * 256 + wr * 64 + fr, c0 = wc * 32 + fq * 8;
        if (u.pn < 2) {
#pragma unroll
            for (int ai = 0; ai < 2; ++ai)
#pragma unroll
                for (int m = 0; m < 4; ++m) { const int s = s0 + ai * 128 + m * 16, rho = s >> 6, j = s & 63;
#pragma unroll
                    for (int bj = 0; bj < 2; ++bj) { const int c = u.pn * 256 + bj * 128 + c0, g = c >> 4, hi = c & 15;
                        st_bf8(UA + ((size_t)(g * UAROWS + rho) * UALD + j * 16 + hi), acc[ai][bj][m][0], acc[ai][bj][m][1]); }
                    asm volatile("" ::: "memory"); } }
        else if (ZG8_FP8 && u.pn >= (512 + Z6) / 256) { unsigned char* zp = ZG8 + (size_t)s0 * 2048 + (u.pn * 256 + c0 - 512 - Z6);
#pragma unroll
            for (int ai = 0; ai < 2; ++ai)
#pragma unroll
                for (int m = 0; m < 4; ++m) { unsigned char* zr = zp + (size_t)(ai * 128 + m * 16) * 2048;
#pragma unroll
                    for (int bj = 0; bj < 2; ++bj) { const f32x4 v0 = acc[ai][bj][m][0] * ZG8_SCALE, v1 = acc[ai][bj][m][1] * ZG8_SCALE; u32x2 w8; w8.x = pack4_fp8(v0[0], v0[1], v0[2], v0[3]); w8.y = pack4_fp8(v1[0], v1[1], v1[2], v1[3]);
                        *(u32x2*)(zr + bj * 128) = w8; } } }
        else { bf16_t* zp = Z + (size_t)s0 * ZC + (u.pn * 256 + c0 - 512);
#pragma unroll
            for (int ai = 0; ai < 2; ++ai)
#pragma unroll
                for (int m = 0; m < 4; ++m) { bf16_t* zr = zp + (size_t)(ai * 128 + m * 16) * ZC;
                    st_bf8(zr, acc[ai][0][m][0], acc[ai][0][m][1]); st_bf8(zr + 128, acc[ai][1][m][0], acc[ai][1][m][1]); } }
    } };
struct F8S5E { float* E;
    __device__ __forceinline__ void store4(const g8::Unit& u, int rl, int cl, f32x4 v) const { const int rho = u.pm * 256 + rl; if (rho < NCHUNK) *(f32x4*)(E + ((size_t)(u.aux * UAROWS + rho) * 256 + cl)) = v; } };
struct F8S5Y { bf16_t* Z5;
    __device__ __forceinline__ void store8(const g8::Unit& u, int rl, int cl, f32x4 v0, f32x4 v1) const { const int rho = u.pm * 256 + rl; if (rho < NCHUNK) { const int col = u.pn * 256 + cl, j = col >> 4, ho = col & 15;
        f32x4 a, b;
#pragma unroll
        for (int k = 0; k < 4; ++k) { a[k] = gelu_tanh(v0[k]); b[k] = gelu_tanh(v1[k]); }
        st_bf8(Z5 + ((size_t)(rho * 64 + j) * 512 + u.aux * 16 + ho), a, b); } } };
struct F8Glu { const bf16_t* Z5; bf16_t* Y;
    __device__ __forceinline__ void store8(const g8::Unit& u, int rl, int cl, f32x4 v0, f32x4 v1) const { const size_t r = u.pm * 256 + rl; const int c = u.pn * 256 + cl; f32x4 z0, z1; ld_bf8(Z5 + r * 512 + c, z0, z1);
        st_bf8(Y + r * DM + c, z0 * sig4(v0), z1 * sig4(v1)); } };
struct F8Up5 { const bf16_t* Z; bf16_t* Mb; const unsigned char* ZG8;
    __device__ __forceinline__ void store8(const g8::Unit& u, int rl, int cl, f32x4 v0, f32x4 v1) const { const size_t r = u.pm * 256 + rl; const int c = u.pn * 256 + cl; f32x4 z0, z1;
        if (ZG8_FP8) { const u32x2 w = *(const u32x2*)(ZG8 + r * 2048 + c); z0 = up4_fp8(w.x) * (1.0f / ZG8_SCALE); z1 = up4_fp8(w.y) * (1.0f / ZG8_SCALE); } else ld_bf8(Z + r * ZC + Z6 + c, z0, z1);
        st_bf8(Mb + r * DM + c, sig4(z0) * v0, sig4(z1) * v1); } };
struct F8Uph { const bf16_t* Z; bf16_t* Mb; bf16_t* Mo; const unsigned char* ZG8;
    __device__ __forceinline__ void store8(const g8::Unit& u, int rl, int cl, f32x4 v0, f32x4 v1) const { const size_t r = u.pm * 256 + rl; const int c = u.pn * 256 + cl; f32x4 z0, z1, p0, p1;
        if (ZG8_FP8) { const u32x2 w = *(const u32x2*)(ZG8 + r * 2048 + (Z7 - Z6) + c); z0 = up4_fp8(w.x) * (1.0f / ZG8_SCALE); z1 = up4_fp8(w.y) * (1.0f / ZG8_SCALE); } else ld_bf8(Z + r * ZC + Z7 + c, z0, z1);
        ld_bf8(Mb + r * DM + c, p0, p1);
        st_bf8(Mo + r * DM + c, p0 + sig4(z0) * v0, p1 + sig4(z1) * v1); } };
struct F8Out { bf16_t* XF; const float* modl; int odd;
    __device__ __forceinline__ void operator()(const f32x4 (&acc)[2][2][4][2], const g8::Unit& u, int wr, int wc, int fr, int fq) const {
        const int s0 = u.pm * 256 + wr * 64 + fr, c0 = u.pn * 256 + wc * 32 + fq * 8;
        const int mb = u.pm < NLAT / 256 ? (u.pm >> 6) : 2;
        const float* gp = modl + mb * NMOD + 2 * DM + c0; f32x4 g[2][2];
#pragma unroll
        for (int bj = 0; bj < 2; ++bj) { g[bj][0] = *(const f32x4*)(gp + bj * 128); g[bj][1] = *(const f32x4*)(gp + bj * 128 + 4); }
#pragma unroll
        for (int ai = 0; ai < 2; ++ai)
#pragma unroll
            for (int m = 0; m < 4; ++m) { const int r = sigma_inv(s0 + ai * 128 + m * 16, odd); bf16_t* xp = XF + (size_t)r * DM + c0;
#pragma unroll
                for (int bj = 0; bj < 2; ++bj) { f32x4 x0, x1; ld_bf8(xp + bj * 128, x0, x1); x0 += g[bj][0] * acc[ai][bj][m][0]; x1 += g[bj][1] * acc[ai][bj][m][1];
                    st_bf8(xp + bj * 128, x0, x1); }
                if (m & 1) asm volatile("" ::: "memory"); }
    } };
constexpr float M2S = MOE2_FP8 ? 1.0f / (FP8_WSCALE * FP8_ASCALE) : 1.0f;
#ifndef OUT2_FP8
#define OUT2_FP8 1
#endif
constexpr float OUT2_SCALE = 32.0f;

struct F8Moe2 { bf16_t* O; const float* b2; const float* rgate; const int* ps;
    __device__ __forceinline__ void operator()(const f32x4 (&acc)[2][2][4][2], const g8::Unit& u, int wr, int wc, int fr, int fq) const {
        const size_t r0 = (size_t)u.pm * 256 + wr * 64 + fr; const int c0 = u.pn * 256 + wc * 32 + fq * 8;
        const float* bp = b2 + (size_t)u.aux * 1024 + c0; f32x4 b[2][2];
#pragma unroll
        for (int bj = 0; bj < 2; ++bj) { b[bj][0] = *(const f32x4*)(bp + bj * 128); b[bj][1] = *(const f32x4*)(bp + bj * 128 + 4); }
        float gt[2][4]; const float* gr = rgate + (size_t)u.aux * NTOK + (u.pm * 256 - ps[u.aux]) + wr * 64 + fr;
#pragma unroll
        for (int ai = 0; ai < 2; ++ai)
#pragma unroll
            for (int m = 0; m < 4; ++m) gt[ai][m] = gr[ai * 128 + m * 16];
#pragma unroll
        for (int ai = 0; ai < 2; ++ai)
#pragma unroll
            for (int m = 0; m < 4; ++m) { bf16_t* op = O + (r0 + ai * 128 + m * 16) * DM + c0; const float g = gt[ai][m] * (OUT2_FP8 ? OUT2_SCALE : 1.0f);
#pragma unroll
                for (int bj = 0; bj < 2; ++bj) { const f32x4 v0 = (acc[ai][bj][m][0] * M2S + b[bj][0]) * g, v1 = (acc[ai][bj][m][1] * M2S + b[bj][1]) * g;
                    if (OUT2_FP8) { u32x2 w8; w8.x = pack4_fp8(v0[0], v0[1], v0[2], v0[3]); w8.y = pack4_fp8(v1[0], v1[1], v1[2], v1[3]);
                        *(u32x2*)((unsigned char*)O + (r0 + ai * 128 + m * 16) * DM + c0 + bj * 128) = w8; }
                    else st_bf8(op + bj * 128, v0, v1); } }
    } };
struct F8Moe1 { bf16_t* ACT; const float* b1;
    __device__ __forceinline__ void operator()(const f32x4 (&acc)[2][2][4][2], const g8::Unit& u, int wr, int wc, int fr, int fq) const {
        typedef float f32x2 __attribute__((ext_vector_type(2)));
        constexpr float SC = 1.0f / (FP8_WSCALE * FP8_ASCALE), AS = MOE2_FP8 ? FP8_ASCALE : 1.0f;
        const int ch = u.pn * 128 + wc * 32 + fq * 8; const float* bp = b1 + (size_t)u.aux * 2048 + ch; f32x4 bg[2], bu[2];
#pragma unroll
        for (int n = 0; n < 2; ++n) { bg[n] = *(const f32x4*)(bp + n * 4); bu[n] = (*(const f32x4*)(bp + 1024 + n * 4) + 1.0f) * AS; }
        bf16_t* ap = ACT + ((size_t)u.pm * 256 + wr * 64 + fr) * DM + ch;
#pragma unroll
        for (int ai = 0; ai < 2; ++ai)
#pragma unroll
            for (int m = 0; m < 4; ++m) { f32x2 o[2][2];
#pragma unroll
                for (int n = 0; n < 2; ++n)
#pragma unroll
                    for (int q = 0; q < 2; ++q) { const f32x2 ag = {acc[ai][0][m][n][2 * q], acc[ai][0][m][n][2 * q + 1]}, au = {acc[ai][1][m][n][2 * q], acc[ai][1][m][n][2 * q + 1]};
                        const f32x2 bg2 = {bg[n][2 * q], bg[n][2 * q + 1]}, bu2 = {bu[n][2 * q], bu[n][2 * q + 1]};
                        f32x2 g = ag * SC + bg2, uu = au * (SC * AS) + bu2;
                        g.x = fminf(g.x, 7.0f); g.y = fminf(g.y, 7.0f); uu.x = __builtin_amdgcn_fmed3f(uu.x, -6.0f * AS, 8.0f * AS); uu.y = __builtin_amdgcn_fmed3f(uu.y, -6.0f * AS, 8.0f * AS);
                        const f32x2 t = g * (-1.702f * 1.4426950408889634f); f32x2 e = {__builtin_amdgcn_exp2f(t.x), __builtin_amdgcn_exp2f(t.y)}; e = e + 1.0f;
                        const f32x2 r = {__builtin_amdgcn_rcpf(e.x), __builtin_amdgcn_rcpf(e.y)};
                        o[n][q] = g * r * uu; }
                if (MOE2_FP8) { u32x2 w8; unsigned w = 0u;
                    w = __builtin_amdgcn_cvt_pk_fp8_f32(o[0][0].x, o[0][0].y, w, false); w = __builtin_amdgcn_cvt_pk_fp8_f32(o[0][1].x, o[0][1].y, w, true); w8.x = w; w = 0u;
                    w = __builtin_amdgcn_cvt_pk_fp8_f32(o[1][0].x, o[1][0].y, w, false); w = __builtin_amdgcn_cvt_pk_fp8_f32(o[1][1].x, o[1][1].y, w, true); w8.y = w;
                    *(u32x2*)((unsigned char*)ACT + ((size_t)u.pm * 256 + wr * 64 + fr + ai * 128 + m * 16) * DM + ch) = w8; }
                else st_bf8(ap + (size_t)(ai * 128 + m * 16) * DM, (f32x4){o[0][0].x, o[0][0].y, o[0][1].x, o[0][1].y}, (f32x4){o[1][0].x, o[1][0].y, o[1][1].x, o[1][1].y}); }
    } };
template <> struct epi_nst<F8Inproj> { static constexpr int v = 16; };
template <> struct epi_nst<g8::Epi8<F8Glu>> { static constexpr int v = 16; };
template <> struct epi_nst<g8::Epi8<F8Up5>> { static constexpr int v = 16; };
template <> struct epi_nst<g8::Epi8<F8Uph>> { static constexpr int v = 16; };
template <> struct epi_nst<F8Out> { static constexpr int v = 16; };
template <> struct epi_nst<F8Moe1> { static constexpr int v = 8; };
template <> struct epi_nst<F8Moe2> { static constexpr int v = 16; };
struct S5Order { const char* A; const char* B; size_t gstepA, gstepB; unsigned lda_b, ldb_b; int MT, NT, G, c;
    __device__ __forceinline__ bool next(int i, g8::Unit& u) const { int g, r;
        if ((G & 7) == 0) { const int x = c & 7, per = G >> 3, e = i * per + (per - 1 - (c >> 3)); if (e >= 4 * MT * NT) return false; g = x + 8 * (e / (MT * NT)); r = e % (MT * NT); }
        else { const int L = i * G + (G - 1 - c); if (L >= S5G * MT * NT) return false; g = L / (MT * NT); r = L % (MT * NT); }
        const int mt = r / NT, nt = r % NT;
        u.pm = mt; u.pn = nt; u.aux = g; u.a = A + (size_t)g * gstepA + (size_t)mt * 256 * lda_b; u.b = B + (size_t)g * gstepB + (size_t)nt * 256 * ldb_b; return true; }
    __device__ __forceinline__ const int* rows(const g8::Unit&) const { return nullptr; } };
struct MoeOrder { const char* A; const char* B; const int* rowtok; const int* te; unsigned estepB; int NT, ntile, G, c; bool gather; unsigned tstepB = 256 * DM * 2;
    __device__ __forceinline__ bool next(int i, g8::Unit& u) const { const int x = c & 7, slot = c >> 3; int t, pn;
        if (G != 256) { const int L = i * G + c; t = L / NT; pn = L % NT; } else if (NT == 4) { t = i * 64 + x * 8 + (slot >> 2); pn = slot & 3; } else { t = i * 32 + (x >> 1) * 8 + (slot >> 2); pn = (x & 1) * 4 + (slot & 3); }
        if (t >= ntile) return false; const int e = te[t];
        u.pm = t; u.pn = pn; u.aux = e; u.a = gather ? A : A + (size_t)t * tstepB; u.b = B + (size_t)e * estepB + (size_t)pn * tstepB; return true; }
    __device__ __forceinline__ const int* rows(const g8::Unit& u) const { return rowtok + (size_t)u.aux * NTOK + (u.pm * 256 - te[u.aux - 64]); } };

template <bool WIDE = false>
__device__ __forceinline__ void norm_mod_row(f32x4 (&x)[4], const float* g, const float* shift, const float* scale, int lane) {
    float ss = 0.f;
#pragma unroll
    for (int k = 0; k < 4; ++k) ss += x[k][0] * x[k][0] + x[k][1] * x[k][1] + x[k][2] * x[k][2] + x[k][3] * x[k][3];
    ss = wave_sum(ss);
    const float rstd = rsqrtf(ss * (1.0f / DM) + EPS);
#pragma unroll
    for (int k = 0; k < 4; ++k) { const int c = WIDE ? lane * 16 + k * 4 : lane * 4 + k * 256; const f32x4 gg = *(const f32x4*)(g + c), sh = *(const f32x4*)(shift + c), sc = *(const f32x4*)(scale + c);
        x[k] = x[k] * rstd * gg * (sc + 1.0f) + sh; }
}

typedef float2 c32;
constexpr int S5T_PW = 2 * 64 * 65, S5T_BB = 2 * 64 * 16, S5T_CC = 2 * 16 * 64, S5T_ALL = S5T_PW + S5T_BB + S5T_CC;
static __device__ __forceinline__ void s5_stage1(unsigned char* ws, const float* const* tab, unsigned char* lds_g, int l, int g) {
    c32* pw = (c32*)lds_g;
    c32* bb = pw + S5T_PW;
    c32* cc = bb + S5T_BB;
    const int tid = ltid();
    const float* a_re = tab[I_ARE]; const float* a_im = tab[I_AIM]; const float* ldt = tab[I_LOGDT];
    for (int idx = tid; idx < S5T_PW; idx += NTHREADS) { const int n = idx % 65, p = (idx / 65) & 63, d = idx / (65 * 64);
        const int gi = (l * 2 + d) * S5G + g; const double are = a_re[gi * 64 + p], aim = a_im[gi * 64 + p], dt = exp((double)ldt[gi]);
        const double mag = exp(are * dt * n), ang = aim * dt * n; pw[idx] = make_float2((float)(mag * cos(ang)), (float)(mag * sin(ang))); }
    for (int idx = tid; idx < S5T_BB; idx += NTHREADS) { const int hi = idx & 15, p = (idx >> 4) & 63, d = idx >> 10;
        const int gi = (l * 2 + d) * S5G + g; const double are = a_re[gi * 64 + p], aim = a_im[gi * 64 + p], dt = exp((double)ldt[gi]);
        const double mag = exp(are * dt), lbr = mag * cos(aim * dt), lbi = mag * sin(aim * dt), den = are * are + aim * aim, nr = lbr - 1.0;
        const double qr = (nr * are + lbi * aim) / den, qi = (lbi * are - nr * aim) / den;
        const double br = tab[I_BRE][(size_t)(gi * 64 + p) * 16 + hi], bi = tab[I_BIM][(size_t)(gi * 64 + p) * 16 + hi];
        bb[idx] = make_float2((float)(qr * br - qi * bi), (float)(qr * bi + qi * br)); }
    for (int idx = tid; idx < S5T_CC; idx += NTHREADS) { const int p = idx & 63, ho = (idx >> 6) & 15, d = idx >> 10;
        const int gi = (l * 2 + d) * S5G + g; cc[idx] = make_float2(tab[I_CRE][(size_t)(gi * 16 + ho) * 64 + p], tab[I_CIM][(size_t)(gi * 16 + ho) * 64 + p]); }
    __syncthreads();
    c32* gsc = (c32*)(ws + WS_S5T) + (size_t)(l * S5G + g) * S5T_ALL;
    for (int idx = tid; idx < S5T_ALL; idx += NTHREADS) gsc[idx] = pw[idx];
    if (tid < 128) { const int d = tid >> 6, p = tid & 63; ((c32*)(ws + WS_LAMT))[((l * 2 + d) * S5G + g) * 64 + p] = pw[(d * 64 + p) * 65 + 64]; }
    { const int hi = tid & 15, ho = (tid >> 4) & 15, d = tid >> 8; float gr[64], gim[64];
#pragma unroll
      for (int p = 0; p < 64; ++p) { const c32 c = cc[(d * 16 + ho) * 64 + p], b = bb[(d * 64 + p) * 16 + hi]; gr[p] = c.x * b.x - c.y * b.y; gim[p] = c.x * b.y + c.y * b.x; }
      float* KT = (float*)(ws + WS_KT) + (size_t)(l * S5G + g) * 2 * 64 * 256 + d * 64 * 256 + ho * 16 + hi;
      for (int dl = 0; dl < 64; ++dl) { float s = 0.f;
#pragma unroll
          for (int p = 0; p < 64; ++p) { const c32 w = pw[(d * 64 + p) * 65 + dl]; s += gr[p] * w.x - gim[p] * w.y; if ((p & 15) == 15) asm volatile("" ::: "memory"); }
          KT[dl * 256] = s; } }
    __syncthreads();
}
static __device__ __forceinline__ void s5_stage2(unsigned char* ws, const float* const* tab, unsigned char* lds_g, int l, int g, int rq) {
    c32* pw = (c32*)lds_g; c32* bb = pw + S5T_PW; c32* cc = bb + S5T_BB;
    const int tid = ltid();
    const c32* gsc = (const c32*)(ws + WS_S5T) + (size_t)(l * S5G + g) * S5T_ALL;
    for (int idx = tid; idx < S5T_ALL; idx += NTHREADS) pw[idx] = gsc[idx];
    __syncthreads();
    const float* KT = (const float*)(ws + WS_KT) + (size_t)(l * S5G + g) * 2 * 64 * 256;
    const float* dsk = tab[I_S5D] + l * 512 + g * 16;
    bf16_t* BT2 = (bf16_t*)(ws + WS_BT2) + (size_t)(l * S5G + g) * 1024 * UALD;
    for (int ck = tid; ck < 256 * 160; ck += NTHREADS) { const int row = rq * 256 + ck / 160, c8 = ck % 160, j = row >> 4, ho = row & 15; float v[8];
        if (c8 < 128) { const int i = c8 >> 1, hi0 = (c8 & 1) * 8;
#pragma unroll
            for (int q = 0; q < 8; ++q) v[q] = 0.f;
            if (j >= i) { const f32x4 a = *(const f32x4*)(KT + ((0 * 64 + (j - i)) * 16 + ho) * 16 + hi0), b = *(const f32x4*)(KT + ((0 * 64 + (j - i)) * 16 + ho) * 16 + hi0 + 4);
#pragma unroll
                for (int q = 0; q < 4; ++q) { v[q] += a[q]; v[4 + q] += b[q]; } }
            if (i >= j) { const f32x4 a = *(const f32x4*)(KT + ((1 * 64 + (i - j)) * 16 + ho) * 16 + hi0), b = *(const f32x4*)(KT + ((1 * 64 + (i - j)) * 16 + ho) * 16 + hi0 + 4);
#pragma unroll
                for (int q = 0; q < 4; ++q) { v[q] += a[q]; v[4 + q] += b[q]; } }
            if (i == j) {
#pragma unroll
                for (int q = 0; q < 8; ++q) if (hi0 + q == ho) v[q] += dsk[ho]; } }
        else { const int kap0 = (c8 - 128) * 8, d = kap0 >> 7, ri = (kap0 >> 6) & 1, p0 = kap0 & 63, n = d == 0 ? j + 1 : 64 - j;
#pragma unroll
            for (int q = 0; q < 8; ++q) { const int p = p0 + q; const c32 c = cc[(d * 16 + ho) * 64 + p], w = pw[(d * 64 + p) * 65 + n];
                const float re = c.x * w.x - c.y * w.y, im = c.x * w.y + c.y * w.x; v[q] = ri == 0 ? re : -im; } }
        u32x4 o; o.x = pack2(v[0], v[1]); o.y = pack2(v[2], v[3]); o.z = pack2(v[4], v[5]); o.w = pack2(v[6], v[7]);
        *(u32x4*)(BT2 + (size_t)row * UALD + c8 * 8) = o; }
    bf16_t* BT1 = (bf16_t*)(ws + WS_BT1) + (size_t)(l * S5G + g) * 256 * 1024;
    for (int ck = tid; ck < 64 * 128; ck += NTHREADS) { const int kap = rq * 64 + (ck >> 7), c8 = ck & 127, d = kap >> 7, ri = (kap >> 6) & 1, p = kap & 63, i = c8 >> 1, hi0 = (c8 & 1) * 8;
        const int n = d == 0 ? 63 - i : i; const c32 w = pw[(d * 64 + p) * 65 + n]; float v[8];
#pragma unroll
        for (int q = 0; q < 8; ++q) { const c32 b = bb[(d * 64 + p) * 16 + hi0 + q]; const float re = w.x * b.x - w.y * b.y, im = w.x * b.y + w.y * b.x; v[q] = ri == 0 ? re : im; }
        u32x4 o; o.x = pack2(v[0], v[1]); o.y = pack2(v[2], v[3]); o.z = pack2(v[4], v[5]); o.w = pack2(v[6], v[7]);
        *(u32x4*)(BT1 + (size_t)kap * 1024 + c8 * 8) = o; }
    __syncthreads();
}

constexpr int CVP = 66;
template <int MAPW1>
__device__ __forceinline__ void conv_run(unsigned char* lds_g, const float* src, int K, int N, bf16_t* dst, int R0, int k0, int nst) {
    const int tid = ltid(), lane = tid & 63, w = tid >> 6;
    const int n4 = (w & 3) * 16 + (lane & 15), kpl = (lane >> 4) + 4 * (w >> 2);
    const int Rl = 4 * n4; const int R = R0 + Rl;
    const int sc = MAPW1 ? ((Rl & 128) ? 1024 : 0) + (R0 >> 8) * 128 + (Rl & 127) : R;
    const float* sp = src + (size_t)(k0 + 2 * kpl) * N + sc;
    f32x4 A[8], B[8];
#define CV_LOAD(X, kt) do { _Pragma("unroll") for (int p = 0; p < 4; ++p) { const float* q = sp + (size_t)((kt) * 64 + 16 * p) * N; X[2 * p] = *(const f32x4*)q; X[2 * p + 1] = *(const f32x4*)(q + N); } } while (0)
#define CV_EMIT(X, kt, buf) do { unsigned* T = (unsigned*)(lds_g + (buf) * 256 * CVP * 2); \
        _Pragma("unroll") for (int p = 0; p < 4; ++p) _Pragma("unroll") for (int i = 0; i < 4; ++i) T[(Rl + i) * (CVP / 2) + kpl + 8 * p] = pack2(X[2 * p][i], X[2 * p + 1][i]); \
        __syncthreads(); \
        _Pragma("unroll") for (int j = 0; j < 4; ++j) { const int piece = tid + j * 512, n = piece >> 3, c = piece & 7; const unsigned* tp = T + n * (CVP / 2) + c * 4; \
            u32x4 o; o.x = tp[0]; o.y = tp[1]; o.z = tp[2]; o.w = tp[3]; *(u32x4*)(dst + (size_t)(R0 + n) * K + k0 + (kt) * 64 + c * 8) = o; } } while (0)
    CV_LOAD(A, 0);
    for (int kt = 0; kt < nst; kt += 2) {
        if (kt + 1 < nst) CV_LOAD(B, kt + 1);
        CV_EMIT(A, kt, 0);
        if (kt + 1 < nst) { if (kt + 2 < nst) CV_LOAD(A, kt + 2); CV_EMIT(B, kt + 1, 1); }
    }
    __syncthreads();
#undef CV_LOAD
#undef CV_EMIT
}

template <int MAPW1>
__device__ __forceinline__ void conv_run8(unsigned char* lds_g, const float* src, int K, int N, unsigned char* dst, int R0, int k0, int nst) {
    const int tid = ltid(), lane = tid & 63, w = tid >> 6;
    const int n4 = (w & 3) * 16 + (lane & 15), kql = (lane >> 4) + 4 * (w >> 2);
    const int Rl = 4 * n4;
    const int sc = MAPW1 ? ((Rl & 128) ? 1024 : 0) + (R0 >> 8) * 128 + (Rl & 127) : R0 + Rl;
    const float* sp = src + (size_t)(k0 + 4 * kql) * N + sc;
    f32x4 A[8], B[8];
#define CV8_LOAD(X, kt) do { _Pragma("unroll") for (int p = 0; p < 2; ++p) _Pragma("unroll") for (int q = 0; q < 4; ++q) X[4 * p + q] = *(const f32x4*)(sp + (size_t)((kt) * 64 + 32 * p + q) * N); } while (0)
#define CV8_EMIT(X, kt, buf) do { unsigned* T = (unsigned*)(lds_g + (buf) * 256 * 17 * 4); \
        _Pragma("unroll") for (int p = 0; p < 2; ++p) _Pragma("unroll") for (int i = 0; i < 4; ++i) \
            T[(Rl + i) * 17 + kql + 8 * p] = pack4_fp8(X[4 * p][i] * FP8_WSCALE, X[4 * p + 1][i] * FP8_WSCALE, X[4 * p + 2][i] * FP8_WSCALE, X[4 * p + 3][i] * FP8_WSCALE); \
        __syncthreads(); \
        _Pragma("unroll") for (int j = 0; j < 2; ++j) { const int piece = tid + j * 512, n = piece >> 2, c = piece & 3; const unsigned* tp = T + n * 17 + c * 4; \
            u32x4 o; o.x = tp[0]; o.y = tp[1]; o.z = tp[2]; o.w = tp[3]; *(u32x4*)(dst + (size_t)(R0 + n) * K + k0 + (kt) * 64 + c * 16) = o; } } while (0)
    CV8_LOAD(A, 0);
    for (int kt = 0; kt < nst; kt += 2) {
        if (kt + 1 < nst) CV8_LOAD(B, kt + 1);
        CV8_EMIT(A, kt, 0);
        if (kt + 1 < nst) { if (kt + 2 < nst) CV8_LOAD(A, kt + 2); CV8_EMIT(B, kt + 1, 1); }
    }
    __syncthreads();
#undef CV8_LOAD
#undef CV8_EMIT
}

constexpr int CVK = 4;
constexpr int PQ_S5 = DEPTH * S5G, PQ_MOD = DEPTH * 96;
constexpr int CVI_WIN = (NIN / 256) * (DM / 64 / CVK), CVI_GLU = 2 * (512 / 64 / CVK), CVI_UP = 4 * (512 / 64 / CVK), CVI_OUT = 4 * (1024 / 64 / CVK);
constexpr int CVI_LAYER = CVI_WIN + CVI_GLU + 2 * CVI_UP + CVI_OUT;
constexpr int CVI_W1 = 8 * (1024 / 64 / CVK), CVI_W2 = 4 * (1024 / 64 / CVK);
constexpr int PQ_CONV = CVI_LAYER + NE * (CVI_W1 + CVI_W2);
constexpr int PQ_XF = NTOK / 256, PQ_LB = 1;
constexpr int PQ_TOTAL = PQ_S5 + PQ_MOD + PQ_CONV + PQ_XF + PQ_LB;

constexpr int CVI_PER_LAYER = CVI_LAYER + NE * (CVI_W1 + CVI_W2);
static __device__ __forceinline__ void conv_item(unsigned char* ws, const float* const* tab, unsigned char* lds_g, int l, int w) {
    if (w < CVI_WIN) { conv_run<0>(lds_g, tab[I_WIN] + (size_t)l * DM * NIN, DM, NIN, (bf16_t*)(ws + WS_WIN) + (size_t)l * NIN * DM, (w >> 2) * 256, (w & 3) * 64 * CVK, CVK); return; }
    w -= CVI_WIN;
    if (w < CVI_GLU) { conv_run<0>(lds_g, tab[I_WGLU] + (size_t)l * 512 * 512, 512, 512, (bf16_t*)(ws + WS_WGLU) + (size_t)l * 512 * 512, (w >> 1) * 256, (w & 1) * 64 * CVK, CVK); return; }
    w -= CVI_GLU;
    if (w < CVI_UP) { conv_run<0>(lds_g, tab[I_WUP5] + (size_t)l * 512 * 1024, 512, 1024, (bf16_t*)(ws + WS_WUP5) + (size_t)l * 1024 * 512, (w >> 1) * 256, (w & 1) * 64 * CVK, CVK); return; }
    w -= CVI_UP;
    if (w < CVI_UP) { conv_run<0>(lds_g, tab[I_WUPH] + (size_t)l * 512 * 1024, 512, 1024, (bf16_t*)(ws + WS_WUPH) + (size_t)l * 1024 * 512, (w >> 1) * 256, (w & 1) * 64 * CVK, CVK); return; }
    w -= CVI_UP;
    if (w < CVI_OUT) { conv_run<0>(lds_g, tab[I_WOUT] + (size_t)l * 1024 * 1024, 1024, 1024, (bf16_t*)(ws + WS_WOUT) + (size_t)l * 1024 * 1024, (w >> 2) * 256, (w & 3) * 64 * CVK, CVK); return; }
    w -= CVI_OUT;
    const int le = l * NE + w / (CVI_W1 + CVI_W2); w = w % (CVI_W1 + CVI_W2);
    if (w < CVI_W1) { if (MOE1_FP8) conv_run8<1>(lds_g, tab[I_W1] + (size_t)le * 1024 * 2048, 1024, 2048, (unsigned char*)(ws + WS_W1) + (size_t)le * 2048 * 1024, (w >> 2) * 256, (w & 3) * 64 * CVK, CVK);
        else conv_run<1>(lds_g, tab[I_W1] + (size_t)le * 1024 * 2048, 1024, 2048, (bf16_t*)(ws + WS_W1) + (size_t)le * 2048 * 1024, (w >> 2) * 256, (w & 3) * 64 * CVK, CVK); }
    else { w -= CVI_W1; if (MOE2_FP8) conv_run8<0>(lds_g, tab[I_W2] + (size_t)le * 1024 * 1024, 1024, 1024, (unsigned char*)(ws + WS_W2) + (size_t)le * 1024 * 1024, (w >> 2) * 256, (w & 3) * 64 * CVK, CVK);
        else conv_run<0>(lds_g, tab[I_W2] + (size_t)le * 1024 * 1024, 1024, 1024, (bf16_t*)(ws + WS_W2) + (size_t)le * 1024 * 1024, (w >> 2) * 256, (w & 3) * 64 * CVK, CVK); }
}
static __device__ __forceinline__ void conv_steal(unsigned char* ws, const float* const* tab, unsigned char* lds_g, int L, int nmax) {
    int* wq = (int*)(lds_g + LDS_BYTES - 64);
    unsigned* ctr = (unsigned*)(ws + WS_CTL) + CW_WQ2 + (L * 8) * 64;
    int x = lbid() & 7, tries = 0;
    for (int n = 0; n < nmax && tries < 8; ) {
        __syncthreads();
        if (ltid() == 0) *wq = (int)atomicAdd(ctr + x * 64, 1u);
        __syncthreads();
        const int v = *wq * 8 + x;
        if (v >= CVI_PER_LAYER) { x = (x + 1) & 7; ++tries; if (nmax < 8) break; continue; }
        conv_item(ws, tab, lds_g, L, v); ++n;
    }
    __syncthreads();
}
static __device__ __forceinline__ void phase_prologue(unsigned char* ws, const float* const* tab, unsigned char* lds_g, int qslot) {
    const int tid = ltid(), lane = tid & 63, wid = tid >> 6;
    float* lsf = (float*)lds_g;
    int* wq = (int*)(lds_g + LDS_BYTES - 64);
    unsigned* ctr = (unsigned*)(ws + WS_CTL) + CW_WQ + 64 * (qslot ? 5 : 0);
    for (;;) {
        __syncthreads();
        if (tid == 0) *wq = (int)atomicAdd(ctr, 1u);
        __syncthreads();
        int v = *wq;
        if (v >= PQ_TOTAL) break;
        if (v < PQ_S5) { s5_stage1(ws, tab, lds_g, v / S5G, v % S5G); continue; }
        v -= PQ_S5;
        if (v < PQ_MOD) {
            const int l = v / 96, j = (v % 96) * 64 + (tid & 63), ks = tid >> 6;
            const float* mw = tab[I_MODW] + (size_t)l * DM * NMOD; float a0 = 0.f, a1 = 0.f, a2 = 0.f;
#pragma unroll 8
            for (int k = ks * 128; k < ks * 128 + 128; ++k) { const float w = mw[(size_t)k * NMOD + j]; const float c0 = tab[I_C][k], c1 = tab[I_C][DM + k], c2 = tab[I_CCTX][k];
                a0 += c0 * sigmoidf_(c0) * w; a1 += c1 * sigmoidf_(c1) * w; a2 += c2 * sigmoidf_(c2) * w; }
            lsf[(ks * 3 + 0) * 64 + (tid & 63)] = a0; lsf[(ks * 3 + 1) * 64 + (tid & 63)] = a1; lsf[(ks * 3 + 2) * 64 + (tid & 63)] = a2;
            __syncthreads();
            if (tid < 192) { const int r = tid >> 6, c = tid & 63; float s = 0.f;
#pragma unroll
                for (int k = 0; k < 8; ++k) s += lsf[(k * 3 + r) * 64 + c];
                const int jj = (v % 96) * 64 + c; ((float*)(ws + WS_MOD))[(size_t)(l * 3 + r) * NMOD + jj] = s + tab[I_MODB][l * NMOD + jj]; }
            continue; }
        v -= PQ_MOD;
        if (v < PQ_CONV) { conv_item(ws, tab, lds_g, 0, v); continue; }
        v -= PQ_CONV;
        if (v < PQ_XF) {
#pragma unroll 4
            for (int rr = 0; rr < 32; ++rr) { const int r = v * 256 + rr * 8 + wid; const float* sp = r < NLAT ? tab[I_X] + (size_t)r * DM : tab[I_CTX] + (size_t)(r - NLAT) * DM;
#pragma unroll
                for (int k = 0; k < 4; ++k) st_bf4((bf16_t*)(ws + WS_XF) + (size_t)r * DM + lane * 4 + k * 256, *(const f32x4*)(sp + lane * 4 + k * 256)); }
            continue; }
        {
#pragma unroll
            for (int hh = 0; hh < 2; ++hh) { const int idx = hh * 512 + tid, d = idx >> 9, ch = idx & 511; const float* lg = tab[I_LBL] + (size_t)d * (DEPTH + 1) * 512 + ch;
                float e[DEPTH + 1], mx = -1e30f, s = 0.f;
#pragma unroll
                for (int k = 0; k <= DEPTH; ++k) { e[k] = lg[k * 512]; mx = fmaxf(mx, e[k]); }
#pragma unroll
                for (int k = 0; k <= DEPTH; ++k) { e[k] = expf(e[k] - mx); s += e[k]; }
                float cum = 0.f;
#pragma unroll
                for (int k = 0; k < DEPTH; ++k) { cum += e[k] / s; ((float*)(ws + WS_LB))[(d * DEPTH + k) * 512 + ch] = cum; } } }
    }
}

static __device__ __forceinline__ void phase_norm1(unsigned char* ws, const float* const* tab, unsigned char* lds_g, int l) {
    if (l == 0) for (int u = lbid(); u < DEPTH * S5G * 4; u += gridDim.x) s5_stage2(ws, tab, lds_g, u / (S5G * 4), (u >> 2) & (S5G - 1), u & 3);
    const int tid = ltid(), lane = tid & 63, wid = tid >> 6; const int odd = l & 1;
    const float* MODl = (const float*)(ws + WS_MOD) + (size_t)l * 3 * NMOD;
    for (int u = lbid(); u < NTOK / 8; u += gridDim.x) { const int r = u * 8 + wid; const int mb = r < NLAT ? (r >> 14) : 2;
        f32x4 x[4];
#pragma unroll
        for (int k = 0; k < 4; ++k) x[k] = *(const f32x4*)((r < NLAT ? tab[I_X] + (size_t)r * DM : tab[I_CTX] + (size_t)(r - NLAT) * DM) + lane * 4 + k * 256);
        norm_mod_row(x, tab[I_N1G] + l * DM, MODl + mb * NMOD, MODl + mb * NMOD + DM, lane);
        bf16_t* hp = (bf16_t*)(ws + WS_HA) + (size_t)sigma_row(r, odd) * DM;
#pragma unroll
        for (int k = 0; k < 4; ++k) st_bf4(hp + lane * 4 + k * 256, x[k]); }
}

__device__ __forceinline__ int chunk_at(int b, int d, int s) {
    if (s < 4) return 512 + b * 4 + (d ? 3 - s : s);
    const int c = s - 4; return b * 256 + (d ? 255 - c : c);
}

constexpr int HP = 136, HPT = 72;
__device__ __forceinline__ bf16x8 lds_frag(const bf16_t* p) { return *(const bf16x8*)p; }
__device__ __forceinline__ void deal3(int c, int c1, int c2, int n0, int n1, int n2, int total, int& first, int& last) {
    int s = c < c1 ? c * n0 : (c < c2 ? c1 * n0 + (c - c1) * n1 : c1 * n0 + (c2 - c1) * n1 + (c - c2) * n2);
    int n = c < c1 ? n0 : (c < c2 ? n1 : n2);
    first = s; last = s + n; if (last > total) last = total; if (first > total) first = total;
}
__device__ __forceinline__ void hgrn_local_phase(unsigned char* ws, unsigned char* lds_g, int l) {
    bf16_t* KT = (bf16_t*)lds_g;
    bf16_t* VT = KT + 2 * 128 * HPT;
    float* qs = (float*)(VT + 128 * HPT);
    const int tid = ltid(), lane = tid & 63, wid = tid >> 6, dk = tid & 127, qt = tid >> 7, fr = lane & 15, fq = lane >> 4, G = gridDim.x;
    const int nunits = NCHUNK * HH;
    int u, uend; if (G == 256) deal3(lbid(), 128, 160, 9, 8, 7, nunits, u, uend); else { const int per = (nunits + G - 1) / G; u = lbid() * per; uend = u + per < nunits ? u + per : nunits; }
    if (u >= uend) return;
    const bf16_t* Zb = (const bf16_t*)(ws + WS_Z);
    unsigned short rf[2][16]; u32x4 vraw[2];
#define HL_LOADRAW(uu) do { const int rho_ = (uu) >> 2, h_ = (uu) & 3; const bf16_t* Zr = Zb + (size_t)rho_ * 64 * ZC + h_ * 128; \
        _Pragma("unroll") for (int jj = 0; jj < 16; ++jj) { const bf16_t* zj = Zr + (size_t)jj * ZC; rf[0][jj] = zj[loff + ZFF]; rf[1][jj] = zj[loff + ZFB]; } \
        _Pragma("unroll") for (int k = 0; k < 2; ++k) { const int idx = tid + k * 512, s = idx >> 4, dvg = idx & 15; vraw[k] = *(const u32x4*)(Zr + (size_t)s * ZC + ZI + dvg * 8); } } while (0)
    const int loff = qt * 16 * ZC + dk;
    HL_LOADRAW(u);
    for (; u < uend; ++u) {
        const int rho = u >> 2, h = u & 3;
        float lf[2][16], kk[2][16];
#pragma unroll
        for (int d = 0; d < 2; ++d) { const float lb = ((const float*)(ws + WS_LB))[(d * DEPTH + l) * 512 + h * 128 + dk]; float qsum = 1.f;
#pragma unroll
            for (int jj = 0; jj < 16; ++jj) { const float f = bf2f(rf[d][jj]); const float sg = sigf(f);
                lf[d][jj] = lb + (1.0f - lb) * sg; kk[d][jj] = (1.0f - lb) * (1.0f - sg); qsum *= lf[d][jj]; }
            qs[(d * 4 + qt) * 128 + dk] = qsum; }
#pragma unroll
        for (int k = 0; k < 2; ++k) { const int idx = tid + k * 512, s = idx >> 4, dvg = idx & 15; const unsigned ww[4] = {vraw[k].x, vraw[k].y, vraw[k].z, vraw[k].w};
#pragma unroll
            for (int i = 0; i < 4; ++i) { VT[(dvg * 8 + 2 * i) * HPT + s] = (bf16_t)(ww[i] & 0xffffu); VT[(dvg * 8 + 2 * i + 1) * HPT + s] = (bf16_t)(ww[i] >> 16); } }
        if (u + 1 < uend) HL_LOADRAW(u + 1);
        __syncthreads();
#pragma unroll
        for (int d = 0; d < 2; ++d) { float after = 1.f, tot = 0.f;
#pragma unroll
            for (int k = 0; k < 4; ++k) { const float s = qs[(d * 4 + k) * 128 + dk]; tot += lg2(s); if (d == 0 ? (k > qt) : (k < qt)) after *= s; }
            float kh[16];
            if (d == 0) { float run = after;
#pragma unroll
                for (int jj = 15; jj >= 0; --jj) { kh[jj] = kk[d][jj] * run; run *= lf[d][jj]; } }
            else { float run = after;
#pragma unroll
                for (int jj = 0; jj < 16; ++jj) { kh[jj] = kk[d][jj] * run; run *= lf[d][jj]; } }
            u32x4 o0, o1; o0.x = pack2(kh[0], kh[1]); o0.y = pack2(kh[2], kh[3]); o0.z = pack2(kh[4], kh[5]); o0.w = pack2(kh[6], kh[7]);
            o1.x = pack2(kh[8], kh[9]); o1.y = pack2(kh[10], kh[11]); o1.z = pack2(kh[12], kh[13]); o1.w = pack2(kh[14], kh[15]);
            bf16_t* kp = KT + (d * 128 + dk) * HPT + qt * 16; *(u32x4*)kp = o0; *(u32x4*)(kp + 8) = o1;
            if (qt == 0) ((float*)(ws + WS_HTOT))[((size_t)(rho * HH + h) * 2 + d) * 128 + dk] = tot; }
        __syncthreads();
#pragma unroll
        for (int d = 0; d < 2; ++d) { f32x4 acc[8];
#pragma unroll
            for (int n = 0; n < 8; ++n) acc[n] = (f32x4){0.f, 0.f, 0.f, 0.f};
#pragma unroll
            for (int ks = 0; ks < 2; ++ks) { const bf16x8 a = lds_frag(KT + (d * 128 + wid * 16 + fr) * HPT + ks * 32 + fq * 8);
#pragma unroll
                for (int n = 0; n < 8; ++n) { const bf16x8 b = lds_frag(VT + (n * 16 + fr) * HPT + ks * 32 + fq * 8); acc[n] = __builtin_amdgcn_mfma_f32_16x16x32_bf16(a, b, acc[n], 0, 0, 0); } }
            unsigned char* KV = (unsigned char*)(ws + WS_HKV) + ((size_t)(rho * HH + h) * 2 + d) * 16384;
#pragma unroll
            for (int n = 0; n < 8; ++n) *(unsigned*)(KV + (n * 16 + fr) * 128 + wid * 16 + fq * 4) = pack4_fp8(acc[n][0] * KV_SCALE, acc[n][1] * KV_SCALE, acc[n][2] * KV_SCALE, acc[n][3] * KV_SCALE); }
        __syncthreads();
    }
#undef HL_LOADRAW
}
__device__ __forceinline__ void hgrn_carry2(unsigned char* ws, int u) {
    const int eb = u & 15, d = (u >> 4) & 1, h = (u >> 5) & 3, b = u >> 7; const int e2 = eb * 512 + ltid(), dkp = e2 & 63;
    const unsigned short* KV = (const unsigned short*)(ws + WS_HKV); const float* TOT = (const float*)(ws + WS_HTOT); unsigned short* HS = (unsigned short*)(ws + WS_HS);
    float S0 = 0.f, S1 = 0.f;
    for (int s0 = 0; s0 < 260; s0 += 13) { unsigned kv[13]; float t0[13], t1[13]; unsigned si[13];
#pragma unroll
        for (int k = 0; k < 13; ++k) { si[k] = (unsigned)((chunk_at(b, d, s0 + k) * HH + h) * 2 + d); kv[k] = KV[(size_t)si[k] * 8192 + e2]; const float2 tt = *(const float2*)(TOT + (size_t)si[k] * 128 + 2 * dkp); t0[k] = tt.x; t1[k] = tt.y; }
#pragma unroll
        for (int k = 0; k < 13; ++k) { typedef float f32x2v __attribute__((ext_vector_type(2))); const f32x2v kf = __builtin_amdgcn_cvt_pk_f32_fp8(kv[k], false);
            HS[(size_t)si[k] * 8192 + e2] = (unsigned short)__builtin_amdgcn_cvt_pk_fp8_f32(sat_fp8(S0 * HS_SCALE), sat_fp8(S1 * HS_SCALE), 0u, false);
            S0 = ex2(t0[k]) * S0 + kf.x * (1.0f / KV_SCALE); S1 = ex2(t1[k]) * S1 + kf.y * (1.0f / KV_SCALE); } }
}
__device__ __forceinline__ void hgrn_out_phase(unsigned char* ws, const float* const* tab, unsigned char* lds_g, int l) {
    bf16_t* Qa = (bf16_t*)lds_g;
    bf16_t* Qi = Qa + 64 * HP;
    bf16_t* Kd = Qi + 32 * HP;
    bf16_t* Ko = Kd + 64 * HP;
    bf16_t* ST = Ko + 32 * HP;
    bf16_t* VT = ST + 128 * HP;
    bf16_t* Pm = VT + 128 * HPT;
    float* qs = (float*)(Pm + 64 * HPT);
    float* ssq = qs + 1024;
    const int tid = ltid(), lane = tid & 63, wid = tid >> 6, fr = lane & 15, fq = lane >> 4, G = gridDim.x;
    const int dp2 = 2 * lane, rg = __builtin_amdgcn_readfirstlane(wid);
    const int nunits = (l == DEPTH - 1 ? NLAT / CH : NCHUNK) * HH;
    int u, uend;
    if (G == 256 && l == DEPTH - 1) { u = lbid() * 8; uend = u + 8; }
    else if (G == 256) { const int c = lbid(); if (c < 128) deal3(c, 64, 128, 10, 9, 0, nunits, u, uend); else { deal3(c - 128, 96, 128, 7, 6, 0, nunits - 1216, u, uend); u += 1216; uend += 1216; } }
    else { const int per = (nunits + G - 1) / G; u = lbid() * per; uend = u + per < nunits ? u + per : nunits; }
    if (u >= uend) return;
    const bf16_t* Zb = (const bf16_t*)(ws + WS_Z);
    const int tt0 = wid >> 2, st = wid & 3;
    const int ot = wid & 3, oh = wid >> 2;
    unsigned rq[8], rf[2][8];
#define HO_LOADRAW(uu) do { const int rho_ = (uu) >> 2, h_ = (uu) & 3; const bf16_t* Zr = Zb + (size_t)rho_ * 64 * ZC + h_ * 128 + (size_t)(rg * 8) * ZC; \
        _Pragma("unroll") for (int jj = 0; jj < 8; ++jj) { const bf16_t* zj = Zr + (size_t)jj * ZC; rq[jj] = *(const unsigned*)(zj + ZQ + dp2); rf[0][jj] = *(const unsigned*)(zj + ZFF + dp2); rf[1][jj] = *(const unsigned*)(zj + ZFB + dp2); } } while (0)
    u32x4 vraw[2], sraw[2];
#define HO_LOADVS(uu) do { const int rho_ = (uu) >> 2, h_ = (uu) & 3; const bf16_t* Zv = Zb + (size_t)rho_ * 64 * ZC + ZI + h_ * 128; \
        _Pragma("unroll") for (int k = 0; k < 2; ++k) { const int idx = tid + k * 512, s_ = idx >> 4, dvg = idx & 15; vraw[k] = *(const u32x4*)(Zv + (size_t)s_ * ZC + dvg * 8); } \
        const u32x4* sp_ = (const u32x4*)((const unsigned char*)(ws + WS_HS) + ((size_t)(rho_ * HH + h_) * 2) * 16384); \
        _Pragma("unroll") for (int k = 0; k < 2; ++k) sraw[k] = sp_[tid + k * 512]; } while (0)
    HO_LOADRAW(u); HO_LOADVS(u);
    for (; u < uend; ++u) {
        const int rho = u >> 2, h = u & 3;
        const bf16_t* Z = Zb + (size_t)rho * 64 * ZC;
        u32x4 sbw[2]; u32x2 graw[4];
        const u32x4* sp0 = (const u32x4*)((const unsigned char*)(ws + WS_HS) + ((size_t)(rho * HH + h) * 2) * 16384);
        float qv0[8], qv1[8];
#pragma unroll
        for (int jj = 0; jj < 8; ++jj) { qv0[jj] = bflo(rq[jj]); qv1[jj] = bfhi(rq[jj]); }
        f32x4 O[4], Pk[2];
#pragma unroll
        for (int n = 0; n < 4; ++n) O[n] = (f32x4){0.f, 0.f, 0.f, 0.f};
        Pk[0] = Pk[1] = (f32x4){0.f, 0.f, 0.f, 0.f};
#pragma unroll
        for (int d = 0; d < 2; ++d) {
            const float2 lb2 = *(const float2*)((const float*)(ws + WS_LB) + (d * DEPTH + l) * 512 + h * 128 + dp2);
            float g0[8], g1[8], k0[8], k1[8], pr0 = 1.f, pr1 = 1.f;
#pragma unroll
            for (int jj = 0; jj < 8; ++jj) { const float s0 = sigf(bflo(rf[d][jj])), s1 = sigf(bfhi(rf[d][jj]));
                g0[jj] = lb2.x + (1.0f - lb2.x) * s0; k0[jj] = (1.0f - lb2.x) * (1.0f - s0); pr0 *= g0[jj];
                g1[jj] = lb2.y + (1.0f - lb2.y) * s1; k1[jj] = (1.0f - lb2.y) * (1.0f - s1); pr1 *= g1[jj]; }
            if (d == 1) __syncthreads();
            *(float2*)(qs + rg * 128 + dp2) = make_float2(pr0, pr1);
#pragma unroll
            for (int k = 0; k < 2; ++k) { const int idx = tid + k * 512, r = idx >> 3, c = idx & 7; const u32x4 w = d == 0 ? sraw[k] : sbw[k];
                const u32x2 q0 = fp8x4_to_bf16x4(w.x, 1.0f / HS_SCALE), q1 = fp8x4_to_bf16x4(w.y, 1.0f / HS_SCALE), q2 = fp8x4_to_bf16x4(w.z, 1.0f / HS_SCALE), q3 = fp8x4_to_bf16x4(w.w, 1.0f / HS_SCALE);
                *(u32x4*)(ST + r * HP + c * 16) = (u32x4){q0.x, q0.y, q1.x, q1.y}; *(u32x4*)(ST + r * HP + c * 16 + 8) = (u32x4){q2.x, q2.y, q3.x, q3.y}; }
            if (d == 0) {
#pragma unroll
                for (int k = 0; k < 2; ++k) sbw[k] = sp0[1024 + tid + k * 512];
#pragma unroll
                for (int n = 0; n < 4; ++n) graw[n] = *(const u32x2*)(Z + (size_t)(ot * 16 + fr) * ZC + ZG + h * 128 + (oh * 4 + n) * 16 + fq * 4); }
            if (d == 0) {
#pragma unroll
                for (int k = 0; k < 2; ++k) { const int idx = tid + k * 512, s = idx >> 4, dvg = idx & 15; const unsigned ww[4] = {vraw[k].x, vraw[k].y, vraw[k].z, vraw[k].w};
#pragma unroll
                    for (int i = 0; i < 4; ++i) { VT[(dvg * 8 + 2 * i) * HPT + s] = (bf16_t)(ww[i] & 0xffffu); VT[(dvg * 8 + 2 * i + 1) * HPT + s] = (bf16_t)(ww[i] >> 16); } } }
            __syncthreads();
            float b10 = 1.f, b11 = 1.f, R0 = 1.f, R1 = 1.f;
#pragma unroll
            for (int g = 0; g < 8; ++g) { const float2 gp = *(const float2*)(qs + g * 128 + dp2);
                const bool first = d == 0 ? (g < 4) : (g >= 4);
                const bool before = d == 0 ? (g >= (rg & ~3) && g < rg) : (g > rg && g <= (rg | 3));
                if (first) { b10 *= gp.x; b11 *= gp.y; }
                if (before) { R0 *= gp.x; R1 *= gp.y; } }
            const bool later = d == 0 ? (rg >= 4) : (rg < 4);
            float Ri0 = __builtin_amdgcn_rcpf(R0), Ri1 = __builtin_amdgcn_rcpf(R1);
#pragma unroll
            for (int jx = 0; jx < 8; ++jx) { const int jj = d == 0 ? jx : 7 - jx; const int j = rg * 8 + jj;
                R0 *= g0[jj]; R1 *= g1[jj]; Ri0 *= __builtin_amdgcn_rcpf(g0[jj]); Ri1 *= __builtin_amdgcn_rcpf(g1[jj]);
                const float qa0 = qv0[jj] * R0, qa1 = qv1[jj] * R1, kd0 = k0[jj] * Ri0, kd1 = k1[jj] * Ri1;
                *(unsigned*)(Qa + j * HP + dp2) = pack2(qa0, qa1); *(unsigned*)(Kd + j * HP + dp2) = pack2(kd0, kd1);
                if (later) *(unsigned*)(Qi + (j & 31) * HP + dp2) = pack2(qa0 * b10, qa1 * b11); else *(unsigned*)(Ko + (j & 31) * HP + dp2) = pack2(kd0 * b10, kd1 * b11); }
            if (d == 1) { asm volatile("" ::: "memory"); if (u + 1 < uend) { HO_LOADRAW(u + 1); HO_LOADVS(u + 1); } }
            __syncthreads();
#pragma unroll
            for (int pp = 0; pp < 2; ++pp) { const int tt = tt0 + 2 * pp; const bool need = d == 0 ? (st <= tt) : (st >= tt);
                if (need) { const bool same = (tt >> 1) == (st >> 1); const bf16_t* Kt = same ? Kd + (st * 16) * HP : Ko + ((st & 1) * 16) * HP; f32x4 D = (f32x4){0.f, 0.f, 0.f, 0.f};
#pragma unroll
                    for (int ks = 0; ks < 4; ++ks) D = __builtin_amdgcn_mfma_f32_16x16x32_bf16(lds_frag(Kt + fr * HP + ks * 32 + fq * 8), lds_frag(Qa + (tt * 16 + fr) * HP + ks * 32 + fq * 8), D, 0, 0, 0);
                    if (tt == st) {
#pragma unroll
                        for (int r = 0; r < 4; ++r) { const int sl = fq * 4 + r; const bool keep = d == 0 ? (sl <= fr) : (sl >= fr); if (!keep) D[r] = 0.f; } }
                    Pk[pp] += D; } }
            if (d == 1) {
#pragma unroll
                for (int pp = 0; pp < 2; ++pp) { const int tt = tt0 + 2 * pp; st_bf4(Pm + (tt * 16 + fr) * HPT + st * 16 + fq * 4, Pk[pp]); } }
            { const bool useQi = d == 0 ? (ot >= 2) : (ot < 2); const bf16_t* Qx = useQi ? Qi + ((ot & 1) * 16) * HP : Qa + (ot * 16) * HP;
#pragma unroll
              for (int ks = 0; ks < 4; ++ks) { const bf16x8 bq = lds_frag(Qx + fr * HP + ks * 32 + fq * 8);
#pragma unroll
                for (int n = 0; n < 4; ++n) O[n] = __builtin_amdgcn_mfma_f32_16x16x32_bf16(lds_frag(ST + ((oh * 4 + n) * 16 + fr) * HP + ks * 32 + fq * 8), bq, O[n], 0, 0, 0); } }
        }
        __syncthreads();
#pragma unroll
        for (int ks = 0; ks < 2; ++ks) { const bf16x8 bp = lds_frag(Pm + (ot * 16 + fr) * HPT + ks * 32 + fq * 8);
#pragma unroll
            for (int n = 0; n < 4; ++n) O[n] = __builtin_amdgcn_mfma_f32_16x16x32_bf16(lds_frag(VT + ((oh * 4 + n) * 16 + fr) * HPT + ks * 32 + fq * 8), bp, O[n], 0, 0, 0); }
        float ss = 0.f;
#pragma unroll
        for (int n = 0; n < 4; ++n) ss += O[n][0] * O[n][0] + O[n][1] * O[n][1] + O[n][2] * O[n][2] + O[n][3] * O[n][3];
        ss += __shfl_xor(ss, 16); ss += __shfl_xor(ss, 32);
        if (fq == 0) ssq[oh * 64 + ot * 16 + fr] = ss;
        __syncthreads();
        const int t = ot * 16 + fr; const float rstd = rsqrtf((ssq[t] + ssq[64 + t]) * (1.0f / 128.0f) + EPS);
        const float* ng = tab[I_HNG] + l * 128;
        bf16_t* Y = (bf16_t*)(ws + WS_YCAT) + (size_t)(rho * 64 + t) * DM + 512 + h * 128;
#pragma unroll
        for (int n = 0; n < 4; ++n) { const int dv = (oh * 4 + n) * 16 + fq * 4; const f32x4 g = (f32x4){bflo(graw[n].x), bfhi(graw[n].x), bflo(graw[n].y), bfhi(graw[n].y)}; const f32x4 w = *(const f32x4*)(ng + dv); f32x4 o;
#pragma unroll
            for (int r = 0; r < 4; ++r) o[r] = O[n][r] * rstd * w[r] * g[r] * sigmoidf_(g[r]);
            st_bf4(Y + dv, o); }
        __syncthreads();
    }
#undef HO_LOADRAW
#undef HO_LOADVS
}

__device__ __forceinline__ void s5_carry(unsigned char* ws, const float* const* tab, int l, int u) {
    const int idx = u * 512 + ltid(), p = idx & 63, d = (idx >> 6) & 1, g = (idx >> 7) & 31, b = idx >> 12;
    const float2 lam = ((const float2*)(ws + WS_LAMT))[((l * 2 + d) * S5G + g) * 64 + p];
    const float* E = (const float*)(ws + WS_S5E) + (size_t)g * UAROWS * 256 + d * 128 + p;
    bf16_t* X = (bf16_t*)(ws + WS_UA) + (size_t)g * UAROWS * UALD + 1024 + d * 128 + p;
    float xr = 0.f, xi = 0.f;
    for (int s0 = 0; s0 < 260; s0 += 4) { float er[4], ei[4]; int rho[4];
#pragma unroll
        for (int k = 0; k < 4; ++k) { rho[k] = chunk_at(b, d, s0 + k); er[k] = E[(size_t)rho[k] * 256]; ei[k] = E[(size_t)rho[k] * 256 + 64]; }
#pragma unroll
        for (int k = 0; k < 4; ++k) { X[(size_t)rho[k] * UALD] = f2bf(xr); X[(size_t)rho[k] * UALD + 64] = f2bf(xi);
            const float nr = lam.x * xr - lam.y * xi + er[k], ni = lam.x * xi + lam.y * xr + ei[k]; xr = nr; xi = ni; } }
}

static __device__ __forceinline__ void phase_norm2_route(unsigned char* ws, const float* const* tab, unsigned char* lds_g, int l, int probe = 0) {
    constexpr int HPF = 1028;
    float* hrow = (float*)lds_g;
    int* hist = (int*)(hrow + 32 * HPF);
    int* base = hist + 32;
    const int tid = ltid(), lane = tid & 63, wid = tid >> 6, e = lane & 31;
    const float* MODl = (const float*)(ws + WS_MOD) + (size_t)l * 3 * NMOD;
    const float* RW = tab[I_RW] + (size_t)l * DM * NE; const float* RB = tab[I_RB] + l * NE;
    unsigned* CNT = (unsigned*)(ws + WS_CTL) + CW_CNT + (l + (probe ? DEPTH : 0)) * NE;
    const size_t pofs = probe ? (WS_ACT - WS_TOPE) : 0;
    float bw0[32], bw1[32];
    { const int fr = lane & 15, fq = lane >> 4; const float* bp = RW + (size_t)(wid * 128 + fq) * NE + fr;
#pragma unroll
      for (int ks = 0; ks < 32; ++ks) { bw0[ks] = bp[(size_t)ks * 4 * NE]; bw1[ks] = bp[(size_t)ks * 4 * NE + 16]; } }
    int pe = 0, pl = 0, pr = -1; float pg = 0.f; unsigned bres = 0u;
#define ROUTE_FLUSH() do { if (lane < 16 && pr >= 0) { const size_t o = (size_t)pr * 4 + (lane & 3); const int rk = base[pe] + pl; \
            ((int*)(ws + pofs + WS_TOPE))[o] = pe; ((int*)(ws + pofs + WS_TOPR))[o] = rk; \
            if (!probe) { ((int*)(ws + WS_ROWTOK))[(size_t)pe * NTOK + rk] = pr; ((float*)(ws + WS_ROWGATE))[(size_t)pe * NTOK + rk] = pg; } } } while (0)
    for (int u = lbid(); u < ((l == DEPTH - 1) ? NLAT : NTOK) / 32; u += gridDim.x) {
        if (tid < 32) hist[tid] = 0;
#pragma unroll
        for (int i = 0; i < 4; ++i) { const int r = u * 32 + wid * 4 + i; const int mb = r < NLAT ? (r >> 14) : 2;
            f32x4 x[4];
#pragma unroll
            for (int k = 0; k < 4; ++k) x[k] = ld_bf4((const bf16_t*)(ws + WS_XF) + (size_t)r * DM + lane * 4 + k * 256);
            norm_mod_row(x, tab[I_N2G] + l * DM, MODl + mb * NMOD + 3 * DM, MODl + mb * NMOD + 4 * DM, lane);
            unsigned* hp = (unsigned*)(ws + WS_HA8 + (size_t)r * DM);
#pragma unroll
            for (int k = 0; k < 4; ++k) { if (MOE1_FP8) hp[lane + k * 64] = pack4_fp8(x[k][0] * FP8_ASCALE, x[k][1] * FP8_ASCALE, x[k][2] * FP8_ASCALE, x[k][3] * FP8_ASCALE); else st_bf4((bf16_t*)(ws + WS_HA) + (size_t)r * DM + lane * 4 + k * 256, x[k]); *(f32x4*)(hrow + (wid * 4 + i) * HPF + lane * 4 + k * 256) = x[k]; } }
        if (tid < 32) base[tid] = (int)bres;
        __syncthreads();
        ROUTE_FLUSH();
        { const int fr = lane & 15, fq = lane >> 4; f32x4 acc00 = (f32x4){0.f, 0.f, 0.f, 0.f}, acc01 = acc00, acc10 = acc00, acc11 = acc00;
          const float* ap = hrow + fr * HPF + wid * 128 + fq;
#pragma unroll
          for (int ks = 0; ks < 32; ++ks) { const float a0 = ap[ks * 4], a1 = ap[16 * HPF + ks * 4];
              acc00 = __builtin_amdgcn_mfma_f32_16x16x4f32(a0, bw0[ks], acc00, 0, 0, 0); acc01 = __builtin_amdgcn_mfma_f32_16x16x4f32(a0, bw1[ks], acc01, 0, 0, 0);
              acc10 = __builtin_amdgcn_mfma_f32_16x16x4f32(a1, bw0[ks], acc10, 0, 0, 0); acc11 = __builtin_amdgcn_mfma_f32_16x16x4f32(a1, bw1[ks], acc11, 0, 0, 0); }
          __syncthreads();
          float* part = hrow + (wid * 32 + fq * 4) * 32;
#pragma unroll
          for (int r = 0; r < 4; ++r) { part[r * 32 + fr] = acc00[r]; part[r * 32 + 16 + fr] = acc01[r]; part[(16 + r) * 32 + fr] = acc10[r]; part[(16 + r) * 32 + 16 + fr] = acc11[r]; } }
        __syncthreads();
        int myl = 0, mye = 0; float myg = 0.f;
#pragma unroll
        for (int i = 0; i < 4; ++i) { const int rl = wid * 4 + i; float v = ((hrow[(0 * 32 + rl) * 32 + e] + hrow[(1 * 32 + rl) * 32 + e]) + (hrow[(2 * 32 + rl) * 32 + e] + hrow[(3 * 32 + rl) * 32 + e])) + ((hrow[(4 * 32 + rl) * 32 + e] + hrow[(5 * 32 + rl) * 32 + e]) + (hrow[(6 * 32 + rl) * 32 + e] + hrow[(7 * 32 + rl) * 32 + e])) + RB[e]; float tv[4]; int te[4];
#pragma unroll
            for (int k = 0; k < 4; ++k) { float best = v; int bi = e;
#pragma unroll
                for (int o = 16; o >= 1; o >>= 1) { const float ov = __shfl_xor(best, o); const int oi = __shfl_xor(bi, o); if (ov > best || (ov == best && oi < bi)) { best = ov; bi = oi; } }
                tv[k] = best; te[k] = bi; if (e == bi) v = -3.0e38f; }
            float ex[4], s = 0.f;
#pragma unroll
            for (int k = 0; k < 4; ++k) { ex[k] = __expf(tv[k] - tv[0]); s += ex[k]; }
            const float inv = 1.0f / s;
#pragma unroll
            for (int k = 0; k < 4; ++k) if (lane == i * 4 + k) { mye = te[k]; myg = ex[k] * inv; } }
        if (lane < 16) myl = atomicAdd(&hist[mye], 1);
        __syncthreads();
        if (tid < 32) bres = atomicAdd(&CNT[tid], (unsigned)hist[tid]);
        pe = mye; pl = myl; pg = myg; pr = u * 32 + wid * 4 + (lane >> 2);
    }
    if (tid < 32) base[tid] = (int)bres;
    __syncthreads();
    ROUTE_FLUSH();
#undef ROUTE_FLUSH
    __syncthreads();
}
__device__ __forceinline__ void moe_segments(unsigned char* ws, int* ps, int l) {
    const int tid = ltid();
    if (tid < 64) { const unsigned* CNT = (const unsigned*)(ws + WS_CTL) + CW_CNT + l * NE; const int e = tid & 31;
        const int n = (int)((__hip_atomic_load(CNT + e, __ATOMIC_RELAXED, __HIP_MEMORY_SCOPE_AGENT) + 255u) >> 8);
        int inc = n;
#pragma unroll
        for (int o = 1; o < 32; o <<= 1) { const int v = __shfl_up(inc, o); if ((tid & 31) >= o) inc += v; }
        const int exc = inc - n;
        if (tid < 32) { ps[e] = exc << 8; if (e == NE - 1) ps[NE] = inc << 8; for (int k = 0; k < n; ++k) ps[64 + exc + k] = e; } }
    __syncthreads();
}
static __device__ __forceinline__ void phase_combine(unsigned char* ws, const float* const* tab, unsigned char* lds_g, int l, int probe = 0) {
    int* ps = (int*)lds_g; moe_segments(ws, ps, l);
    const int tid = ltid(), lane = tid & 63, wid = tid >> 6;
    const float* MODl = (const float*)(ws + WS_MOD) + (size_t)l * 3 * NMOD;
    const int* TE = (const int*)(ws + WS_TOPE); const int* TR = (const int*)(ws + WS_TOPR); const bf16_t* O2 = (const bf16_t*)(ws + WS_OUT2);
    const int nu = ((l == DEPTH - 1) ? NLAT : NTOK) / 8; const int G = gridDim.x;
    typedef int i32x4 __attribute__((ext_vector_type(4)));
    int u = lbid(); if (u >= nu) { __syncthreads(); return; }
    i32x4 en = *(const i32x4*)(TE + (size_t)(u * 8 + wid) * 4), rn = *(const i32x4*)(TR + (size_t)(u * 8 + wid) * 4);
    for (; u < nu; u += G) { const int r = u * 8 + wid; const int mb = r < NLAT ? (r >> 14) : 2;
        const int p0 = ps[en[0]] + rn[0], p1 = ps[en[1]] + rn[1], p2 = ps[en[2]] + rn[2], p3 = ps[en[3]] + rn[3];
        if (u + G < nu) { en = *(const i32x4*)(TE + (size_t)((u + G) * 8 + wid) * 4); rn = *(const i32x4*)(TR + (size_t)((u + G) * 8 + wid) * 4); }
        static_assert(OUT2_FP8, "the wide-lane combine reads fp8 expert rows");
        const bf16_t* xp = (const bf16_t*)(ws + WS_XF) + (size_t)r * DM + lane * 16; bf16_t* xo = (bf16_t*)(ws + (probe ? WS_ACT : WS_XF)) + (size_t)r * DM + lane * 16; f32x4 x[4];
        { const unsigned char* O8 = (const unsigned char*)O2 + lane * 16;
          const u32x4 w0 = *(const u32x4*)(O8 + (size_t)p0 * DM), w1 = *(const u32x4*)(O8 + (size_t)p1 * DM), w2 = *(const u32x4*)(O8 + (size_t)p2 * DM), w3 = *(const u32x4*)(O8 + (size_t)p3 * DM);
          f32x4 xa, xb, xc, xd; ld_bf8(xp, xa, xb); ld_bf8(xp + 8, xc, xd);
          const float* gp = MODl + mb * NMOD + 5 * DM + lane * 16;
          const unsigned a0[4] = {w0.x, w0.y, w0.z, w0.w}, a1[4] = {w1.x, w1.y, w1.z, w1.w}, a2[4] = {w2.x, w2.y, w2.z, w2.w}, a3[4] = {w3.x, w3.y, w3.z, w3.w};
          const f32x4 xr[4] = {xa, xb, xc, xd};
#pragma unroll
          for (int k = 0; k < 4; ++k) { const f32x4 y = (up4_fp8(a0[k]) + up4_fp8(a1[k])) + (up4_fp8(a2[k]) + up4_fp8(a3[k]));
              const f32x4 g = *(const f32x4*)(gp + k * 4) * (1.0f / OUT2_SCALE); x[k] = xr[k] + g * y; }
          if (l + 1 < DEPTH) { st_bf8(xo, x[0], x[1]); st_bf8(xo + 8, x[2], x[3]); } }
        if (l + 1 < DEPTH) { const float* MODn = MODl + 3 * NMOD;
            norm_mod_row<true>(x, tab[I_N1G] + (l + 1) * DM, MODn + mb * NMOD, MODn + mb * NMOD + DM, lane);
            bf16_t* hp = (bf16_t*)(ws + (probe ? WS_ACT + SZ_XF : WS_HA)) + (size_t)sigma_row(r, (l + 1) & 1) * DM + lane * 16;
            st_bf8(hp, x[0], x[1]); st_bf8(hp + 8, x[2], x[3]); }
        else if (r < NLAT) { float ss = 0.f;
#pragma unroll
            for (int k = 0; k < 4; ++k) ss += x[k][0] * x[k][0] + x[k][1] * x[k][1] + x[k][2] * x[k][2] + x[k][3] * x[k][3];
            ss = wave_sum(ss); const float rstd = rsqrtf(ss * (1.0f / DM) + EPS);
#pragma unroll
            for (int k = 0; k < 4; ++k) { const int c = lane * 16 + k * 4; *(f32x4*)((probe ? (float*)(ws + WS_ACT + SZ_XF) : (float*)tab[N_INPUTS]) + (size_t)r * DM + c) = x[k] * rstd * *(const f32x4*)(tab[I_FG] + c); } }
    }
    __syncthreads();
}

#define GAS __attribute__((address_space(1)))
template <class T> __device__ __forceinline__ T* launder(T* p) { unsigned long long v = (unsigned long long)p; asm volatile("" : "+s"(v)); GAS T* g = (GAS T*)v; return (T*)g; }
#define PHASE_FN static __device__ __forceinline__
#define G8_LDS(l) ((LAS unsigned char*)(l))
PHASE_FN void ph_inproj(unsigned char* ws, const float* const* tab, unsigned char* lds, int l) {
    g8::GridOrder S{(const char*)(ws + WS_HA), (const char*)(ws + WS_WIN) + (size_t)l * NIN * DM * 2, (size_t)256 * DM * 2, (size_t)256 * DM * 2, 130, 20, 130 * 20, (int)gridDim.x, lbid()};
    F8Inproj E{(bf16_t*)(ws + WS_UA), (bf16_t*)(ws + WS_Z), (unsigned char*)(ws + WS_ZG8)};
    g8::gemm_phase<true, false>(G8_LDS(lds), DM, DM * 2, DM * 2, S, E);
    if (l + 1 < DEPTH && (130 * 20) % (int)gridDim.x != 0 && (int)lbid() >= (130 * 20) % (int)gridDim.x) conv_steal(ws, tab, lds, l + 1, 1);
}
PHASE_FN void ph_s5e(unsigned char* ws, unsigned char* lds, int l) {
    S5Order S{(const char*)(ws + WS_UA), (const char*)(ws + WS_BT1) + (size_t)l * S5G * 256 * 1024 * 2, (size_t)UAROWS * UALD * 2, (size_t)256 * 1024 * 2, UALD * 2, 1024 * 2, 3, 1, (int)gridDim.x, lbid()};
    g8::Epi4<F8S5E> E{{(float*)(ws + WS_S5E)}};
    g8::gemm_phase<false, false>(G8_LDS(lds), 1024, UALD * 2, 1024 * 2, S, E);
}
PHASE_FN void ph_s5y(unsigned char* ws, unsigned char* lds, int l) {
    S5Order S{(const char*)(ws + WS_UA), (const char*)(ws + WS_BT2) + (size_t)l * S5G * 1024 * UALD * 2, (size_t)UAROWS * UALD * 2, (size_t)1024 * UALD * 2, UALD * 2, UALD * 2, (l == DEPTH - 1) ? 2 : 3, 4, (int)gridDim.x, lbid()};
    g8::Epi8<F8S5Y> E{{(bf16_t*)(ws + WS_Z5)}};
    g8::gemm_phase<true, false>(G8_LDS(lds), UALD, UALD * 2, UALD * 2, S, E);
}
PHASE_FN void ph_glu(unsigned char* ws, const float* const* tab, unsigned char* lds, int l) {
    const int probe_ = 0;
    const int nM = (l == DEPTH - 1) ? NLAT / 256 : NTOK / 256;
    g8::GridOrder S{(const char*)(ws + WS_Z5), (const char*)(ws + WS_WGLU) + (size_t)l * 512 * 512 * 2, (size_t)256 * 512 * 2, (size_t)256 * 512 * 2, nM, 2, nM * 2, (int)gridDim.x, lbid()};
    g8::Epi8<F8Glu> E{{(const bf16_t*)(ws + WS_Z5), (bf16_t*)(ws + WS_YCAT)}};
    g8::gemm_phase<true, false>(G8_LDS(lds), 512, 512 * 2, 512 * 2, S, E);
    if (l + 1 < DEPTH && !probe_ && (nM * 2) % (int)gridDim.x != 0 && (int)lbid() >= (nM * 2) % (int)gridDim.x) conv_steal(ws, tab, lds, l + 1, 1);
}
PHASE_FN void ph_up5(unsigned char* ws, const float* const* tab, unsigned char* lds, int l) {
    const int probe_ = 0;
    const int nM = (l == DEPTH - 1) ? NLAT / 256 : NTOK / 256;
    g8::GridOrder S{(const char*)(ws + WS_YCAT), (const char*)(ws + WS_WUP5) + (size_t)l * 1024 * 512 * 2, (size_t)256 * DM * 2, (size_t)256 * 512 * 2, nM, 4, nM * 4, (int)gridDim.x, lbid()};
    g8::Epi8<F8Up5> E{{(const bf16_t*)(ws + WS_Z), (bf16_t*)(ws + WS_MBUF), (const unsigned char*)(ws + WS_ZG8)}};
    g8::gemm_phase<true, false>(G8_LDS(lds), 512, DM * 2, 512 * 2, S, E);
    if (l + 1 < DEPTH && !probe_ && (nM * 4) % (int)gridDim.x != 0 && (int)lbid() >= (nM * 4) % (int)gridDim.x) conv_steal(ws, tab, lds, l + 1, 1);
}
PHASE_FN void ph_uph(unsigned char* ws, const float* const* tab, unsigned char* lds, int l, int probe = 0) {
    const int probe_ = probe;
    const int nM = (l == DEPTH - 1) ? NLAT / 256 : NTOK / 256;
    g8::GridOrder S{(const char*)(ws + WS_YCAT) + 512 * 2, (const char*)(ws + WS_WUPH) + (size_t)l * 1024 * 512 * 2, (size_t)256 * DM * 2, (size_t)256 * 512 * 2, nM, 4, nM * 4, (int)gridDim.x, lbid()};
    g8::Epi8<F8Uph> E{{(const bf16_t*)(ws + WS_Z), (bf16_t*)(ws + WS_MBUF), (bf16_t*)(ws + (probe ? WS_ACT : WS_MBUF)), (const unsigned char*)(ws + WS_ZG8)}};
    g8::gemm_phase<true, false>(G8_LDS(lds), 512, DM * 2, 512 * 2, S, E);
    if (l + 1 < DEPTH && !probe_ && (nM * 4) % (int)gridDim.x != 0 && (int)lbid() >= (nM * 4) % (int)gridDim.x) conv_steal(ws, tab, lds, l + 1, 1);
}
PHASE_FN void ph_out(unsigned char* ws, const float* const* tab, unsigned char* lds, int l, int probe = 0) {
    const int probe_ = probe;
    const int nM = (l == DEPTH - 1) ? NLAT / 256 : NTOK / 256;
    g8::GridOrder S{(const char*)(ws + WS_MBUF), (const char*)(ws + WS_WOUT) + (size_t)l * 1024 * 1024 * 2, (size_t)256 * DM * 2, (size_t)256 * DM * 2, nM, 4, nM * 4, (int)gridDim.x, lbid()};
    F8Out E{(bf16_t*)(ws + (probe ? WS_ACT : WS_XF)), (const float*)(ws + WS_MOD) + (size_t)l * 3 * NMOD, l & 1};
    g8::gemm_phase<true, false>(G8_LDS(lds), DM, DM * 2, DM * 2, S, E);
    if (l + 1 < DEPTH && !probe_ && (nM * 4) % (int)gridDim.x != 0 && (int)lbid() >= (nM * 4) % (int)gridDim.x) conv_steal(ws, tab, lds, l + 1, 2);
}
PHASE_FN void ph_moe1(unsigned char* ws, const float* const* tab, unsigned char* lds, int l) {
    int* ps = (int*)(lds + g8::STAGE_BYTES); moe_segments(ws, ps, l);
    constexpr unsigned EB = MOE1_FP8 ? 1u : 2u;
    MoeOrder S{(const char*)(ws + (MOE1_FP8 ? WS_HA8 : WS_HA)), (const char*)(ws + WS_W1) + (size_t)l * NE * 2048 * 1024 * EB, (const int*)(ws + WS_ROWTOK), ps + 64, 2048u * 1024u * EB, 8, ps[NE] >> 8, (int)gridDim.x, lbid(), true, 256 * DM * EB};
    F8Moe1 E{(bf16_t*)(ws + WS_ACT), tab[I_B1] + (size_t)l * NE * 2048};
    g8::gemm_phase<true, true, MOE1_FP8 != 0>(G8_LDS(lds), MOE1_FP8 ? DM / 2 : DM, DM * EB, DM * EB, S, E);
    if (l + 1 < DEPTH) { g8::Unit du; const int rounds = (S.ntile + 31) >> 5; if (rounds > 0 && !S.next(rounds - 1, du)) conv_steal(ws, tab, lds, l + 1, 1); }
}
PHASE_FN void ph_moe2(unsigned char* ws, const float* const* tab, unsigned char* lds, int l) {
    int* ps = (int*)(lds + g8::STAGE_BYTES); moe_segments(ws, ps, l);
    constexpr unsigned EB = MOE2_FP8 ? 1u : 2u;
    MoeOrder S{(const char*)(ws + WS_ACT), (const char*)(ws + WS_W2) + (size_t)l * NE * 1024 * 1024 * EB, (const int*)(ws + WS_ROWTOK), ps + 64, 1024u * 1024u * EB, 4, ps[NE] >> 8, (int)gridDim.x, lbid(), false, 256 * DM * EB};
    F8Moe2 E{(bf16_t*)(ws + WS_OUT2), tab[I_B2] + (size_t)l * NE * 1024, (const float*)(ws + WS_ROWGATE), ps};
    g8::gemm_phase<true, false, MOE2_FP8 != 0>(G8_LDS(lds), MOE2_FP8 ? DM / 2 : DM, DM * EB, DM * EB, S, E);
    if (l + 1 < DEPTH) { g8::Unit du; const int rounds = (S.ntile + 63) >> 6; if (rounds > 0 && !S.next(rounds - 1, du)) conv_steal(ws, tab, lds, l + 1, 1); }
}
PHASE_FN void ph_hgrn_local(unsigned char* ws, const float* const* tab, unsigned char* lds, int l) {
    hgrn_local_phase(ws, lds, l);
}
PHASE_FN void ph_carry(unsigned char* ws, const float* const* tab, int l) {
    for (int u = lbid(); u < 16 + 256; u += gridDim.x) { if (u < 16) s5_carry(ws, tab, l, u); else hgrn_carry2(ws, u - 16); }
}
PHASE_FN void ph_hgrn_out(unsigned char* ws, const float* const* tab, unsigned char* lds, int l) {
    hgrn_out_phase(ws, tab, lds, l);
}

constexpr int PH_PER_LAYER = 12;
constexpr int N_PHASES = 2 + DEPTH * PH_PER_LAYER;
__global__ void __launch_bounds__(NTHREADS, 2) mega(Params P) {
    extern __shared__ __attribute__((aligned(16))) unsigned char lds[];
    const int tid = threadIdx.x;
    LAS unsigned* xbw = (LAS unsigned*)(lds + LDS_BYTES - 16);
    if (tid < 4) xbw[tid] = 0u;
    unsigned char* ws = P.ws;
    const float** tabw = (const float**)(ws + WS_PTRS) + (size_t)blockIdx.x * 32;
    if (tid == 0) {
#pragma unroll
        for (int i = 0; i < N_INPUTS; ++i) tabw[i] = P.in[i];
        tabw[N_INPUTS] = P.out;
    }
    __syncthreads();
    const float* const* tab = (const float* const*)tabw;
    XcdBarrier bar; bar.bar = (unsigned*)(ws + WS_CTL) + CW_BAR; bar.x = 0; bar.st = nullptr;
    const int lo = P.ph_lo, hi = P.ph_hi;
    if (hi - lo > 1) bar = xcd_barrier_post((unsigned*)(ws + WS_CTL) + CW_BAR, (volatile LAS unsigned*)xbw);
#ifndef PROBE_DUP_MASK
#define PROBE_DUP_MASK 0
#endif
#define DUPON(j) ((PROBE_DUP_MASK >> (j)) & 1)
#define IN(k) (lo <= (k) && (k) < hi && ((ws = launder(ws)), (tab = launder(tab)), true))
#define SEAM(k) do { if ((k) + 1 < hi) xcd_barrier(bar); } while (0)

    if (IN(0)) { phase_prologue(ws, tab, lds, 0); if (DUPON(13)) { xcd_barrier(bar); ws = launder(ws); tab = launder(tab); phase_prologue(ws, tab, lds, 1); } SEAM(0); }
    if (IN(1)) { phase_norm1(ws, tab, lds, 0); SEAM(1); }
#define LAYER_BODY(l) do { const int pb = 2 + l * PH_PER_LAYER; \
        if (IN(pb + 0)) { { ph_inproj(ws, tab, lds, l); } if (DUPON(0)) { ws = launder(ws); tab = launder(tab); ph_inproj(ws, tab, lds, l); } SEAM(pb + 0); } \
        if (IN(pb + 1)) { { ph_s5e(ws, lds, l); ph_hgrn_local(ws, tab, lds, l); } if (DUPON(1)) { ws = launder(ws); tab = launder(tab); ph_s5e(ws, lds, l); ph_hgrn_local(ws, tab, lds, l); } SEAM(pb + 1); } \
        if (IN(pb + 2)) { { ph_carry(ws, tab, l); } if (DUPON(2)) { ws = launder(ws); tab = launder(tab); ph_carry(ws, tab, l); } SEAM(pb + 2); } \
        if (IN(pb + 3)) { { ph_s5y(ws, lds, l); ph_hgrn_out(ws, tab, lds, l); } if (DUPON(3)) { ws = launder(ws); tab = launder(tab); ph_s5y(ws, lds, l); ph_hgrn_out(ws, tab, lds, l); } SEAM(pb + 3); } \
        if (IN(pb + 4)) { { ph_glu(ws, tab, lds, l); } if (DUPON(4)) { ws = launder(ws); tab = launder(tab); ph_glu(ws, tab, lds, l); } SEAM(pb + 4); } \
        if (IN(pb + 5)) { { ph_up5(ws, tab, lds, l); } if (DUPON(5)) { ws = launder(ws); tab = launder(tab); ph_up5(ws, tab, lds, l); } SEAM(pb + 5); } \
        if (IN(pb + 6)) { ph_uph(ws, tab, lds, l); if (DUPON(6)) { ws = launder(ws); ph_uph(ws, tab, lds, l, 1); } SEAM(pb + 6); } \
        if (IN(pb + 7)) { ph_out(ws, tab, lds, l); if (DUPON(7)) { ws = launder(ws); ph_out(ws, tab, lds, l, 1); } SEAM(pb + 7); } \
        if (IN(pb + 8)) { phase_norm2_route(ws, tab, lds, l); if (DUPON(8)) { ws = launder(ws); tab = launder(tab); phase_norm2_route(ws, tab, lds, l, 1); } SEAM(pb + 8); } \
        if (IN(pb + 9)) { { ph_moe1(ws, tab, lds, l); } if (DUPON(10)) { ws = launder(ws); tab = launder(tab); ph_moe1(ws, tab, lds, l); } SEAM(pb + 9); } \
        if (IN(pb + 10)) { { ph_moe2(ws, tab, lds, l); } if (DUPON(11)) { ws = launder(ws); tab = launder(tab); ph_moe2(ws, tab, lds, l); } SEAM(pb + 10); } \
        if (IN(pb + 11)) { if (DUPON(12)) { phase_combine(ws, tab, lds, l, 1); ws = launder(ws); tab = launder(tab); } phase_combine(ws, tab, lds, l); if (l + 1 < DEPTH) conv_steal(ws, tab, lds, l + 1, 1 << 30); SEAM(pb + 11); } } while (0)
    LAYER_BODY(0); LAYER_BODY(1); LAYER_BODY(2); LAYER_BODY(3);
#undef LAYER_BODY
#undef IN
#undef SEAM
}

#ifndef MK_LAUNCH_PER_PHASE
#define MK_LAUNCH_PER_PHASE 0
#endif
extern "C" void kernel_launch(void* const* d_in, const int* in_sizes, int n_in, void* d_out, int out_size, void* d_ws, size_t ws_size, hipStream_t stream) {
    static int grid = 0;
    if (grid == 0) {
        if (n_in != N_INPUTS || out_size != NLAT * DM || ws_size < WS_END) { fprintf(stderr, "kernel_launch: unexpected problem (n_in %d, out %d, ws %zu < %zu)\n", n_in, out_size, ws_size, (size_t)WS_END); grid = -1; return; }
        int dev = 0, cus = 0, per_cu = 0;
        if (hipGetDevice(&dev) != hipSuccess || hipDeviceGetAttribute(&cus, hipDeviceAttributeMultiprocessorCount, dev) != hipSuccess) { grid = -1; return; }
        if (hipFuncSetAttribute((const void*)mega, hipFuncAttributeMaxDynamicSharedMemorySize, LDS_BYTES) != hipSuccess) { fprintf(stderr, "kernel_launch: hipFuncSetAttribute failed\n"); grid = -1; return; }
        if (hipOccupancyMaxActiveBlocksPerMultiprocessor(&per_cu, (const void*)mega, NTHREADS, LDS_BYTES) != hipSuccess || per_cu < 1) { fprintf(stderr, "kernel_launch: occupancy query says %d\n", per_cu); }
        (void)hipGetLastError();
        grid = cus;
    }
    if (grid < 0) return;
    (void)hipMemsetAsync((char*)d_ws + WS_CTL, 0, CTL_BYTES, stream);
    Params p{};
    for (int i = 0; i < N_INPUTS; ++i) p.in[i] = (const float*)d_in[i];
    p.out = (float*)d_out; p.ws = (unsigned char*)d_ws;
#if MK_LAUNCH_PER_PHASE
    for (int ph = 0; ph < N_PHASES; ++ph) { p.ph_lo = ph; p.ph_hi = ph + 1; hipLaunchKernelGGL(mega, dim3(grid), dim3(NTHREADS), LDS_BYTES, stream, p); }
#else
    p.ph_lo = 0; p.ph_hi = N_PHASES; hipLaunchKernelGGL(mega, dim3(grid), dim3(NTHREADS), LDS_BYTES, stream, p);
#endif
}
```

```cpp
#include <hip/hip_runtime.h>
#include <cstdio>
#include <cstdint>

typedef unsigned short bf16_t;
typedef short bf16x8 __attribute__((ext_vector_type(8)));
typedef float f32x4 __attribute__((ext_vector_type(4)));
typedef unsigned u32x2 __attribute__((ext_vector_type(2)));
typedef unsigned u32x4 __attribute__((ext_vector_type(4)));
typedef int i32x8 __attribute__((ext_vector_type(8)));
typedef int i32x4v __attribute__((ext_vector_type(4)));
#define MOE1_FP8 1
#define MOE2_FP8 1
constexpr float FP8_WSCALE = MOE1_FP8 ? 32.0f : 1.0f, FP8_ASCALE = MOE1_FP8 ? 4.0f : 1.0f;
#define LAS __attribute__((address_space(3)))

constexpr int DM = 1024, NB = 2, SEQ = 16384, DEPTH = 4, CTXL = 256;
constexpr int NLAT = NB * SEQ, NCTX = NB * CTXL, NTOK = NLAT + NCTX;
constexpr int CH = 64, NCHUNK = NTOK / CH;
constexpr int S5G = 32, S5H = 16, S5P = 64;
constexpr int HH = 4;
constexpr int NIN = 5120, ZC = NIN - 512;
constexpr int ZQ = 0, ZI = 512, ZFF = 1024, ZFB = 1536, ZG = 2048, Z6 = 2560, Z7 = 3584;
constexpr int NE = 32, TOPK = 4;
constexpr int NMOD = 6 * DM;
constexpr int UAROWS = 768, UALD = 1280;
constexpr int MAXROWS = NTOK * TOPK + NE * 256;
constexpr int NTHREADS = 512;
constexpr int LDS_BYTES = 147456;
constexpr float EPS = 1e-6f;

constexpr size_t al256(size_t x) { return (x + 255) & ~(size_t)255; }
constexpr size_t WS_CTL = 0;                 constexpr size_t CTL_BYTES = 1u << 20;
constexpr size_t WS_MOD = WS_CTL + CTL_BYTES;            constexpr size_t SZ_MOD = (size_t)DEPTH * 3 * NMOD * 4;
constexpr size_t WS_LB = al256(WS_MOD + SZ_MOD);         constexpr size_t SZ_LB = (size_t)2 * DEPTH * 512 * 4;
constexpr size_t WS_LAMT = al256(WS_LB + SZ_LB);         constexpr size_t SZ_LAMT = (size_t)DEPTH * 2 * S5G * S5P * 2 * 4;
constexpr size_t WS_KT = al256(WS_LAMT + SZ_LAMT);       constexpr size_t SZ_KT = (size_t)DEPTH * S5G * 2 * 64 * 256 * 4;
constexpr size_t WS_S5T = al256(WS_KT + SZ_KT);          constexpr size_t SZ_S5T = (size_t)DEPTH * S5G * (2 * 64 * 65 + 2 * 64 * 16 + 2 * 16 * 64) * 8;
constexpr size_t WS_BT1 = al256(WS_S5T + SZ_S5T);          constexpr size_t SZ_BT1 = (size_t)DEPTH * S5G * 256 * 1024 * 2;
constexpr size_t WS_BT2 = al256(WS_BT1 + SZ_BT1);        constexpr size_t SZ_BT2 = (size_t)DEPTH * S5G * 1024 * UALD * 2;
constexpr size_t WS_XF = al256(WS_BT2 + SZ_BT2);         constexpr size_t SZ_XF = (size_t)NTOK * DM * 4;
constexpr size_t WS_HA = al256(WS_XF + SZ_XF);           constexpr size_t SZ_HA = (size_t)NTOK * DM * 2;
constexpr size_t WS_UA = al256(WS_HA + SZ_HA);           constexpr size_t SZ_UA = (size_t)S5G * UAROWS * UALD * 2;
constexpr size_t WS_Z = al256(WS_UA + SZ_UA);            constexpr size_t SZ_Z = (size_t)NTOK * ZC * 2;
constexpr size_t WS_Z5 = al256(WS_Z + SZ_Z);             constexpr size_t SZ_Z5 = (size_t)NTOK * 512 * 2;
constexpr size_t WS_YCAT = al256(WS_Z5 + SZ_Z5);         constexpr size_t SZ_YCAT = (size_t)NTOK * DM * 2;
constexpr size_t WS_MBUF = al256(WS_YCAT + SZ_YCAT);     constexpr size_t SZ_MBUF = (size_t)NTOK * DM * 2;
constexpr size_t WS_S5E = al256(WS_MBUF + SZ_MBUF);      constexpr size_t SZ_S5E = (size_t)S5G * UAROWS * 256 * 4;
constexpr size_t WS_HKV = al256(WS_S5E + SZ_S5E);        constexpr size_t SZ_HKV = (size_t)NCHUNK * HH * 2 * 128 * 128 * 4;
constexpr size_t WS_HS = al256(WS_HKV + SZ_HKV);         constexpr size_t SZ_HS = SZ_HKV;
constexpr size_t WS_HTOT = al256(WS_HS + SZ_HS);         constexpr size_t SZ_HTOT = (size_t)NCHUNK * HH * 2 * 128 * 4;
constexpr size_t WS_TOPE = al256(WS_HTOT + SZ_HTOT);     constexpr size_t SZ_TOP = (size_t)NTOK * TOPK * 4;
constexpr size_t WS_TOPG = al256(WS_TOPE + SZ_TOP);
constexpr size_t WS_TOPR = al256(WS_TOPG + SZ_TOP);
constexpr size_t WS_POS = al256(WS_TOPR + SZ_TOP);
constexpr size_t WS_ROWTOK = al256(WS_POS + SZ_TOP);     constexpr size_t SZ_ROWS = (size_t)NE * NTOK * 4;
constexpr size_t WS_ROWGATE = al256(WS_ROWTOK + SZ_ROWS);
constexpr size_t WS_ACT = al256(WS_ROWGATE + SZ_ROWS);   constexpr size_t SZ_ACT = (size_t)MAXROWS * DM * 2;
constexpr size_t WS_OUT2 = al256(WS_ACT + SZ_ACT);
constexpr size_t WS_WIN = al256(WS_OUT2 + SZ_ACT);       constexpr size_t SZ_WIN = (size_t)DEPTH * NIN * DM * 2;
constexpr size_t WS_WGLU = al256(WS_WIN + SZ_WIN);       constexpr size_t SZ_WGLU = (size_t)DEPTH * 512 * 512 * 2;
constexpr size_t WS_WUP5 = al256(WS_WGLU + SZ_WGLU);     constexpr size_t SZ_WUP = (size_t)DEPTH * 1024 * 512 * 2;
constexpr size_t WS_WUPH = al256(WS_WUP5 + SZ_WUP);
constexpr size_t WS_WOUT = al256(WS_WUPH + SZ_WUP);      constexpr size_t SZ_WOUT = (size_t)DEPTH * 1024 * 1024 * 2;
constexpr size_t WS_W1 = al256(WS_WOUT + SZ_WOUT);       constexpr size_t SZ_W1 = (size_t)DEPTH * NE * 2048 * 1024 * 2;
constexpr size_t WS_W2 = al256(WS_W1 + SZ_W1);           constexpr size_t SZ_W2 = (size_t)DEPTH * NE * 1024 * 1024 * 2;
constexpr size_t WS_HA8 = al256(WS_W2 + SZ_W2);         constexpr size_t SZ_HA8 = (size_t)NTOK * DM;
constexpr size_t WS_ZG8 = al256(WS_HA8 + SZ_HA8);       constexpr size_t SZ_ZG8 = (size_t)NTOK * 2048;
constexpr size_t WS_END = al256(WS_ZG8 + SZ_ZG8);

constexpr int CW_BAR = 0;
constexpr int CW_WQ = 3584;
constexpr int CW_CNT = 4096;
constexpr int CW_WQ2 = 8192;
constexpr size_t WS_PTRS = WS_CTL + 65536;

enum { I_X = 0, I_C, I_CTX, I_CCTX, I_MODW, I_MODB, I_N1G, I_N2G, I_WIN, I_ARE, I_AIM, I_LOGDT, I_BRE, I_BIM, I_CRE, I_CIM, I_S5D, I_WGLU,
       I_LBL, I_HNG, I_WUP5, I_WUPH, I_WOUT, I_RW, I_RB, I_W1, I_B1, I_W2, I_B2, I_FG, N_INPUTS };

struct Params { const float* in[N_INPUTS]; float* out; unsigned char* ws; int ph_lo, ph_hi; };

typedef __bf16 bf16v2 __attribute__((ext_vector_type(2)));
typedef float f32v2 __attribute__((ext_vector_type(2)));
__device__ __forceinline__ unsigned pack2(float a, float b) { const f32v2 v = {a, b}; const bf16v2 r = __builtin_convertvector(v, bf16v2); return __builtin_bit_cast(unsigned, r); }
__device__ __forceinline__ bf16_t f2bf(float f) { return __builtin_bit_cast(unsigned short, (__bf16)f); }
__device__ __forceinline__ float sat_fp8(float x) { return __builtin_amdgcn_fmed3f(x, -448.0f, 448.0f); }
__device__ __forceinline__ unsigned pack4_fp8(float a, float b, float c, float d) { unsigned w = 0u; w = __builtin_amdgcn_cvt_pk_fp8_f32(sat_fp8(a), sat_fp8(b), w, false); w = __builtin_amdgcn_cvt_pk_fp8_f32(sat_fp8(c), sat_fp8(d), w, true); return w; }
__device__ __forceinline__ float bf2f(bf16_t b) { return __uint_as_float(((unsigned)b) << 16); }
__device__ __forceinline__ float bflo(unsigned w) { return __uint_as_float(w << 16); }
__device__ __forceinline__ float bfhi(unsigned w) { return __uint_as_float(w & 0xffff0000u); }
__device__ __forceinline__ f32x4 up4_fp8(unsigned w) { typedef float f32x2v __attribute__((ext_vector_type(2))); const f32x2v lo = __builtin_amdgcn_cvt_pk_f32_fp8(w, false), hi = __builtin_amdgcn_cvt_pk_f32_fp8(w, true); return (f32x4){lo.x, lo.y, hi.x, hi.y}; }
constexpr float HS_SCALE = 32.0f, KV_SCALE = 16.0f;
__device__ __forceinline__ u32x2 fp8x4_to_bf16x4(unsigned w, float sc) { const f32x4 v = up4_fp8(w) * sc; u32x2 o; o.x = pack2(v[0], v[1]); o.y = pack2(v[2], v[3]); return o; }
#ifndef ZG8_FP8
#define ZG8_FP8 1
#endif
constexpr float ZG8_SCALE = 16.0f;
__device__ __forceinline__ float sigmoidf_(float x) { return __builtin_amdgcn_rcpf(1.0f + __builtin_amdgcn_exp2f(-1.4426950408889634f * x)); }
__device__ __forceinline__ float ex2(float x) { return __builtin_amdgcn_exp2f(x); }
__device__ __forceinline__ float lg2(float x) { return __builtin_amdgcn_logf(x); }
__device__ __forceinline__ float sigf(float x) { return __builtin_amdgcn_rcpf(1.0f + ex2(-1.4426950408889634f * x)); }
__device__ __forceinline__ float gelu_tanh(float x) { const float y = 0.7978845608028654f * (x + 0.044715f * x * x * x); return x * __builtin_amdgcn_rcpf(1.0f + __builtin_amdgcn_exp2f(-2.8853900817779268f * y)); }
__device__ __forceinline__ float wave_sum(float v) {
#pragma unroll
    for (int o = 32; o >= 1; o >>= 1) v += __shfl_xor(v, o);
    return v;
}
__device__ __forceinline__ int sigma_row(int r, int odd) {
    if (r >= NLAT || !odd) return r;
    const int b = r >> 14, n = r & 16383; return (b << 14) + ((n & 63) << 8) + (n >> 6);
}
__device__ __forceinline__ int sigma_inv(int s, int odd) {
    if (s >= NLAT || !odd) return s;
    const int b = s >> 14, q = s & 16383; return (b << 14) + ((q & 255) << 6) + (q >> 8);
}

__device__ __forceinline__ int ltid() { int t = threadIdx.x; asm volatile("" : "+v"(t)); return t; }
__device__ __forceinline__ int lbid() { int t = blockIdx.x; asm volatile("" : "+s"(t)); return t; }
#define XB_TMO      128
#define XB_XCNT(j)  (256  + 64 * (j))
#define XB_XSUB(j)  (1280 + 64 * (j))
#define XB_XGEN(j)  (2304 + 64 * (j))
#define XB_TOP      3328
#define XB_TOPGEN   3392
#define XCD_BAR_WORDS 3456
#define XB_SPIN_CAP (1u << 22)
__device__ __forceinline__ unsigned xb_ld(unsigned* p)              { return __hip_atomic_load(p, __ATOMIC_RELAXED, __HIP_MEMORY_SCOPE_AGENT); }
__device__ __forceinline__ unsigned xb_add(unsigned* p, unsigned v) { return __hip_atomic_fetch_add(p, v, __ATOMIC_RELAXED, __HIP_MEMORY_SCOPE_AGENT); }
__device__ __forceinline__ unsigned xb_xcc_id() { return (unsigned)__builtin_amdgcn_s_getreg((3 << 11) | 20) & 0xFu; }
#define XB_SPIN(cond, bar) do { unsigned _sp = 0; while (cond) { __builtin_amdgcn_s_sleep(1); \
    if ((++_sp & 255u) == 0u) { if (xb_ld(&(bar)[XB_TMO])) break; if (_sp > XB_SPIN_CAP) { atomicAdd(&(bar)[XB_TMO], 1u); break; } } } } while (0)
struct XcdBarrier { unsigned* bar; unsigned x; volatile LAS unsigned* st; };
__device__ __forceinline__ XcdBarrier xcd_barrier_post(unsigned* bar, volatile LAS unsigned* st) {
    XcdBarrier b; b.bar = bar; b.x = xb_xcc_id(); b.st = st;
    if (threadIdx.x == 0) (void)xb_add(&bar[XB_XCNT(b.x)], 1u);
    return b;
}
__device__ __forceinline__ void xcd_barrier_complete(unsigned* bar, unsigned x, unsigned& nloc, unsigned& nx) {
    const unsigned G = gridDim.x * gridDim.y * gridDim.z;
    unsigned sum, cnt, mine, sp = 0u;
    for (;;) {
        sum = 0u; cnt = 0u; mine = 0u;
#pragma unroll
        for (unsigned j = 0; j < 16; ++j) { const unsigned c = xb_ld(&bar[XB_XCNT(j)]); sum += c; cnt += (c > 0u) ? 1u : 0u; mine = (j == x) ? c : mine; }
        if (sum == G) break;
        __builtin_amdgcn_s_sleep(1);
        if ((++sp & 255u) == 0u) { if (xb_ld(&bar[XB_TMO])) break; if (sp > XB_SPIN_CAP) { atomicAdd(&bar[XB_TMO], 1u); break; } }
    }
    nloc = mine > 0u ? mine : 1u; nx = cnt > 0u ? cnt : 1u;
}
__device__ __forceinline__ void xcd_barrier(const XcdBarrier& b) {
    asm volatile("s_waitcnt vmcnt(0)" ::: "memory");
    __syncthreads();
    if (threadIdx.x == 0) {
        unsigned* bar = b.bar;
        __builtin_amdgcn_s_waitcnt(0);
        unsigned nloc = b.st[0], nx = b.st[1];
        if (nloc == 0u) { xcd_barrier_complete(bar, b.x, nloc, nx); b.st[0] = nloc; b.st[1] = nx; }
        const unsigned old = xb_add(&bar[XB_XSUB(b.x)], 1u);
        const unsigned gen = old / nloc;
        if (old + 1u == (gen + 1u) * nloc) {
            __builtin_amdgcn_fence(__ATOMIC_RELEASE, "agent");
            asm volatile("s_waitcnt vmcnt(0)" ::: "memory");
            const unsigned og = xb_add(&bar[XB_TOP], 1u);
            const unsigned tg = og / nx;
            if (og + 1u == (tg + 1u) * nx) xb_add(&bar[XB_TOPGEN], 1u);
            else XB_SPIN(xb_ld(&bar[XB_TOPGEN]) == tg, bar);
            __builtin_amdgcn_fence(__ATOMIC_ACQUIRE, "agent");
            xb_add(&bar[XB_XGEN(b.x)], 1u);
            asm volatile("s_waitcnt vmcnt(0)" ::: "memory");
        } else {
            XB_SPIN(xb_ld(&bar[XB_XGEN(b.x)]) == gen, bar);
            __builtin_amdgcn_fence(__ATOMIC_ACQUIRE, "agent");
            asm volatile("s_waitcnt vmcnt(0)" ::: "memory");
        }
    }
    __syncthreads();
}

constexpr int G_ABUF = 32768, G_BBUF = 16384, G_BUF = G_ABUF + G_BBUF;
template <class Epi>
__device__ __forceinline__ void gemm256x128(unsigned char* lds_g, const bf16_t* A, long lda, const int* rowidx, const bf16_t* Bt, long ldb, int K, const Epi& epi) {
    LAS unsigned char* lds = (LAS unsigned char*)lds_g;
    const int tid = ltid(), lane = tid & 63, wid = tid >> 6, wr = wid >> 1, wc = wid & 1, fr = lane & 15, fq = lane >> 4;
    const int r0 = tid >> 3, cg = (tid & 7) ^ (r0 & 7);
    const int wvu = __builtin_amdgcn_readfirstlane(wid);
    const bf16_t* pa[4]; const bf16_t* pb[2];
#pragma unroll
    for (int i = 0; i < 4; ++i) { const int r = r0 + 64 * i; const long rr = rowidx ? (long)rowidx[r] : (long)r; pa[i] = A + rr * lda + cg * 8; }
#pragma unroll
    for (int i = 0; i < 2; ++i) { const int r = r0 + 64 * i; pb[i] = Bt + (long)r * ldb + cg * 8; }
    f32x4 acc[4][4];
#pragma unroll
    for (int m = 0; m < 4; ++m)
#pragma unroll
        for (int n = 0; n < 4; ++n) acc[m][n] = (f32x4){0.f, 0.f, 0.f, 0.f};
    const int nk = K >> 6;
#define G_STAGE(kt, buf) do { \
        _Pragma("unroll") for (int _i = 0; _i < 4; ++_i) __builtin_amdgcn_global_load_lds((const unsigned*)(pa[_i] + (size_t)(kt) * 64), (LAS unsigned*)(lds + (buf) * G_BUF + wvu * 1024 + _i * 8192), 16, 0, 0); \
        _Pragma("unroll") for (int _i = 0; _i < 2; ++_i) __builtin_amdgcn_global_load_lds((const unsigned*)(pb[_i] + (size_t)(kt) * 64), (LAS unsigned*)(lds + (buf) * G_BUF + G_ABUF + wvu * 1024 + _i * 8192), 16, 0, 0); } while (0)
    G_STAGE(0, 0);
    const int arow = wr * 64 + fr, brow = wc * 64 + fr, sw = fr & 7;
    for (int kt = 0; kt < nk; ++kt) {
        const int cur = kt & 1;
        if (kt + 1 < nk) { G_STAGE(kt + 1, cur ^ 1); asm volatile("s_waitcnt vmcnt(6)" ::: "memory"); }
        else asm volatile("s_waitcnt vmcnt(0)" ::: "memory");
        __builtin_amdgcn_s_barrier();
        asm volatile("" ::: "memory");
        const LAS unsigned char* ab = lds + cur * G_BUF; const LAS unsigned char* bb = ab + G_ABUF;
#pragma unroll
        for (int ks = 0; ks < 2; ++ks) {
            bf16x8 af[4], bfr[4];
            const int co = (((ks * 4 + fq) ^ sw) << 4);
#pragma unroll
            for (int m = 0; m < 4; ++m) af[m] = *(const LAS bf16x8*)(ab + (arow + m * 16) * 128 + co);
#pragma unroll
            for (int n = 0; n < 4; ++n) bfr[n] = *(const LAS bf16x8*)(bb + (brow + n * 16) * 128 + co);
#pragma unroll
            for (int m = 0; m < 4; ++m)
#pragma unroll
                for (int n = 0; n < 4; ++n) acc[m][n] = __builtin_amdgcn_mfma_f32_16x16x32_bf16(bfr[n], af[m], acc[m][n], 0, 0, 0);
        }
        asm volatile("s_waitcnt lgkmcnt(0)" ::: "memory");
        __builtin_amdgcn_s_barrier();
        asm volatile("" ::: "memory");
    }
#undef G_STAGE
    epi(acc, wr, wc, fr, fq);
}
template <class E> struct EpiFrag {
    E e;
    __device__ __forceinline__ void operator()(const f32x4 (&acc)[4][4], int wr, int wc, int fr, int fq) const {
#pragma unroll
        for (int m = 0; m < 4; ++m)
#pragma unroll
            for (int n = 0; n < 4; ++n) e.store(wr * 64 + m * 16 + fr, wc * 64 + n * 16 + fq * 4, acc[m][n]);
    }
};
__device__ __forceinline__ void st_bf4(bf16_t* p, f32x4 v) { u32x2 w; w.x = pack2(v[0], v[1]); w.y = pack2(v[2], v[3]); *(u32x2*)p = w; }
__device__ __forceinline__ f32x4 ld_bf4(const bf16_t* p) { const u32x2 w = *(const u32x2*)p; return (f32x4){bflo(w.x), bfhi(w.x), bflo(w.y), bfhi(w.y)}; }

struct EInproj { bf16_t* UA; bf16_t* Z; int m0, n0;
    __device__ __forceinline__ void store(int rl, int cl, f32x4 v) const { const int s = m0 + rl, c = n0 + cl;
        if (c < 512) { const int g = c >> 4, hi = c & 15, rho = s >> 6, j = s & 63; st_bf4(UA + ((size_t)(g * UAROWS + rho) * UALD + j * 16 + hi), v); }
        else st_bf4(Z + (size_t)s * ZC + (c - 512), v); } };
struct ES5E { float* E; int g, m0, n0;
    __device__ __forceinline__ void store(int rl, int cl, f32x4 v) const { const int rho = m0 + rl; if (rho < NCHUNK) *(f32x4*)(E + ((size_t)(g * UAROWS + rho) * 256 + n0 + cl)) = v; } };
struct ES5Y { bf16_t* Z5; int g, m0, n0;
    __device__ __forceinline__ void store(int rl, int cl, f32x4 v) const { const int rho = m0 + rl; if (rho < NCHUNK) { const int col = n0 + cl, j = col >> 4, ho = col & 15;
        f32x4 o; o[0] = gelu_tanh(v[0]); o[1] = gelu_tanh(v[1]); o[2] = gelu_tanh(v[2]); o[3] = gelu_tanh(v[3]); st_bf4(Z5 + ((size_t)(rho * 64 + j) * 512 + g * 16 + ho), o); } } };
struct EGlu { const bf16_t* Z5; bf16_t* Y; int m0, n0;
    __device__ __forceinline__ void store(int rl, int cl, f32x4 v) const { const size_t r = m0 + rl; const int c = n0 + cl; const f32x4 z = ld_bf4(Z5 + r * 512 + c);
        f32x4 o; o[0] = z[0] * sigmoidf_(v[0]); o[1] = z[1] * sigmoidf_(v[1]); o[2] = z[2] * sigmoidf_(v[2]); o[3] = z[3] * sigmoidf_(v[3]); st_bf4(Y + r * DM + c, o); } };
struct EUp5 { const bf16_t* Z; bf16_t* Mb; int m0, n0;
    __device__ __forceinline__ void store(int rl, int cl, f32x4 v) const { const size_t r = m0 + rl; const int c = n0 + cl; const f32x4 z = ld_bf4(Z + r * ZC + Z6 + c);
        f32x4 o; o[0] = sigmoidf_(z[0]) * v[0]; o[1] = sigmoidf_(z[1]) * v[1]; o[2] = sigmoidf_(z[2]) * v[2]; o[3] = sigmoidf_(z[3]) * v[3]; st_bf4(Mb + r * DM + c, o); } };
struct EUph { const bf16_t* Z; bf16_t* Mb; int m0, n0;
    __device__ __forceinline__ void store(int rl, int cl, f32x4 v) const { const size_t r = m0 + rl; const int c = n0 + cl; const f32x4 z = ld_bf4(Z + r * ZC + Z7 + c); const f32x4 p = ld_bf4(Mb + r * DM + c);
        f32x4 o; o[0] = p[0] + sigmoidf_(z[0]) * v[0]; o[1] = p[1] + sigmoidf_(z[1]) * v[1]; o[2] = p[2] + sigmoidf_(z[2]) * v[2]; o[3] = p[3] + sigmoidf_(z[3]) * v[3]; st_bf4(Mb + r * DM + c, o); } };
struct EOut { float* XF; const float* modl; int odd, m0, n0;
    __device__ __forceinline__ void store(int rl, int cl, f32x4 v) const { const int s = m0 + rl, c = n0 + cl; const int r = sigma_inv(s, odd); const int mb = r < NLAT ? (r >> 14) : 2;
        const f32x4 g = *(const f32x4*)(modl + mb * NMOD + 2 * DM + c); float* xp = XF + (size_t)r * DM + c; f32x4 x = *(f32x4*)xp; x += g * v; *(f32x4*)xp = x; } };
struct EMoe2 { bf16_t* O; const float* b2; const float* rgate; int m0, n0;
    __device__ __forceinline__ void store(int rl, int cl, f32x4 v) const { const size_t r = m0 + rl; const int c = n0 + cl; const float g = rgate[r]; const f32x4 b = *(const f32x4*)(b2 + c);
        f32x4 o = (v + b) * g; st_bf4(O + r * DM + c, o); } };
struct EMoe1 { bf16_t* ACT; const float* b1; int m0, pn;
    __device__ __forceinline__ void operator()(const f32x4 (&acc)[4][4], int wr, int wc, int fr, int fq) const {
#pragma unroll
        for (int m = 0; m < 4; ++m)
#pragma unroll
            for (int n = 0; n < 2; ++n) { const size_t r = m0 + wr * 64 + m * 16 + fr; const int ch = pn * 64 + wc * 32 + n * 16 + fq * 4;
                const f32x4 bg = *(const f32x4*)(b1 + ch), bu = *(const f32x4*)(b1 + 1024 + ch); f32x4 o;
#pragma unroll
                for (int j = 0; j < 4; ++j) { float g = acc[m][n][j] + bg[j], u = acc[m][n + 2][j] + bu[j]; g = fminf(g, 7.0f); u = fminf(fmaxf(u, -7.0f), 7.0f); o[j] = g * sigmoidf_(1.702f * g) * (u + 1.0f); }
                st_bf4(ACT + r * DM + ch, o); }
    }
};


#define PROBE_EPI2 0
template <class E> struct epi_dup { static constexpr bool v = false; };
template <class E> struct epi_nst { static constexpr int v = 0; };
namespace g8 {
constexpr int BM = 256, BK = 64, HALF = 128, HTB = HALF * BK * 2, STAGE_BYTES = 8 * HTB;
__device__ __forceinline__ int lds_byte(int r, int c) { const int st = (r >> 4) * 2 + (c >> 5), rr = r & 15, cc = c & 31, ob = rr * 64 + cc * 2; return st * 1024 + (ob ^ (((ob >> 9) & 1) << 5)); }
__device__ __forceinline__ void stage_rc(int b, int& R, int& C) { const int st = b / 1024, sb = b % 1024, swz = sb ^ (((sb >> 9) & 1) << 5); R = (st >> 1) * 16 + swz / 64; C = (st & 1) * 32 + (swz % 64) / 2; }
__device__ __forceinline__ int perm32(int rho) { const int n = rho >> 4, i = rho & 15; return 8 * (i >> 2) + 4 * n + (i & 3); }
struct Unit { const char* a; const char* b; int pm, pn, aux; };
__device__ __forceinline__ i32x8 cat8(bf16x8 lo, bf16x8 hi) { typedef int i32x4 __attribute__((ext_vector_type(4))); const i32x4 a = __builtin_bit_cast(i32x4, lo), b = __builtin_bit_cast(i32x4, hi); return (i32x8){a[0], a[1], a[2], a[3], b[0], b[1], b[2], b[3]}; }
#ifndef G8_SP2
#define G8_SP2 1
#endif
#ifndef G8_ALIGN_EPI
#define G8_ALIGN_EPI 1
#endif
template <bool PERM, bool GATHER, bool FP8 = false, class Sched, class Epi>
__device__ __forceinline__ void gemm_phase(LAS unsigned char* lds, const int K, const unsigned lda_b, const unsigned ldb_b, const Sched& S, const Epi& E) {
    const int tid = ltid(), wid = __builtin_amdgcn_readfirstlane(tid >> 6), lane = tid & 63, wr = wid >> 2, wc = wid & 3, fr = lane & 15, fq = lane >> 4;
    const int nt = K / BK; constexpr int NST = epi_nst<Epi>::v;
    int Rr[2], Cc[2]; unsigned voffB[2], voffA[2][2], voffN[2][2];
#pragma unroll
    for (int i = 0; i < 2; ++i) { stage_rc(tid * 16 + i * 8192, Rr[i], Cc[i]); const int Rb = PERM ? ((Rr[i] & ~31) + perm32(Rr[i] & 31)) : Rr[i];
        voffB[i] = (unsigned)Rb * ldb_b + (unsigned)Cc[i] * 2u; }
    const size_t kstep = (size_t)(BK * 2);
    const size_t hstepB = (size_t)HALF * ldb_b;
    const unsigned ldsw = (unsigned)wid * 1024u;
    const int aoff = lds_byte(wr * 64 + fr, FP8 ? fq * 16 : fq * 8), boff = lds_byte(wc * 32 + fr, FP8 ? fq * 16 : fq * 8);
    constexpr int aoff1 = FP8 ? 16 : 1024, boff1 = aoff1;
#define G8_SA(b, h) (((b) * 2 + (h)) * HTB)
#define G8_SB(b, h) ((4 + (b) * 2 + (h)) * HTB)
#define G8_STAGE(bufoff, gbase, voff) do { _Pragma("unroll") for (int _i = 0; _i < 2; ++_i) \
        __builtin_amdgcn_global_load_lds((const unsigned*)((const char*)(gbase) + (voff)[_i]), (LAS unsigned*)(lds + (bufoff) + ldsw + _i * 8192), 16, 0, 0); } while (0)
#define G8_CAT(p0, p1) __builtin_shufflevector(p0, p1, 0, 1, 2, 3, 4, 5, 6, 7)
#define G8_LO(v) __builtin_bit_cast(bf16x8, __builtin_shufflevector(v, v, 0, 1, 2, 3))
#define G8_HI(v) __builtin_bit_cast(bf16x8, __builtin_shufflevector(v, v, 4, 5, 6, 7))
#define G8_LDA(dst, b, h) do { _Pragma("unroll") for (int m = 0; m < 4; ++m) { const i32x4v p0 = *(const LAS i32x4v*)(lds + G8_SA(b, h) + aoff + m * 2048), p1 = *(const LAS i32x4v*)(lds + G8_SA(b, h) + aoff + m * 2048 + aoff1); dst[m] = G8_CAT(p0, p1); } } while (0)
#define G8_LDB(dst, b, h) do { _Pragma("unroll") for (int n = 0; n < 2; ++n) { const i32x4v p0 = *(const LAS i32x4v*)(lds + G8_SB(b, h) + boff + n * 2048), p1 = *(const LAS i32x4v*)(lds + G8_SB(b, h) + boff + n * 2048 + boff1); dst[n] = G8_CAT(p0, p1); } } while (0)
#define G8_MMA(ai, bj, At, Bt) do { __builtin_amdgcn_s_setprio(1); _Pragma("unroll") for (int m = 0; m < 4; ++m) _Pragma("unroll") for (int n = 0; n < 2; ++n) { \
        if constexpr (FP8) asm volatile("v_mfma_scale_f32_16x16x128_f8f6f4 %0, %1, %2, %0, %3, %3 op_sel_hi:[0,0,0]" : "+v"(acc[ai][bj][m][n]) : "v"(Bt[n]), "v"(At[m]), "v"(one_scale)); \
        else { acc[ai][bj][m][n] = __builtin_amdgcn_mfma_f32_16x16x32_bf16(G8_LO(Bt[n]), G8_LO(At[m]), acc[ai][bj][m][n], 0, 0, 0); \
               acc[ai][bj][m][n] = __builtin_amdgcn_mfma_f32_16x16x32_bf16(G8_HI(Bt[n]), G8_HI(At[m]), acc[ai][bj][m][n], 0, 0, 0); } } \
        __builtin_amdgcn_s_setprio(0); } while (0)
#define G8_WAIT_V(n) asm volatile("s_waitcnt vmcnt(" #n ")" ::: "memory")
#define G8_WAIT_L(n) asm volatile("s_waitcnt lgkmcnt(" #n ")" ::: "memory")
#define G8_WAIT_VR() do { if (NST > 0 && t == 0 && ui > 0) asm volatile("s_waitcnt vmcnt(%0)" :: "i"(8 + NST) : "memory"); else G8_WAIT_V(8); } while (0)
#define G8_BAR __builtin_amdgcn_s_barrier()
#define G8_SCHED __builtin_amdgcn_sched_barrier(0)
#define G8_AOFFS(dst, u) do { _Pragma("unroll") for (int _h = 0; _h < 2; ++_h) _Pragma("unroll") for (int _i = 0; _i < 2; ++_i) { \
        const unsigned _row = GATHER ? min((unsigned)S.rows(u)[_h * HALF + Rr[_i]], (unsigned)(NTOK - 1)) : (unsigned)(_h * HALF + Rr[_i]); dst[_h][_i] = _row * lda_b + (unsigned)Cc[_i] * 2u; } } while (0)
    Unit cur, nxt; int ui = 0;
    if (!S.next(0, cur)) return;
    f32x4 acc[2][2][4][2];
#pragma unroll
    for (int a = 0; a < 2; ++a)
#pragma unroll
        for (int b = 0; b < 2; ++b)
#pragma unroll
            for (int m = 0; m < 4; ++m)
#pragma unroll
                for (int n = 0; n < 2; ++n) acc[a][b][m][n] = (f32x4){0.f, 0.f, 0.f, 0.f};
    i32x8 At[4], B0[2], B1[2];
    int one_scale = 0x7f7f7f7f; asm volatile("" : "+v"(one_scale));
    const char* cA = cur.a; const char* cB = cur.b;
    G8_AOFFS(voffA, cur);
    if (!GATHER) {
#pragma unroll
        for (int _h = 0; _h < 2; ++_h)
#pragma unroll
            for (int _i = 0; _i < 2; ++_i) voffN[_h][_i] = voffA[_h][_i]; }
    if (G8_SP2) {
        G8_STAGE(G8_SB(0, 0), cB, voffB); G8_STAGE(G8_SB(0, 1), cB + hstepB, voffB); G8_STAGE(G8_SA(0, 0), cA, voffA[0]); G8_STAGE(G8_SA(0, 1), cA, voffA[1]);
        if (wr == 1) G8_BAR;
        G8_WAIT_V(2); G8_BAR;
        G8_STAGE(G8_SB(1, 0), cB + kstep, voffB); G8_STAGE(G8_SA(1, 0), cA + kstep, voffA[0]); G8_STAGE(G8_SB(1, 1), cB + hstepB + kstep, voffB);
        G8_WAIT_V(6); G8_BAR;
    } else {
    G8_STAGE(G8_SB(0, 0), cB, voffB); G8_STAGE(G8_SA(0, 0), cA, voffA[0]); G8_STAGE(G8_SB(0, 1), cB + hstepB, voffB); G8_STAGE(G8_SA(0, 1), cA, voffA[1]);
    if (wr == 1) G8_BAR;
    G8_WAIT_V(4); G8_BAR;
    G8_STAGE(G8_SB(1, 0), cB + kstep, voffB); G8_STAGE(G8_SA(1, 0), cA + kstep, voffA[0]); G8_STAGE(G8_SB(1, 1), cB + hstepB + kstep, voffB);
    G8_WAIT_V(6); G8_BAR;
    }
    for (;;) {
        const bool has_next = S.next(ui + 1, nxt);
        const char* nA = has_next ? nxt.a : cA; const char* nB = has_next ? nxt.b : cB;
        if (GATHER) { if (has_next) { G8_AOFFS(voffN, nxt); } else {
#pragma unroll
            for (int _h = 0; _h < 2; ++_h)
#pragma unroll
                for (int _i = 0; _i < 2; ++_i) voffN[_h][_i] = voffA[_h][_i]; } }
#pragma nounroll
        for (int t = 0; t < nt; t += 2) {
            const bool last = (t == nt - 2);
            const char* a1 = cA + (size_t)(t + 1) * kstep;
            const char* a2 = last ? nA : cA + (size_t)(t + 2) * kstep; const char* b2 = last ? nB : cB + (size_t)(t + 2) * kstep;
            const char* a3 = a2 + kstep; const char* b3 = b2 + kstep;
            unsigned vA0[2], vA1[2];
#pragma unroll
            for (int _i = 0; _i < 2; ++_i) { vA0[_i] = (GATHER && last) ? voffN[0][_i] : voffA[0][_i]; vA1[_i] = (GATHER && last) ? voffN[1][_i] : voffA[1][_i]; }
            if (G8_SP2) {
            G8_LDB(B0, 0, 0); G8_LDB(B1, 0, 1); G8_SCHED; G8_LDA(At, 0, 0); G8_STAGE(G8_SA(1, 1), a1, voffA[1]);
            G8_WAIT_VR(); G8_WAIT_L(0); G8_BAR; G8_MMA(0, 0, At, B0); G8_MMA(0, 1, At, B1); G8_BAR; G8_SCHED;
            G8_LDA(At, 0, 1); G8_STAGE(G8_SB(0, 0), b2, voffB); G8_STAGE(G8_SB(0, 1), b2 + hstepB, voffB); G8_STAGE(G8_SA(0, 0), a2, vA0);
            G8_WAIT_VR(); G8_WAIT_L(0); G8_BAR; G8_MMA(1, 0, At, B0); G8_MMA(1, 1, At, B1); G8_BAR; G8_SCHED;
            G8_LDB(B0, 1, 0); G8_LDB(B1, 1, 1); G8_SCHED; G8_LDA(At, 1, 0); G8_STAGE(G8_SA(0, 1), a2, vA1);
            G8_WAIT_V(8); G8_WAIT_L(0); G8_BAR; G8_MMA(0, 0, At, B0); G8_MMA(0, 1, At, B1); G8_BAR; G8_SCHED;
            G8_LDA(At, 1, 1); G8_STAGE(G8_SB(1, 0), b3, voffB); G8_STAGE(G8_SB(1, 1), b3 + hstepB, voffB); G8_STAGE(G8_SA(1, 0), a3, vA0);
            G8_WAIT_V(8); G8_WAIT_L(0); G8_BAR; G8_MMA(1, 0, At, B0); G8_MMA(1, 1, At, B1); G8_BAR; G8_SCHED;
            } else {
            G8_LDB(B0, 0, 0); G8_SCHED; G8_LDA(At, 0, 0); G8_STAGE(G8_SA(1, 1), a1, voffA[1]);
            G8_WAIT_L(8); G8_BAR; G8_WAIT_L(0); G8_MMA(0, 0, At, B0); G8_BAR; G8_SCHED;
            G8_LDB(B1, 0, 1); G8_STAGE(G8_SB(0, 0), b2, voffB);
            G8_BAR; G8_WAIT_L(0); G8_MMA(0, 1, At, B1); G8_BAR;
            G8_LDA(At, 0, 1); G8_STAGE(G8_SA(0, 0), a2, vA0);
            G8_BAR; G8_WAIT_L(0); G8_MMA(1, 0, At, B0); G8_BAR; G8_SCHED;
            G8_STAGE(G8_SB(0, 1), b2 + hstepB, voffB);
            G8_WAIT_V(6); G8_BAR; G8_MMA(1, 1, At, B1); G8_BAR;
            G8_LDB(B0, 1, 0); G8_SCHED; G8_LDA(At, 1, 0); G8_STAGE(G8_SA(0, 1), a2, vA1);
            G8_WAIT_L(8); G8_BAR; G8_WAIT_L(0); G8_MMA(0, 0, At, B0); G8_BAR; G8_SCHED;
            G8_LDB(B1, 1, 1); G8_STAGE(G8_SB(1, 0), b3, voffB);
            G8_BAR; G8_WAIT_L(0); G8_MMA(0, 1, At, B1); G8_BAR;
            G8_LDA(At, 1, 1); G8_STAGE(G8_SA(1, 0), a3, vA0);
            G8_BAR; G8_WAIT_L(0); G8_MMA(1, 0, At, B0); G8_BAR; G8_SCHED;
            G8_STAGE(G8_SB(1, 1), b3 + hstepB, voffB);
            G8_WAIT_V(6); G8_BAR; G8_MMA(1, 1, At, B1); G8_BAR;
            }
        }
        if (G8_ALIGN_EPI) { if (wr == 0) G8_BAR; }
        asm volatile("" ::: "memory");
        E(acc, cur, wr, wc, fr, fq);
#if PROBE_EPI2
        if (epi_dup<Epi>::v) { asm volatile("" ::: "memory"); E(acc, cur, wr, wc, fr, fq); }
#endif
        if (!has_next) break;
#pragma unroll
        for (int a = 0; a < 2; ++a)
#pragma unroll
            for (int b = 0; b < 2; ++b)
#pragma unroll
                for (int m = 0; m < 4; ++m)
#pragma unroll
                    for (int n = 0; n < 2; ++n) acc[a][b][m][n] = (f32x4){0.f, 0.f, 0.f, 0.f};
        cur = nxt; cA = nA; cB = nB; ++ui;
        if (GATHER) {
#pragma unroll
            for (int _h = 0; _h < 2; ++_h)
#pragma unroll
                for (int _i = 0; _i < 2; ++_i) voffA[_h][_i] = voffN[_h][_i]; }
        if (G8_ALIGN_EPI) { if (wr == 1) G8_BAR; }
    }
    G8_WAIT_V(0);
    if (!G8_ALIGN_EPI) { if (wr == 0) G8_BAR; }
    G8_BAR;
#undef G8_SA
#undef G8_SB
#undef G8_STAGE
#undef G8_LDA
#undef G8_CAT
#undef G8_LO
#undef G8_HI
#undef G8_LDB
#undef G8_MMA
#undef G8_WAIT_V
#undef G8_WAIT_L
#undef G8_WAIT_VR
#undef G8_BAR
#undef G8_SCHED
#undef G8_AOFFS
}
template <class E> struct Epi8 { E e;
    __device__ __forceinline__ void operator()(const f32x4 (&acc)[2][2][4][2], const Unit& u, int wr, int wc, int fr, int fq) const {
#pragma unroll
        for (int ai = 0; ai < 2; ++ai)
#pragma unroll
            for (int m = 0; m < 4; ++m) {
#pragma unroll
                for (int bj = 0; bj < 2; ++bj) e.store8(u, ai * 128 + wr * 64 + m * 16 + fr, bj * 128 + wc * 32 + fq * 8, acc[ai][bj][m][0], acc[ai][bj][m][1]);
                asm volatile("" ::: "memory"); } } };
template <class E> struct Epi4 { E e;
    __device__ __forceinline__ void operator()(const f32x4 (&acc)[2][2][4][2], const Unit& u, int wr, int wc, int fr, int fq) const {
#pragma unroll
        for (int ai = 0; ai < 2; ++ai)
#pragma unroll
            for (int m = 0; m < 4; ++m) {
#pragma unroll
                for (int bj = 0; bj < 2; ++bj)
#pragma unroll
                    for (int n = 0; n < 2; ++n) e.store4(u, ai * 128 + wr * 64 + m * 16 + fr, bj * 128 + wc * 32 + n * 16 + fq * 4, acc[ai][bj][m][n]);
                asm volatile("" ::: "memory"); } } };
struct GridOrder { const char* A; const char* B; size_t tstepA, tstepB; int nM, nN, nwg, G, c;
    __device__ __forceinline__ bool next(int i, Unit& u) const {
        const long L = (long)i * G + c; if (L >= nwg) return false;
        int wgid = (int)L; { const int q = nwg / 8, r = nwg % 8, xcd = wgid % 8, off = wgid / 8; wgid = (xcd < r ? xcd * (q + 1) : r * (q + 1) + (xcd - r) * q) + off; }
        const int nig = 8 * nN, gid = wgid / nig, fm = gid * 8, gsz = (nM - fm) < 8 ? (nM - fm) : 8;
        u.pm = fm + ((wgid % nig) % gsz); u.pn = (wgid % nig) / gsz; u.a = A + (size_t)u.pm * tstepA; u.b = B + (size_t)u.pn * tstepB; u.aux = 0; return true; }
    __device__ __forceinline__ const int* rows(const Unit&) const { return nullptr; } };
}
__device__ __forceinline__ void st_bf8(bf16_t* p, f32x4 a, f32x4 b) { u32x4 w; w.x = pack2(a[0], a[1]); w.y = pack2(a[2], a[3]); w.z = pack2(b[0], b[1]); w.w = pack2(b[2], b[3]); *(u32x4*)p = w; }
__device__ __forceinline__ void ld_bf8(const bf16_t* p, f32x4& a, f32x4& b) { const u32x4 w = *(const u32x4*)p; a = (f32x4){bflo(w.x), bfhi(w.x), bflo(w.y), bfhi(w.y)}; b = (f32x4){bflo(w.z), bfhi(w.z), bflo(w.w), bfhi(w.w)}; }
__device__ __forceinline__ f32x4 sig4(f32x4 z) { return (f32x4){sigmoidf_(z[0]), sigmoidf_(z[1]), sigmoidf_(z[2]), sigmoidf_(z[3])}; }

struct F8Inproj { bf16_t* UA; bf16_t* Z; unsigned char* ZG8;
    __device__ __forceinline__ void operator()(const f32x4 (&acc)[2][2][4][2], const g8::Unit& u, int wr, int wc, int fr, int fq) const {
        const int s0 = u.pm * 256 + wr * 64 + fr, c0 = wc * 32 + fq * 8;
        if (u.pn < 2) {
#pragma unroll
            for (int ai = 0; ai < 2; ++ai)
#pragma unroll
                for (int m = 0; m < 4; ++m) { const int s = s0 + ai * 128 + m * 16, rho = s >> 6, j = s & 63;
#pragma unroll
                    for (int bj = 0; bj < 2; ++bj) { const int c = u.pn * 256 + bj * 128 + c0, g = c >> 4, hi = c & 15;
                        st_bf8(UA + ((size_t)(g * UAROWS + rho) * UALD + j * 16 + hi), acc[ai][bj][m][0], acc[ai][bj][m][1]); }
                    asm volatile("" ::: "memory"); } }
        else if (ZG8_FP8 && u.pn >= (512 + Z6) / 256) { unsigned char* zp = ZG8 + (size_t)s0 * 2048 + (u.pn * 256 + c0 - 512 - Z6);
#pragma unroll
            for (int ai = 0; ai < 2; ++ai)
#pragma unroll
                for (int m = 0; m < 4; ++m) { unsigned char* zr = zp + (size_t)(ai * 128 + m * 16) * 2048;
#pragma unroll
                    for (int bj = 0; bj < 2; ++bj) { const f32x4 v0 = acc[ai][bj][m][0] * ZG8_SCALE, v1 = acc[ai][bj][m][1] * ZG8_SCALE; u32x2 w8; w8.x = pack4_fp8(v0[0], v0[1], v0[2], v0[3]); w8.y = pack4_fp8(v1[0], v1[1], v1[2], v1[3]);
                        *(u32x2*)(zr + bj * 128) = w8; } } }
        else { bf16_t* zp = Z + (size_t)s0 * ZC + (u.pn * 256 + c0 - 512);
#pragma unroll
            for (int ai = 0; ai < 2; ++ai)
#pragma unroll
                for (int m = 0; m < 4; ++m) { bf16_t* zr = zp + (size_t)(ai * 128 + m * 16) * ZC;
                    st_bf8(zr, acc[ai][0][m][0], acc[ai][0][m][1]); st_bf8(zr + 128, acc[ai][1][m][0], acc[ai][1][m][1]); } }
    } };
struct F8S5E { float* E;
    __device__ __forceinline__ void store4(const g8::Unit& u, int rl, int cl, f32x4 v) const { const int rho = u.pm * 256 + rl; if (rho < NCHUNK) *(f32x4*)(E + ((size_t)(u.aux * UAROWS + rho) * 256 + cl)) = v; } };
struct F8S5Y { bf16_t* Z5;
    __device__ __forceinline__ void store8(const g8::Unit& u, int rl, int cl, f32x4 v0, f32x4 v1) const { const int rho = u.pm * 256 + rl; if (rho < NCHUNK) { const int col = u.pn * 256 + cl, j = col >> 4, ho = col & 15;
        f32x4 a, b;
#pragma unroll
        for (int k = 0; k < 4; ++k) { a[k] = gelu_tanh(v0[k]); b[k] = gelu_tanh(v1[k]); }
        st_bf8(Z5 + ((size_t)(rho * 64 + j) * 512 + u.aux * 16 + ho), a, b); } } };
struct F8Glu { const bf16_t* Z5; bf16_t* Y;
    __device__ __forceinline__ void store8(const g8::Unit& u, int rl, int cl, f32x4 v0, f32x4 v1) const { const size_t r = u.pm * 256 + rl; const int c = u.pn * 256 + cl; f32x4 z0, z1; ld_bf8(Z5 + r * 512 + c, z0, z1);
        st_bf8(Y + r * DM + c, z0 * sig4(v0), z1 * sig4(v1)); } };
struct F8Up5 { const bf16_t* Z; bf16_t* Mb; const unsigned char* ZG8;
    __device__ __forceinline__ void store8(const g8::Unit& u, int rl, int cl, f32x4 v0, f32x4 v1) const { const size_t r = u.pm * 256 + rl; const int c = u.pn * 256 + cl; f32x4 z0, z1;
        if (ZG8_FP8) { const u32x2 w = *(const u32x2*)(ZG8 + r * 2048 + c); z0 = up4_fp8(w.x) * (1.0f / ZG8_SCALE); z1 = up4_fp8(w.y) * (1.0f / ZG8_SCALE); } else ld_bf8(Z + r * ZC + Z6 + c, z0, z1);
        st_bf8(Mb + r * DM + c, sig4(z0) * v0, sig4(z1) * v1); } };
struct F8Uph { const bf16_t* Z; bf16_t* Mb; bf16_t* Mo; const unsigned char* ZG8;
    __device__ __forceinline__ void store8(const g8::Unit& u, int rl, int cl, f32x4 v0, f32x4 v1) const { const size_t r = u.pm * 256 + rl; const int c = u.pn * 256 + cl; f32x4 z0, z1, p0, p1;
        if (ZG8_FP8) { const u32x2 w = *(const u32x2*)(ZG8 + r * 2048 + (Z7 - Z6) + c); z0 = up4_fp8(w.x) * (1.0f / ZG8_SCALE); z1 = up4_fp8(w.y) * (1.0f / ZG8_SCALE); } else ld_bf8(Z + r * ZC + Z7 + c, z0, z1);
        ld_bf8(Mb + r * DM + c, p0, p1);
        st_bf8(Mo + r * DM + c, p0 + sig4(z0) * v0, p1 + sig4(z1) * v1); } };
struct F8Out { bf16_t* XF; const float* modl; int odd;
    __device__ __forceinline__ void operator()(const f32x4 (&acc)[2][2][4][2], const g8::Unit& u, int wr, int wc, int fr, int fq) const {
        const int s0 = u.pm * 256 + wr * 64 + fr, c0 = u.pn * 256 + wc * 32 + fq * 8;
        const int mb = u.pm < NLAT / 256 ? (u.pm >> 6) : 2;
        const float* gp = modl + mb * NMOD + 2 * DM + c0; f32x4 g[2][2];
#pragma unroll
        for (int bj = 0; bj < 2; ++bj) { g[bj][0] = *(const f32x4*)(gp + bj * 128); g[bj][1] = *(const f32x4*)(gp + bj * 128 + 4); }
#pragma unroll
        for (int ai = 0; ai < 2; ++ai)
#pragma unroll
            for (int m = 0; m < 4; ++m) { const int r = sigma_inv(s0 + ai * 128 + m * 16, odd); bf16_t* xp = XF + (size_t)r * DM + c0;
#pragma unroll
                for (int bj = 0; bj < 2; ++bj) { f32x4 x0, x1; ld_bf8(xp + bj * 128, x0, x1); x0 += g[bj][0] * acc[ai][bj][m][0]; x1 += g[bj][1] * acc[ai][bj][m][1];
                    st_bf8(xp + bj * 128, x0, x1); }
                if (m & 1) asm volatile("" ::: "memory"); }
    } };
constexpr float M2S = MOE2_FP8 ? 1.0f / (FP8_WSCALE * FP8_ASCALE) : 1.0f;
#ifndef OUT2_FP8
#define OUT2_FP8 1
#endif
constexpr float OUT2_SCALE = 32.0f;

struct F8Moe2 { bf16_t* O; const float* b2; const float* rgate; const int* ps;
    __device__ __forceinline__ void operator()(const f32x4 (&acc)[2][2][4][2], const g8::Unit& u, int wr, int wc, int fr, int fq) const {
        const size_t r0 = (size_t)u.pm * 256 + wr * 64 + fr; const int c0 = u.pn * 256 + wc * 32 + fq * 8;
        const float* bp = b2 + (size_t)u.aux * 1024 + c0; f32x4 b[2][2];
#pragma unroll
        for (int bj = 0; bj < 2; ++bj) { b[bj][0] = *(const f32x4*)(bp + bj * 128); b[bj][1] = *(const f32x4*)(bp + bj * 128 + 4); }
        float gt[2][4]; const float* gr = rgate + (size_t)u.aux * NTOK + (u.pm * 256 - ps[u.aux]) + wr * 64 + fr;
#pragma unroll
        for (int ai = 0; ai < 2; ++ai)
#pragma unroll
            for (int m = 0; m < 4; ++m) gt[ai][m] = gr[ai * 128 + m * 16];
#pragma unroll
        for (int ai = 0; ai < 2; ++ai)
#pragma unroll
            for (int m = 0; m < 4; ++m) { bf16_t* op = O + (r0 + ai * 128 + m * 16) * DM + c0; const float g = gt[ai][m] * (OUT2_FP8 ? OUT2_SCALE : 1.0f);
#pragma unroll
                for (int bj = 0; bj < 2; ++bj) { const f32x4 v0 = (acc[ai][bj][m][0] * M2S + b[bj][0]) * g, v1 = (acc[ai][bj][m][1] * M2S + b[bj][1]) * g;
                    if (OUT2_FP8) { u32x2 w8; w8.x = pack4_fp8(v0[0], v0[1], v0[2], v0[3]); w8.y = pack4_fp8(v1[0], v1[1], v1[2], v1[3]);
                        *(u32x2*)((unsigned char*)O + (r0 + ai * 128 + m * 16) * DM + c0 + bj * 128) = w8; }
                    else st_bf8(op + bj * 128, v0, v1); } }
    } };
struct F8Moe1 { bf16_t* ACT; const float* b1;
    __device__ __forceinline__ void operator()(const f32x4 (&acc)[2][2][4][2], const g8::Unit& u, int wr, int wc, int fr, int fq) const {
        typedef float f32x2 __attribute__((ext_vector_type(2)));
        constexpr float SC = 1.0f / (FP8_WSCALE * FP8_ASCALE), AS = MOE2_FP8 ? FP8_ASCALE : 1.0f;
        const int ch = u.pn * 128 + wc * 32 + fq * 8; const float* bp = b1 + (size_t)u.aux * 2048 + ch; f32x4 bg[2], bu[2];
#pragma unroll
        for (int n = 0; n < 2; ++n) { bg[n] = *(const f32x4*)(bp + n * 4); bu[n] = (*(const f32x4*)(bp + 1024 + n * 4) + 1.0f) * AS; }
        bf16_t* ap = ACT + ((size_t)u.pm * 256 + wr * 64 + fr) * DM + ch;
#pragma unroll
        for (int ai = 0; ai < 2; ++ai)
#pragma unroll
            for (int m = 0; m < 4; ++m) { f32x2 o[2][2];
#pragma unroll
                for (int n = 0; n < 2; ++n)
#pragma unroll
                    for (int q = 0; q < 2; ++q) { const f32x2 ag = {acc[ai][0][m][n][2 * q], acc[ai][0][m][n][2 * q + 1]}, au = {acc[ai][1][m][n][2 * q], acc[ai][1][m][n][2 * q + 1]};
                        const f32x2 bg2 = {bg[n][2 * q], bg[n][2 * q + 1]}, bu2 = {bu[n][2 * q], bu[n][2 * q + 1]};
                        f32x2 g = ag * SC + bg2, uu = au * (SC * AS) + bu2;
                        g.x = fminf(g.x, 7.0f); g.y = fminf(g.y, 7.0f); uu.x = __builtin_amdgcn_fmed3f(uu.x, -6.0f * AS, 8.0f * AS); uu.y = __builtin_amdgcn_fmed3f(uu.y, -6.0f * AS, 8.0f * AS);
                        const f32x2 t = g * (-1.702f * 1.4426950408889634f); f32x2 e = {__builtin_amdgcn_exp2f(t.x), __builtin_amdgcn_exp2f(t.y)}; e = e + 1.0f;
                        const f32x2 r = {__builtin_amdgcn_rcpf(e.x), __builtin_amdgcn_rcpf(e.y)};
                        o[n][q] = g * r * uu; }
                if (MOE2_FP8) { u32x2 w8; unsigned w = 0u;
                    w = __builtin_amdgcn_cvt_pk_fp8_f32(o[0][0].x, o[0][0].y, w, false); w = __builtin_amdgcn_cvt_pk_fp8_f32(o[0][1].x, o[0][1].y, w, true); w8.x = w; w = 0u;
                    w = __builtin_amdgcn_cvt_pk_fp8_f32(o[1][0].x, o[1][0].y, w, false); w = __builtin_amdgcn_cvt_pk_fp8_f32(o[1][1].x, o[1][1].y, w, true); w8.y = w;
                    *(u32x2*)((unsigned char*)ACT + ((size_t)u.pm * 256 + wr * 64 + fr + ai * 128 + m * 16) * DM + ch) = w8; }
                else st_bf8(ap + (size_t)(ai * 128 + m * 16) * DM, (f32x4){o[0][0].x, o[0][0].y, o[0][1].x, o[0][1].y}, (f32x4){o[1][0].x, o[1][0].y, o[1][1].x, o[1][1].y}); }
    } };
template <> struct epi_nst<F8Inproj> { static constexpr int v = 16; };
template <> struct epi_nst<g8::Epi8<F8Glu>> { static constexpr int v = 16; };
template <> struct epi_nst<g8::Epi8<F8Up5>> { static constexpr int v = 16; };
template <> struct epi_nst<g8::Epi8<F8Uph>> { static constexpr int v = 16; };
template <> struct epi_nst<F8Out> { static constexpr int v = 16; };
template <> struct epi_nst<F8Moe1> { static constexpr int v = 8; };
template <> struct epi_nst<F8Moe2> { static constexpr int v = 16; };
struct S5Order { const char* A; const char* B; size_t gstepA, gstepB; unsigned lda_b, ldb_b; int MT, NT, G, c;
    __device__ __forceinline__ bool next(int i, g8::Unit& u) const { int g, r;
        if ((G & 7) == 0) { const int x = c & 7, per = G >> 3, e = i * per + (per - 1 - (c >> 3)); if (e >= 4 * MT * NT) return false; g = x + 8 * (e / (MT * NT)); r = e % (MT * NT); }
        else { const int L = i * G + (G - 1 - c); if (L >= S5G * MT * NT) return false; g = L / (MT * NT); r = L % (MT * NT); }
        const int mt = r / NT, nt = r % NT;
        u.pm = mt; u.pn = nt; u.aux = g; u.a = A + (size_t)g * gstepA + (size_t)mt * 256 * lda_b; u.b = B + (size_t)g * gstepB + (size_t)nt * 256 * ldb_b; return true; }
    __device__ __forceinline__ const int* rows(const g8::Unit&) const { return nullptr; } };
struct MoeOrder { const char* A; const char* B; const int* rowtok; const int* te; unsigned estepB; int NT, ntile, G, c; bool gather; unsigned tstepB = 256 * DM * 2;
    __device__ __forceinline__ bool next(int i, g8::Unit& u) const { const int x = c & 7, slot = c >> 3; int t, pn;
        if (G != 256) { const int L = i * G + c; t = L / NT; pn = L % NT; } else if (NT == 4) { t = i * 64 + x * 8 + (slot >> 2); pn = slot & 3; } else { t = i * 32 + (x >> 1) * 8 + (slot >> 2); pn = (x & 1) * 4 + (slot & 3); }
        if (t >= ntile) return false; const int e = te[t];
        u.pm = t; u.pn = pn; u.aux = e; u.a = gather ? A : A + (size_t)t * tstepB; u.b = B + (size_t)e * estepB + (size_t)pn * tstepB; return true; }
    __device__ __forceinline__ const int* rows(const g8::Unit& u) const { return rowtok + (size_t)u.aux * NTOK + (u.pm * 256 - te[u.aux - 64]); } };

template <bool WIDE = false>
__device__ __forceinline__ void norm_mod_row(f32x4 (&x)[4], const float* g, const float* shift, const float* scale, int lane) {
    float ss = 0.f;
#pragma unroll
    for (int k = 0; k < 4; ++k) ss += x[k][0] * x[k][0] + x[k][1] * x[k][1] + x[k][2] * x[k][2] + x[k][3] * x[k][3];
    ss = wave_sum(ss);
    const float rstd = rsqrtf(ss * (1.0f / DM) + EPS);
#pragma unroll
    for (int k = 0; k < 4; ++k) { const int c = WIDE ? lane * 16 + k * 4 : lane * 4 + k * 256; const f32x4 gg = *(const f32x4*)(g + c), sh = *(const f32x4*)(shift + c), sc = *(const f32x4*)(scale + c);
        x[k] = x[k] * rstd * gg * (sc + 1.0f) + sh; }
}

typedef float2 c32;
constexpr int S5T_PW = 2 * 64 * 65, S5T_BB = 2 * 64 * 16, S5T_CC = 2 * 16 * 64, S5T_ALL = S5T_PW + S5T_BB + S5T_CC;
static __device__ __forceinline__ void s5_stage1(unsigned char* ws, const float* const* tab, unsigned char* lds_g, int l, int g) {
    c32* pw = (c32*)lds_g;
    c32* bb = pw + S5T_PW;
    c32* cc = bb + S5T_BB;
    const int tid = ltid();
    const float* a_re = tab[I_ARE]; const float* a_im = tab[I_AIM]; const float* ldt = tab[I_LOGDT];
    for (int idx = tid; idx < S5T_PW; idx += NTHREADS) { const int n = idx % 65, p = (idx / 65) & 63, d = idx / (65 * 64);
        const int gi = (l * 2 + d) * S5G + g; const double are = a_re[gi * 64 + p], aim = a_im[gi * 64 + p], dt = exp((double)ldt[gi]);
        const double mag = exp(are * dt * n), ang = aim * dt * n; pw[idx] = make_float2((float)(mag * cos(ang)), (float)(mag * sin(ang))); }
    for (int idx = tid; idx < S5T_BB; idx += NTHREADS) { const int hi = idx & 15, p = (idx >> 4) & 63, d = idx >> 10;
        const int gi = (l * 2 + d) * S5G + g; const double are = a_re[gi * 64 + p], aim = a_im[gi * 64 + p], dt = exp((double)ldt[gi]);
        const double mag = exp(are * dt), lbr = mag * cos(aim * dt), lbi = mag * sin(aim * dt), den = are * are + aim * aim, nr = lbr - 1.0;
        const double qr = (nr * are + lbi * aim) / den, qi = (lbi * are - nr * aim) / den;
        const double br = tab[I_BRE][(size_t)(gi * 64 + p) * 16 + hi], bi = tab[I_BIM][(size_t)(gi * 64 + p) * 16 + hi];
        bb[idx] = make_float2((float)(qr * br - qi * bi), (float)(qr * bi + qi * br)); }
    for (int idx = tid; idx < S5T_CC; idx += NTHREADS) { const int p = idx & 63, ho = (idx >> 6) & 15, d = idx >> 10;
        const int gi = (l * 2 + d) * S5G + g; cc[idx] = make_float2(tab[I_CRE][(size_t)(gi * 16 + ho) * 64 + p], tab[I_CIM][(size_t)(gi * 16 + ho) * 64 + p]); }
    __syncthreads();
    c32* gsc = (c32*)(ws + WS_S5T) + (size_t)(l * S5G + g) * S5T_ALL;
    for (int idx = tid; idx < S5T_ALL; idx += NTHREADS) gsc[idx] = pw[idx];
    if (tid < 128) { const int d = tid >> 6, p = tid & 63; ((c32*)(ws + WS_LAMT))[((l * 2 + d) * S5G + g) * 64 + p] = pw[(d * 64 + p) * 65 + 64]; }
    { const int hi = tid & 15, ho = (tid >> 4) & 15, d = tid >> 8; float gr[64], gim[64];
#pragma unroll
      for (int p = 0; p < 64; ++p) { const c32 c = cc[(d * 16 + ho) * 64 + p], b = bb[(d * 64 + p) * 16 + hi]; gr[p] = c.x * b.x - c.y * b.y; gim[p] = c.x * b.y + c.y * b.x; }
      float* KT = (float*)(ws + WS_KT) + (size_t)(l * S5G + g) * 2 * 64 * 256 + d * 64 * 256 + ho * 16 + hi;
      for (int dl = 0; dl < 64; ++dl) { float s = 0.f;
#pragma unroll
          for (int p = 0; p < 64; ++p) { const c32 w = pw[(d * 64 + p) * 65 + dl]; s += gr[p] * w.x - gim[p] * w.y; if ((p & 15) == 15) asm volatile("" ::: "memory"); }
          KT[dl * 256] = s; } }
    __syncthreads();
}
static __device__ __forceinline__ void s5_stage2(unsigned char* ws, const float* const* tab, unsigned char* lds_g, int l, int g, int rq) {
    c32* pw = (c32*)lds_g; c32* bb = pw + S5T_PW; c32* cc = bb + S5T_BB;
    const int tid = ltid();
    const c32* gsc = (const c32*)(ws + WS_S5T) + (size_t)(l * S5G + g) * S5T_ALL;
    for (int idx = tid; idx < S5T_ALL; idx += NTHREADS) pw[idx] = gsc[idx];
    __syncthreads();
    const float* KT = (const float*)(ws + WS_KT) + (size_t)(l * S5G + g) * 2 * 64 * 256;
    const float* dsk = tab[I_S5D] + l * 512 + g * 16;
    bf16_t* BT2 = (bf16_t*)(ws + WS_BT2) + (size_t)(l * S5G + g) * 1024 * UALD;
    for (int ck = tid; ck < 256 * 160; ck += NTHREADS) { const int row = rq * 256 + ck / 160, c8 = ck % 160, j = row >> 4, ho = row & 15; float v[8];
        if (c8 < 128) { const int i = c8 >> 1, hi0 = (c8 & 1) * 8;
#pragma unroll
            for (int q = 0; q < 8; ++q) v[q] = 0.f;
            if (j >= i) { const f32x4 a = *(const f32x4*)(KT + ((0 * 64 + (j - i)) * 16 + ho) * 16 + hi0), b = *(const f32x4*)(KT + ((0 * 64 + (j - i)) * 16 + ho) * 16 + hi0 + 4);
#pragma unroll
                for (int q = 0; q < 4; ++q) { v[q] += a[q]; v[4 + q] += b[q]; } }
            if (i >= j) { const f32x4 a = *(const f32x4*)(KT + ((1 * 64 + (i - j)) * 16 + ho) * 16 + hi0), b = *(const f32x4*)(KT + ((1 * 64 + (i - j)) * 16 + ho) * 16 + hi0 + 4);
#pragma unroll
                for (int q = 0; q < 4; ++q) { v[q] += a[q]; v[4 + q] += b[q]; } }
            if (i == j) {
#pragma unroll
                for (int q = 0; q < 8; ++q) if (hi0 + q == ho) v[q] += dsk[ho]; } }
        else { const int kap0 = (c8 - 128) * 8, d = kap0 >> 7, ri = (kap0 >> 6) & 1, p0 = kap0 & 63, n = d == 0 ? j + 1 : 64 - j;
#pragma unroll
            for (int q = 0; q < 8; ++q) { const int p = p0 + q; const c32 c = cc[(d * 16 + ho) * 64 + p], w = pw[(d * 64 + p) * 65 + n];
                const float re = c.x * w.x - c.y * w.y, im = c.x * w.y + c.y * w.x; v[q] = ri == 0 ? re : -im; } }
        u32x4 o; o.x = pack2(v[0], v[1]); o.y = pack2(v[2], v[3]); o.z = pack2(v[4], v[5]); o.w = pack2(v[6], v[7]);
        *(u32x4*)(BT2 + (size_t)row * UALD + c8 * 8) = o; }
    bf16_t* BT1 = (bf16_t*)(ws + WS_BT1) + (size_t)(l * S5G + g) * 256 * 1024;
    for (int ck = tid; ck < 64 * 128; ck += NTHREADS) { const int kap = rq * 64 + (ck >> 7), c8 = ck & 127, d = kap >> 7, ri = (kap >> 6) & 1, p = kap & 63, i = c8 >> 1, hi0 = (c8 & 1) * 8;
        const int n = d == 0 ? 63 - i : i; const c32 w = pw[(d * 64 + p) * 65 + n]; float v[8];
#pragma unroll
        for (int q = 0; q < 8; ++q) { const c32 b = bb[(d * 64 + p) * 16 + hi0 + q]; const float re = w.x * b.x - w.y * b.y, im = w.x * b.y + w.y * b.x; v[q] = ri == 0 ? re : im; }
        u32x4 o; o.x = pack2(v[0], v[1]); o.y = pack2(v[2], v[3]); o.z = pack2(v[4], v[5]); o.w = pack2(v[6], v[7]);
        *(u32x4*)(BT1 + (size_t)kap * 1024 + c8 * 8) = o; }
    __syncthreads();
}

constexpr int CVP = 66;
template <int MAPW1>
__device__ __forceinline__ void conv_run(unsigned char* lds_g, const float* src, int K, int N, bf16_t* dst, int R0, int k0, int nst) {
    const int tid = ltid(), lane = tid & 63, w = tid >> 6;
    const int n4 = (w & 3) * 16 + (lane & 15), kpl = (lane >> 4) + 4 * (w >> 2);
    const int Rl = 4 * n4; const int R = R0 + Rl;
    const int sc = MAPW1 ? ((Rl & 128) ? 1024 : 0) + (R0 >> 8) * 128 + (Rl & 127) : R;
    const float* sp = src + (size_t)(k0 + 2 * kpl) * N + sc;
    f32x4 A[8], B[8];
#define CV_LOAD(X, kt) do { _Pragma("unroll") for (int p = 0; p < 4; ++p) { const float* q = sp + (size_t)((kt) * 64 + 16 * p) * N; X[2 * p] = __builtin_nontemporal_load((const f32x4*)q); X[2 * p + 1] = __builtin_nontemporal_load((const f32x4*)(q + N)); } } while (0)
#define CV_EMIT(X, kt, buf) do { unsigned* T = (unsigned*)(lds_g + (buf) * 256 * CVP * 2); \
        _Pragma("unroll") for (int p = 0; p < 4; ++p) _Pragma("unroll") for (int i = 0; i < 4; ++i) T[(Rl + i) * (CVP / 2) + kpl + 8 * p] = pack2(X[2 * p][i], X[2 * p + 1][i]); \
        __syncthreads(); \
        _Pragma("unroll") for (int j = 0; j < 4; ++j) { const int piece = tid + j * 512, n = piece >> 3, c = piece & 7; const unsigned* tp = T + n * (CVP / 2) + c * 4; \
            u32x4 o; o.x = tp[0]; o.y = tp[1]; o.z = tp[2]; o.w = tp[3]; *(u32x4*)(dst + (size_t)(R0 + n) * K + k0 + (kt) * 64 + c * 8) = o; } } while (0)
    CV_LOAD(A, 0);
    for (int kt = 0; kt < nst; kt += 2) {
        if (kt + 1 < nst) CV_LOAD(B, kt + 1);
        CV_EMIT(A, kt, 0);
        if (kt + 1 < nst) { if (kt + 2 < nst) CV_LOAD(A, kt + 2); CV_EMIT(B, kt + 1, 1); }
    }
    __syncthreads();
#undef CV_LOAD
#undef CV_EMIT
}

template <int MAPW1>
__device__ __forceinline__ void conv_run8(unsigned char* lds_g, const float* src, int K, int N, unsigned char* dst, int R0, int k0, int nst) {
    const int tid = ltid(), lane = tid & 63, w = tid >> 6;
    const int n4 = (w & 3) * 16 + (lane & 15), kql = (lane >> 4) + 4 * (w >> 2);
    const int Rl = 4 * n4;
    const int sc = MAPW1 ? ((Rl & 128) ? 1024 : 0) + (R0 >> 8) * 128 + (Rl & 127) : R0 + Rl;
    const float* sp = src + (size_t)(k0 + 4 * kql) * N + sc;
    f32x4 A[8], B[8];
#define CV8_LOAD(X, kt) do { _Pragma("unroll") for (int p = 0; p < 2; ++p) _Pragma("unroll") for (int q = 0; q < 4; ++q) X[4 * p + q] = __builtin_nontemporal_load((const f32x4*)(sp + (size_t)((kt) * 64 + 32 * p + q) * N)); } while (0)
#define CV8_EMIT(X, kt, buf) do { unsigned* T = (unsigned*)(lds_g + (buf) * 256 * 17 * 4); \
        _Pragma("unroll") for (int p = 0; p < 2; ++p) _Pragma("unroll") for (int i = 0; i < 4; ++i) \
            T[(Rl + i) * 17 + kql + 8 * p] = pack4_fp8(X[4 * p][i] * FP8_WSCALE, X[4 * p + 1][i] * FP8_WSCALE, X[4 * p + 2][i] * FP8_WSCALE, X[4 * p + 3][i] * FP8_WSCALE); \
        __syncthreads(); \
        _Pragma("unroll") for (int j = 0; j < 2; ++j) { const int piece = tid + j * 512, n = piece >> 2, c = piece & 3; const unsigned* tp = T + n * 17 + c * 4; \
            u32x4 o; o.x = tp[0]; o.y = tp[1]; o.z = tp[2]; o.w = tp[3]; *(u32x4*)(dst + (size_t)(R0 + n) * K + k0 + (kt) * 64 + c * 16) = o; } } while (0)
    CV8_LOAD(A, 0);
    for (int kt = 0; kt < nst; kt += 2) {
        if (kt + 1 < nst) CV8_LOAD(B, kt + 1);
        CV8_EMIT(A, kt, 0);
        if (kt + 1 < nst) { if (kt + 2 < nst) CV8_LOAD(A, kt + 2); CV8_EMIT(B, kt + 1, 1); }
    }
    __syncthreads();
#undef CV8_LOAD
#undef CV8_EMIT
}

constexpr int CVK = 4;
constexpr int PQ_S5 = DEPTH * S5G, PQ_MOD = DEPTH * 96;
constexpr int CVI_WIN = (NIN / 256) * (DM / 64 / CVK), CVI_GLU = 2 * (512 / 64 / CVK), CVI_UP = 4 * (512 / 64 / CVK), CVI_OUT = 4 * (1024 / 64 / CVK);
constexpr int CVI_LAYER = CVI_WIN + CVI_GLU + 2 * CVI_UP + CVI_OUT;
constexpr int CVI_W1 = 8 * (1024 / 64 / CVK), CVI_W2 = 4 * (1024 / 64 / CVK);
constexpr int PQ_CONV = CVI_LAYER + NE * (CVI_W1 + CVI_W2);
constexpr int PQ_XF = NTOK / 256, PQ_LB = 1;
constexpr int PQ_TOTAL = PQ_S5 + PQ_MOD + PQ_CONV + PQ_XF + PQ_LB;

constexpr int CVI_PER_LAYER = CVI_LAYER + NE * (CVI_W1 + CVI_W2);
static __device__ __forceinline__ void conv_item(unsigned char* ws, const float* const* tab, unsigned char* lds_g, int l, int w) {
    if (w < CVI_WIN) { conv_run<0>(lds_g, tab[I_WIN] + (size_t)l * DM * NIN, DM, NIN, (bf16_t*)(ws + WS_WIN) + (size_t)l * NIN * DM, (w >> 2) * 256, (w & 3) * 64 * CVK, CVK); return; }
    w -= CVI_WIN;
    if (w < CVI_GLU) { conv_run<0>(lds_g, tab[I_WGLU] + (size_t)l * 512 * 512, 512, 512, (bf16_t*)(ws + WS_WGLU) + (size_t)l * 512 * 512, (w >> 1) * 256, (w & 1) * 64 * CVK, CVK); return; }
    w -= CVI_GLU;
    if (w < CVI_UP) { conv_run<0>(lds_g, tab[I_WUP5] + (size_t)l * 512 * 1024, 512, 1024, (bf16_t*)(ws + WS_WUP5) + (size_t)l * 1024 * 512, (w >> 1) * 256, (w & 1) * 64 * CVK, CVK); return; }
    w -= CVI_UP;
    if (w < CVI_UP) { conv_run<0>(lds_g, tab[I_WUPH] + (size_t)l * 512 * 1024, 512, 1024, (bf16_t*)(ws + WS_WUPH) + (size_t)l * 1024 * 512, (w >> 1) * 256, (w & 1) * 64 * CVK, CVK); return; }
    w -= CVI_UP;
    if (w < CVI_OUT) { conv_run<0>(lds_g, tab[I_WOUT] + (size_t)l * 1024 * 1024, 1024, 1024, (bf16_t*)(ws + WS_WOUT) + (size_t)l * 1024 * 1024, (w >> 2) * 256, (w & 3) * 64 * CVK, CVK); return; }
    w -= CVI_OUT;
    const int le = l * NE + w / (CVI_W1 + CVI_W2); w = w % (CVI_W1 + CVI_W2);
    if (w < CVI_W1) { if (MOE1_FP8) conv_run8<1>(lds_g, tab[I_W1] + (size_t)le * 1024 * 2048, 1024, 2048, (unsigned char*)(ws + WS_W1) + (size_t)le * 2048 * 1024, (w >> 2) * 256, (w & 3) * 64 * CVK, CVK);
        else conv_run<1>(lds_g, tab[I_W1] + (size_t)le * 1024 * 2048, 1024, 2048, (bf16_t*)(ws + WS_W1) + (size_t)le * 2048 * 1024, (w >> 2) * 256, (w & 3) * 64 * CVK, CVK); }
    else { w -= CVI_W1; if (MOE2_FP8) conv_run8<0>(lds_g, tab[I_W2] + (size_t)le * 1024 * 1024, 1024, 1024, (unsigned char*)(ws + WS_W2) + (size_t)le * 1024 * 1024, (w >> 2) * 256, (w & 3) * 64 * CVK, CVK);
        else conv_run<0>(lds_g, tab[I_W2] + (size_t)le * 1024 * 1024, 1024, 1024, (bf16_t*)(ws + WS_W2) + (size_t)le * 1024 * 1024, (w >> 2) * 256, (w & 3) * 64 * CVK, CVK); }
}
static __device__ __forceinline__ void conv_steal(unsigned char* ws, const float* const* tab, unsigned char* lds_g, int L, int nmax) {
    int* wq = (int*)(lds_g + LDS_BYTES - 64);
    unsigned* ctr = (unsigned*)(ws + WS_CTL) + CW_WQ2 + (L * 8) * 64;
    int x = lbid() & 7, tries = 0;
    for (int n = 0; n < nmax && tries < 8; ) {
        __syncthreads();
        if (ltid() == 0) *wq = (int)atomicAdd(ctr + x * 64, 1u);
        __syncthreads();
        const int v = *wq * 8 + x;
        if (v >= CVI_PER_LAYER) { x = (x + 1) & 7; ++tries; if (nmax < 8) break; continue; }
        conv_item(ws, tab, lds_g, L, v); ++n;
    }
    __syncthreads();
}
static __device__ __forceinline__ void phase_prologue(unsigned char* ws, const float* const* tab, unsigned char* lds_g, int qslot) {
    const int tid = ltid(), lane = tid & 63, wid = tid >> 6;
    float* lsf = (float*)lds_g;
    int* wq = (int*)(lds_g + LDS_BYTES - 64);
    unsigned* ctr = (unsigned*)(ws + WS_CTL) + CW_WQ + 64 * (qslot ? 5 : 0);
    for (;;) {
        __syncthreads();
        if (tid == 0) *wq = (int)atomicAdd(ctr, 1u);
        __syncthreads();
        int v = *wq;
        if (v >= PQ_TOTAL) break;
        if (v < PQ_S5) { s5_stage1(ws, tab, lds_g, v / S5G, v % S5G); continue; }
        v -= PQ_S5;
        if (v < PQ_MOD) {
            const int l = v / 96, j = (v % 96) * 64 + (tid & 63), ks = tid >> 6;
            const float* mw = tab[I_MODW] + (size_t)l * DM * NMOD; float a0 = 0.f, a1 = 0.f, a2 = 0.f;
#pragma unroll 8
            for (int k = ks * 128; k < ks * 128 + 128; ++k) { const float w = mw[(size_t)k * NMOD + j]; const float c0 = tab[I_C][k], c1 = tab[I_C][DM + k], c2 = tab[I_CCTX][k];
                a0 += c0 * sigmoidf_(c0) * w; a1 += c1 * sigmoidf_(c1) * w; a2 += c2 * sigmoidf_(c2) * w; }
            lsf[(ks * 3 + 0) * 64 + (tid & 63)] = a0; lsf[(ks * 3 + 1) * 64 + (tid & 63)] = a1; lsf[(ks * 3 + 2) * 64 + (tid & 63)] = a2;
            __syncthreads();
            if (tid < 192) { const int r = tid >> 6, c = tid & 63; float s = 0.f;
#pragma unroll
                for (int k = 0; k < 8; ++k) s += lsf[(k * 3 + r) * 64 + c];
                const int jj = (v % 96) * 64 + c; ((float*)(ws + WS_MOD))[(size_t)(l * 3 + r) * NMOD + jj] = s + tab[I_MODB][l * NMOD + jj]; }
            continue; }
        v -= PQ_MOD;
        if (v < PQ_CONV) { conv_item(ws, tab, lds_g, 0, v); continue; }
        v -= PQ_CONV;
        if (v < PQ_XF) {
#pragma unroll 4
            for (int rr = 0; rr < 32; ++rr) { const int r = v * 256 + rr * 8 + wid; const float* sp = r < NLAT ? tab[I_X] + (size_t)r * DM : tab[I_CTX] + (size_t)(r - NLAT) * DM;
#pragma unroll
                for (int k = 0; k < 4; ++k) st_bf4((bf16_t*)(ws + WS_XF) + (size_t)r * DM + lane * 4 + k * 256, *(const f32x4*)(sp + lane * 4 + k * 256)); }
            continue; }
        {
#pragma unroll
            for (int hh = 0; hh < 2; ++hh) { const int idx = hh * 512 + tid, d = idx >> 9, ch = idx & 511; const float* lg = tab[I_LBL] + (size_t)d * (DEPTH + 1) * 512 + ch;
                float e[DEPTH + 1], mx = -1e30f, s = 0.f;
#pragma unroll
                for (int k = 0; k <= DEPTH; ++k) { e[k] = lg[k * 512]; mx = fmaxf(mx, e[k]); }
#pragma unroll
                for (int k = 0; k <= DEPTH; ++k) { e[k] = expf(e[k] - mx); s += e[k]; }
                float cum = 0.f;
#pragma unroll
                for (int k = 0; k < DEPTH; ++k) { cum += e[k] / s; ((float*)(ws + WS_LB))[(d * DEPTH + k) * 512 + ch] = cum; } } }
    }
}

static __device__ __forceinline__ void phase_norm1(unsigned char* ws, const float* const* tab, unsigned char* lds_g, int l) {
    if (l == 0) for (int u = lbid(); u < DEPTH * S5G * 4; u += gridDim.x) s5_stage2(ws, tab, lds_g, u / (S5G * 4), (u >> 2) & (S5G - 1), u & 3);
    const int tid = ltid(), lane = tid & 63, wid = tid >> 6; const int odd = l & 1;
    const float* MODl = (const float*)(ws + WS_MOD) + (size_t)l * 3 * NMOD;
    for (int u = lbid(); u < NTOK / 8; u += gridDim.x) { const int r = u * 8 + wid; const int mb = r < NLAT ? (r >> 14) : 2;
        f32x4 x[4];
#pragma unroll
        for (int k = 0; k < 4; ++k) x[k] = *(const f32x4*)((r < NLAT ? tab[I_X] + (size_t)r * DM : tab[I_CTX] + (size_t)(r - NLAT) * DM) + lane * 4 + k * 256);
        norm_mod_row(x, tab[I_N1G] + l * DM, MODl + mb * NMOD, MODl + mb * NMOD + DM, lane);
        bf16_t* hp = (bf16_t*)(ws + WS_HA) + (size_t)sigma_row(r, odd) * DM;
#pragma unroll
        for (int k = 0; k < 4; ++k) st_bf4(hp + lane * 4 + k * 256, x[k]); }
}

__device__ __forceinline__ int chunk_at(int b, int d, int s) {
    if (s < 4) return 512 + b * 4 + (d ? 3 - s : s);
    const int c = s - 4; return b * 256 + (d ? 255 - c : c);
}

constexpr int HP = 136, HPT = 72;
__device__ __forceinline__ bf16x8 lds_frag(const bf16_t* p) { return *(const bf16x8*)p; }
__device__ __forceinline__ void deal3(int c, int c1, int c2, int n0, int n1, int n2, int total, int& first, int& last) {
    int s = c < c1 ? c * n0 : (c < c2 ? c1 * n0 + (c - c1) * n1 : c1 * n0 + (c2 - c1) * n1 + (c - c2) * n2);
    int n = c < c1 ? n0 : (c < c2 ? n1 : n2);
    first = s; last = s + n; if (last > total) last = total; if (first > total) first = total;
}
__device__ __forceinline__ void hgrn_local_phase(unsigned char* ws, unsigned char* lds_g, int l) {
    bf16_t* KT = (bf16_t*)lds_g;
    bf16_t* VT = KT + 2 * 128 * HPT;
    float* qs = (float*)(VT + 128 * HPT);
    const int tid = ltid(), lane = tid & 63, wid = tid >> 6, dk = tid & 127, qt = tid >> 7, fr = lane & 15, fq = lane >> 4, G = gridDim.x;
    const int nunits = NCHUNK * HH;
    int u, uend; if (G == 256) deal3(lbid(), 128, 160, 9, 8, 7, nunits, u, uend); else { const int per = (nunits + G - 1) / G; u = lbid() * per; uend = u + per < nunits ? u + per : nunits; }
    if (u >= uend) return;
    const bf16_t* Zb = (const bf16_t*)(ws + WS_Z);
    unsigned short rf[2][16]; u32x4 vraw[2];
#define HL_LOADRAW(uu) do { const int rho_ = (uu) >> 2, h_ = (uu) & 3; const bf16_t* Zr = Zb + (size_t)rho_ * 64 * ZC + h_ * 128; \
        _Pragma("unroll") for (int jj = 0; jj < 16; ++jj) { const bf16_t* zj = Zr + (size_t)jj * ZC; rf[0][jj] = zj[loff + ZFF]; rf[1][jj] = zj[loff + ZFB]; } \
        _Pragma("unroll") for (int k = 0; k < 2; ++k) { const int idx = tid + k * 512, s = idx >> 4, dvg = idx & 15; vraw[k] = *(const u32x4*)(Zr + (size_t)s * ZC + ZI + dvg * 8); } } while (0)
    const int loff = qt * 16 * ZC + dk;
    HL_LOADRAW(u);
    for (; u < uend; ++u) {
        const int rho = u >> 2, h = u & 3;
        float lf[2][16], kk[2][16];
#pragma unroll
        for (int d = 0; d < 2; ++d) { const float lb = ((const float*)(ws + WS_LB))[(d * DEPTH + l) * 512 + h * 128 + dk]; float qsum = 1.f;
#pragma unroll
            for (int jj = 0; jj < 16; ++jj) { const float f = bf2f(rf[d][jj]); const float sg = sigf(f);
                lf[d][jj] = lb + (1.0f - lb) * sg; kk[d][jj] = (1.0f - lb) * (1.0f - sg); qsum *= lf[d][jj]; }
            qs[(d * 4 + qt) * 128 + dk] = qsum; }
#pragma unroll
        for (int k = 0; k < 2; ++k) { const int idx = tid + k * 512, s = idx >> 4, dvg = idx & 15; const unsigned ww[4] = {vraw[k].x, vraw[k].y, vraw[k].z, vraw[k].w};
#pragma unroll
            for (int i = 0; i < 4; ++i) { VT[(dvg * 8 + 2 * i) * HPT + s] = (bf16_t)(ww[i] & 0xffffu); VT[(dvg * 8 + 2 * i + 1) * HPT + s] = (bf16_t)(ww[i] >> 16); } }
        if (u + 1 < uend) HL_LOADRAW(u + 1);
        __syncthreads();
#pragma unroll
        for (int d = 0; d < 2; ++d) { float after = 1.f, tot = 0.f;
#pragma unroll
            for (int k = 0; k < 4; ++k) { const float s = qs[(d * 4 + k) * 128 + dk]; tot += lg2(s); if (d == 0 ? (k > qt) : (k < qt)) after *= s; }
            float kh[16];
            if (d == 0) { float run = after;
#pragma unroll
                for (int jj = 15; jj >= 0; --jj) { kh[jj] = kk[d][jj] * run; run *= lf[d][jj]; } }
            else { float run = after;
#pragma unroll
                for (int jj = 0; jj < 16; ++jj) { kh[jj] = kk[d][jj] * run; run *= lf[d][jj]; } }
            u32x4 o0, o1; o0.x = pack2(kh[0], kh[1]); o0.y = pack2(kh[2], kh[3]); o0.z = pack2(kh[4], kh[5]); o0.w = pack2(kh[6], kh[7]);
            o1.x = pack2(kh[8], kh[9]); o1.y = pack2(kh[10], kh[11]); o1.z = pack2(kh[12], kh[13]); o1.w = pack2(kh[14], kh[15]);
            bf16_t* kp = KT + (d * 128 + dk) * HPT + qt * 16; *(u32x4*)kp = o0; *(u32x4*)(kp + 8) = o1;
            if (qt == 0) ((float*)(ws + WS_HTOT))[((size_t)(rho * HH + h) * 2 + d) * 128 + dk] = tot; }
        __syncthreads();
#pragma unroll
        for (int d = 0; d < 2; ++d) { f32x4 acc[8];
#pragma unroll
            for (int n = 0; n < 8; ++n) acc[n] = (f32x4){0.f, 0.f, 0.f, 0.f};
#pragma unroll
            for (int ks = 0; ks < 2; ++ks) { const bf16x8 a = lds_frag(KT + (d * 128 + wid * 16 + fr) * HPT + ks * 32 + fq * 8);
#pragma unroll
                for (int n = 0; n < 8; ++n) { const bf16x8 b = lds_frag(VT + (n * 16 + fr) * HPT + ks * 32 + fq * 8); acc[n] = __builtin_amdgcn_mfma_f32_16x16x32_bf16(a, b, acc[n], 0, 0, 0); } }
            unsigned char* KV = (unsigned char*)(ws + WS_HKV) + ((size_t)(rho * HH + h) * 2 + d) * 16384;
#pragma unroll
            for (int n = 0; n < 8; ++n) *(unsigned*)(KV + (n * 16 + fr) * 128 + wid * 16 + fq * 4) = pack4_fp8(acc[n][0] * KV_SCALE, acc[n][1] * KV_SCALE, acc[n][2] * KV_SCALE, acc[n][3] * KV_SCALE); }
        __syncthreads();
    }
#undef HL_LOADRAW
}
__device__ __forceinline__ void hgrn_carry2(unsigned char* ws, int u) {
    const int eb = u & 15, d = (u >> 4) & 1, h = (u >> 5) & 3, b = u >> 7; const int e2 = eb * 512 + ltid(), dkp = e2 & 63;
    const unsigned short* KV = (const unsigned short*)(ws + WS_HKV); const float* TOT = (const float*)(ws + WS_HTOT); unsigned short* HS = (unsigned short*)(ws + WS_HS);
    float S0 = 0.f, S1 = 0.f;
    for (int s0 = 0; s0 < 260; s0 += 13) { unsigned kv[13]; float t0[13], t1[13]; unsigned si[13];
#pragma unroll
        for (int k = 0; k < 13; ++k) { si[k] = (unsigned)((chunk_at(b, d, s0 + k) * HH + h) * 2 + d); kv[k] = KV[(size_t)si[k] * 8192 + e2]; const float2 tt = *(const float2*)(TOT + (size_t)si[k] * 128 + 2 * dkp); t0[k] = tt.x; t1[k] = tt.y; }
#pragma unroll
        for (int k = 0; k < 13; ++k) { typedef float f32x2v __attribute__((ext_vector_type(2))); const f32x2v kf = __builtin_amdgcn_cvt_pk_f32_fp8(kv[k], false);
            HS[(size_t)si[k] * 8192 + e2] = (unsigned short)__builtin_amdgcn_cvt_pk_fp8_f32(sat_fp8(S0 * HS_SCALE), sat_fp8(S1 * HS_SCALE), 0u, false);
            S0 = ex2(t0[k]) * S0 + kf.x * (1.0f / KV_SCALE); S1 = ex2(t1[k]) * S1 + kf.y * (1.0f / KV_SCALE); } }
}
__device__ __forceinline__ void hgrn_out_phase(unsigned char* ws, const float* const* tab, unsigned char* lds_g, int l) {
    bf16_t* Qa = (bf16_t*)lds_g;
    bf16_t* Qi = Qa + 64 * HP;
    bf16_t* Kd = Qi + 32 * HP;
    bf16_t* Ko = Kd + 64 * HP;
    bf16_t* ST = Ko + 32 * HP;
    bf16_t* VT = ST + 128 * HP;
    bf16_t* Pm = VT + 128 * HPT;
    float* qs = (float*)(Pm + 64 * HPT);
    float* ssq = qs + 1024;
    const int tid = ltid(), lane = tid & 63, wid = tid >> 6, fr = lane & 15, fq = lane >> 4, G = gridDim.x;
    const int dp2 = 2 * lane, rg = __builtin_amdgcn_readfirstlane(wid);
    const int nunits = (l == DEPTH - 1 ? NLAT / CH : NCHUNK) * HH;
    int u, uend;
    if (G == 256 && l == DEPTH - 1) { u = lbid() * 8; uend = u + 8; }
    else if (G == 256) { const int c = lbid(); if (c < 128) deal3(c, 64, 128, 10, 9, 0, nunits, u, uend); else { deal3(c - 128, 96, 128, 7, 6, 0, nunits - 1216, u, uend); u += 1216; uend += 1216; } }
    else { const int per = (nunits + G - 1) / G; u = lbid() * per; uend = u + per < nunits ? u + per : nunits; }
    if (u >= uend) return;
    const bf16_t* Zb = (const bf16_t*)(ws + WS_Z);
    const int tt0 = wid >> 2, st = wid & 3;
    const int ot = wid & 3, oh = wid >> 2;
    unsigned rq[8], rf[2][8];
#define HO_LOADRAW(uu) do { const int rho_ = (uu) >> 2, h_ = (uu) & 3; const bf16_t* Zr = Zb + (size_t)rho_ * 64 * ZC + h_ * 128 + (size_t)(rg * 8) * ZC; \
        _Pragma("unroll") for (int jj = 0; jj < 8; ++jj) { const bf16_t* zj = Zr + (size_t)jj * ZC; rq[jj] = *(const unsigned*)(zj + ZQ + dp2); rf[0][jj] = *(const unsigned*)(zj + ZFF + dp2); rf[1][jj] = *(const unsigned*)(zj + ZFB + dp2); } } while (0)
    u32x4 vraw[2], sraw[2];
#define HO_LOADVS(uu) do { const int rho_ = (uu) >> 2, h_ = (uu) & 3; const bf16_t* Zv = Zb + (size_t)rho_ * 64 * ZC + ZI + h_ * 128; \
        _Pragma("unroll") for (int k = 0; k < 2; ++k) { const int idx = tid + k * 512, s_ = idx >> 4, dvg = idx & 15; vraw[k] = *(const u32x4*)(Zv + (size_t)s_ * ZC + dvg * 8); } \
        const u32x4* sp_ = (const u32x4*)((const unsigned char*)(ws + WS_HS) + ((size_t)(rho_ * HH + h_) * 2) * 16384); \
        _Pragma("unroll") for (int k = 0; k < 2; ++k) sraw[k] = sp_[tid + k * 512]; } while (0)
    HO_LOADRAW(u); HO_LOADVS(u);
    for (; u < uend; ++u) {
        const int rho = u >> 2, h = u & 3;
        const bf16_t* Z = Zb + (size_t)rho * 64 * ZC;
        u32x4 sbw[2]; u32x2 graw[4];
        const u32x4* sp0 = (const u32x4*)((const unsigned char*)(ws + WS_HS) + ((size_t)(rho * HH + h) * 2) * 16384);
        float qv0[8], qv1[8];
#pragma unroll
        for (int jj = 0; jj < 8; ++jj) { qv0[jj] = bflo(rq[jj]); qv1[jj] = bfhi(rq[jj]); }
        f32x4 O[4], Pk[2];
#pragma unroll
        for (int n = 0; n < 4; ++n) O[n] = (f32x4){0.f, 0.f, 0.f, 0.f};
        Pk[0] = Pk[1] = (f32x4){0.f, 0.f, 0.f, 0.f};
#pragma unroll
        for (int d = 0; d < 2; ++d) {
            const float2 lb2 = *(const float2*)((const float*)(ws + WS_LB) + (d * DEPTH + l) * 512 + h * 128 + dp2);
            float g0[8], g1[8], k0[8], k1[8], pr0 = 1.f, pr1 = 1.f;
#pragma unroll
            for (int jj = 0; jj < 8; ++jj) { const float s0 = sigf(bflo(rf[d][jj])), s1 = sigf(bfhi(rf[d][jj]));
                g0[jj] = lb2.x + (1.0f - lb2.x) * s0; k0[jj] = (1.0f - lb2.x) * (1.0f - s0); pr0 *= g0[jj];
                g1[jj] = lb2.y + (1.0f - lb2.y) * s1; k1[jj] = (1.0f - lb2.y) * (1.0f - s1); pr1 *= g1[jj]; }
            if (d == 1) __syncthreads();
            *(float2*)(qs + rg * 128 + dp2) = make_float2(pr0, pr1);
#pragma unroll
            for (int k = 0; k < 2; ++k) { const int idx = tid + k * 512, r = idx >> 3, c = idx & 7; const u32x4 w = d == 0 ? sraw[k] : sbw[k];
                const u32x2 q0 = fp8x4_to_bf16x4(w.x, 1.0f / HS_SCALE), q1 = fp8x4_to_bf16x4(w.y, 1.0f / HS_SCALE), q2 = fp8x4_to_bf16x4(w.z, 1.0f / HS_SCALE), q3 = fp8x4_to_bf16x4(w.w, 1.0f / HS_SCALE);
                *(u32x4*)(ST + r * HP + c * 16) = (u32x4){q0.x, q0.y, q1.x, q1.y}; *(u32x4*)(ST + r * HP + c * 16 + 8) = (u32x4){q2.x, q2.y, q3.x, q3.y}; }
            if (d == 0) {
#pragma unroll
                for (int k = 0; k < 2; ++k) sbw[k] = sp0[1024 + tid + k * 512];
#pragma unroll
                for (int n = 0; n < 4; ++n) graw[n] = *(const u32x2*)(Z + (size_t)(ot * 16 + fr) * ZC + ZG + h * 128 + (oh * 4 + n) * 16 + fq * 4); }
            if (d == 0) {
#pragma unroll
                for (int k = 0; k < 2; ++k) { const int idx = tid + k * 512, s = idx >> 4, dvg = idx & 15; const unsigned ww[4] = {vraw[k].x, vraw[k].y, vraw[k].z, vraw[k].w};
#pragma unroll
                    for (int i = 0; i < 4; ++i) { VT[(dvg * 8 + 2 * i) * HPT + s] = (bf16_t)(ww[i] & 0xffffu); VT[(dvg * 8 + 2 * i + 1) * HPT + s] = (bf16_t)(ww[i] >> 16); } } }
            __syncthreads();
            float b10 = 1.f, b11 = 1.f, R0 = 1.f, R1 = 1.f;
#pragma unroll
            for (int g = 0; g < 8; ++g) { const float2 gp = *(const float2*)(qs + g * 128 + dp2);
                const bool first = d == 0 ? (g < 4) : (g >= 4);
                const bool before = d == 0 ? (g >= (rg & ~3) && g < rg) : (g > rg && g <= (rg | 3));
                if (first) { b10 *= gp.x; b11 *= gp.y; }
                if (before) { R0 *= gp.x; R1 *= gp.y; } }
            const bool later = d == 0 ? (rg >= 4) : (rg < 4);
            float Ri0 = __builtin_amdgcn_rcpf(R0), Ri1 = __builtin_amdgcn_rcpf(R1);
#pragma unroll
            for (int jx = 0; jx < 8; ++jx) { const int jj = d == 0 ? jx : 7 - jx; const int j = rg * 8 + jj;
                R0 *= g0[jj]; R1 *= g1[jj]; Ri0 *= __builtin_amdgcn_rcpf(g0[jj]); Ri1 *= __builtin_amdgcn_rcpf(g1[jj]);
                const float qa0 = qv0[jj] * R0, qa1 = qv1[jj] * R1, kd0 = k0[jj] * Ri0, kd1 = k1[jj] * Ri1;
                *(unsigned*)(Qa + j * HP + dp2) = pack2(qa0, qa1); *(unsigned*)(Kd + j * HP + dp2) = pack2(kd0, kd1);
                if (later) *(unsigned*)(Qi + (j & 31) * HP + dp2) = pack2(qa0 * b10, qa1 * b11); else *(unsigned*)(Ko + (j & 31) * HP + dp2) = pack2(kd0 * b10, kd1 * b11); }
            if (d == 1) { asm volatile("" ::: "memory"); if (u + 1 < uend) { HO_LOADRAW(u + 1); HO_LOADVS(u + 1); } }
            __syncthreads();
#pragma unroll
            for (int pp = 0; pp < 2; ++pp) { const int tt = tt0 + 2 * pp; const bool need = d == 0 ? (st <= tt) : (st >= tt);
                if (need) { const bool same = (tt >> 1) == (st >> 1); const bf16_t* Kt = same ? Kd + (st * 16) * HP : Ko + ((st & 1) * 16) * HP; f32x4 D = (f32x4){0.f, 0.f, 0.f, 0.f};
#pragma unroll
                    for (int ks = 0; ks < 4; ++ks) D = __builtin_amdgcn_mfma_f32_16x16x32_bf16(lds_frag(Kt + fr * HP + ks * 32 + fq * 8), lds_frag(Qa + (tt * 16 + fr) * HP + ks * 32 + fq * 8), D, 0, 0, 0);
                    if (tt == st) {
#pragma unroll
                        for (int r = 0; r < 4; ++r) { const int sl = fq * 4 + r; const bool keep = d == 0 ? (sl <= fr) : (sl >= fr); if (!keep) D[r] = 0.f; } }
                    Pk[pp] += D; } }
            if (d == 1) {
#pragma unroll
                for (int pp = 0; pp < 2; ++pp) { const int tt = tt0 + 2 * pp; st_bf4(Pm + (tt * 16 + fr) * HPT + st * 16 + fq * 4, Pk[pp]); } }
            { const bool useQi = d == 0 ? (ot >= 2) : (ot < 2); const bf16_t* Qx = useQi ? Qi + ((ot & 1) * 16) * HP : Qa + (ot * 16) * HP;
#pragma unroll
              for (int ks = 0; ks < 4; ++ks) { const bf16x8 bq = lds_frag(Qx + fr * HP + ks * 32 + fq * 8);
#pragma unroll
                for (int n = 0; n < 4; ++n) O[n] = __builtin_amdgcn_mfma_f32_16x16x32_bf16(lds_frag(ST + ((oh * 4 + n) * 16 + fr) * HP + ks * 32 + fq * 8), bq, O[n], 0, 0, 0); } }
        }
        __syncthreads();
#pragma unroll
        for (int ks = 0; ks < 2; ++ks) { const bf16x8 bp = lds_frag(Pm + (ot * 16 + fr) * HPT + ks * 32 + fq * 8);
#pragma unroll
            for (int n = 0; n < 4; ++n) O[n] = __builtin_amdgcn_mfma_f32_16x16x32_bf16(lds_frag(VT + ((oh * 4 + n) * 16 + fr) * HPT + ks * 32 + fq * 8), bp, O[n], 0, 0, 0); }
        float ss = 0.f;
#pragma unroll
        for (int n = 0; n < 4; ++n) ss += O[n][0] * O[n][0] + O[n][1] * O[n][1] + O[n][2] * O[n][2] + O[n][3] * O[n][3];
        ss += __shfl_xor(ss, 16); ss += __shfl_xor(ss, 32);
        if (fq == 0) ssq[oh * 64 + ot * 16 + fr] = ss;
        __syncthreads();
        const int t = ot * 16 + fr; const float rstd = rsqrtf((ssq[t] + ssq[64 + t]) * (1.0f / 128.0f) + EPS);
        const float* ng = tab[I_HNG] + l * 128;
        bf16_t* Y = (bf16_t*)(ws + WS_YCAT) + (size_t)(rho * 64 + t) * DM + 512 + h * 128;
#pragma unroll
        for (int n = 0; n < 4; ++n) { const int dv = (oh * 4 + n) * 16 + fq * 4; const f32x4 g = (f32x4){bflo(graw[n].x), bfhi(graw[n].x), bflo(graw[n].y), bfhi(graw[n].y)}; const f32x4 w = *(const f32x4*)(ng + dv); f32x4 o;
#pragma unroll
            for (int r = 0; r < 4; ++r) o[r] = O[n][r] * rstd * w[r] * g[r] * sigmoidf_(g[r]);
            st_bf4(Y + dv, o); }
        __syncthreads();
    }
#undef HO_LOADRAW
#undef HO_LOADVS
}

__device__ __forceinline__ void s5_carry(unsigned char* ws, const float* const* tab, int l, int u) {
    const int idx = u * 512 + ltid(), p = idx & 63, d = (idx >> 6) & 1, g = (idx >> 7) & 31, b = idx >> 12;
    const float2 lam = ((const float2*)(ws + WS_LAMT))[((l * 2 + d) * S5G + g) * 64 + p];
    const float* E = (const float*)(ws + WS_S5E) + (size_t)g * UAROWS * 256 + d * 128 + p;
    bf16_t* X = (bf16_t*)(ws + WS_UA) + (size_t)g * UAROWS * UALD + 1024 + d * 128 + p;
    float xr = 0.f, xi = 0.f;
    for (int s0 = 0; s0 < 260; s0 += 4) { float er[4], ei[4]; int rho[4];
#pragma unroll
        for (int k = 0; k < 4; ++k) { rho[k] = chunk_at(b, d, s0 + k); er[k] = E[(size_t)rho[k] * 256]; ei[k] = E[(size_t)rho[k] * 256 + 64]; }
#pragma unroll
        for (int k = 0; k < 4; ++k) { X[(size_t)rho[k] * UALD] = f2bf(xr); X[(size_t)rho[k] * UALD + 64] = f2bf(xi);
            const float nr = lam.x * xr - lam.y * xi + er[k], ni = lam.x * xi + lam.y * xr + ei[k]; xr = nr; xi = ni; } }
}

static __device__ __forceinline__ void phase_norm2_route(unsigned char* ws, const float* const* tab, unsigned char* lds_g, int l, int probe = 0) {
    constexpr int HPF = 1028;
    float* hrow = (float*)lds_g;
    int* hist = (int*)(hrow + 32 * HPF);
    int* base = hist + 32;
    const int tid = ltid(), lane = tid & 63, wid = tid >> 6, e = lane & 31;
    const float* MODl = (const float*)(ws + WS_MOD) + (size_t)l * 3 * NMOD;
    const float* RW = tab[I_RW] + (size_t)l * DM * NE; const float* RB = tab[I_RB] + l * NE;
    unsigned* CNT = (unsigned*)(ws + WS_CTL) + CW_CNT + (l + (probe ? DEPTH : 0)) * NE;
    const size_t pofs = probe ? (WS_ACT - WS_TOPE) : 0;
    float bw0[32], bw1[32];
    { const int fr = lane & 15, fq = lane >> 4; const float* bp = RW + (size_t)(wid * 128 + fq) * NE + fr;
#pragma unroll
      for (int ks = 0; ks < 32; ++ks) { bw0[ks] = bp[(size_t)ks * 4 * NE]; bw1[ks] = bp[(size_t)ks * 4 * NE + 16]; } }
    int pe = 0, pl = 0, pr = -1; float pg = 0.f; unsigned bres = 0u;
#define ROUTE_FLUSH() do { if (lane < 16 && pr >= 0) { const size_t o = (size_t)pr * 4 + (lane & 3); const int rk = base[pe] + pl; \
            ((int*)(ws + pofs + WS_TOPE))[o] = pe; ((int*)(ws + pofs + WS_TOPR))[o] = rk; \
            if (!probe) { ((int*)(ws + WS_ROWTOK))[(size_t)pe * NTOK + rk] = pr; ((float*)(ws + WS_ROWGATE))[(size_t)pe * NTOK + rk] = pg; } } } while (0)
    for (int u = lbid(); u < ((l == DEPTH - 1) ? NLAT : NTOK) / 32; u += gridDim.x) {
        if (tid < 32) hist[tid] = 0;
#pragma unroll
        for (int i = 0; i < 4; ++i) { const int r = u * 32 + wid * 4 + i; const int mb = r < NLAT ? (r >> 14) : 2;
            f32x4 x[4];
#pragma unroll
            for (int k = 0; k < 4; ++k) x[k] = ld_bf4((const bf16_t*)(ws + WS_XF) + (size_t)r * DM + lane * 4 + k * 256);
            norm_mod_row(x, tab[I_N2G] + l * DM, MODl + mb * NMOD + 3 * DM, MODl + mb * NMOD + 4 * DM, lane);
            unsigned* hp = (unsigned*)(ws + WS_HA8 + (size_t)r * DM);
#pragma unroll
            for (int k = 0; k < 4; ++k) { if (MOE1_FP8) hp[lane + k * 64] = pack4_fp8(x[k][0] * FP8_ASCALE, x[k][1] * FP8_ASCALE, x[k][2] * FP8_ASCALE, x[k][3] * FP8_ASCALE); else st_bf4((bf16_t*)(ws + WS_HA) + (size_t)r * DM + lane * 4 + k * 256, x[k]); *(f32x4*)(hrow + (wid * 4 + i) * HPF + lane * 4 + k * 256) = x[k]; } }
        if (tid < 32) base[tid] = (int)bres;
        __syncthreads();
        ROUTE_FLUSH();
        { const int fr = lane & 15, fq = lane >> 4; f32x4 acc00 = (f32x4){0.f, 0.f, 0.f, 0.f}, acc01 = acc00, acc10 = acc00, acc11 = acc00;
          const float* ap = hrow + fr * HPF + wid * 128 + fq;
#pragma unroll
          for (int ks = 0; ks < 32; ++ks) { const float a0 = ap[ks * 4], a1 = ap[16 * HPF + ks * 4];
              acc00 = __builtin_amdgcn_mfma_f32_16x16x4f32(a0, bw0[ks], acc00, 0, 0, 0); acc01 = __builtin_amdgcn_mfma_f32_16x16x4f32(a0, bw1[ks], acc01, 0, 0, 0);
              acc10 = __builtin_amdgcn_mfma_f32_16x16x4f32(a1, bw0[ks], acc10, 0, 0, 0); acc11 = __builtin_amdgcn_mfma_f32_16x16x4f32(a1, bw1[ks], acc11, 0, 0, 0); }
          __syncthreads();
          float* part = hrow + (wid * 32 + fq * 4) * 32;
#pragma unroll
          for (int r = 0; r < 4; ++r) { part[r * 32 + fr] = acc00[r]; part[r * 32 + 16 + fr] = acc01[r]; part[(16 + r) * 32 + fr] = acc10[r]; part[(16 + r) * 32 + 16 + fr] = acc11[r]; } }
        __syncthreads();
        int myl = 0, mye = 0; float myg = 0.f;
#pragma unroll
        for (int i = 0; i < 4; ++i) { const int rl = wid * 4 + i; float v = ((hrow[(0 * 32 + rl) * 32 + e] + hrow[(1 * 32 + rl) * 32 + e]) + (hrow[(2 * 32 + rl) * 32 + e] + hrow[(3 * 32 + rl) * 32 + e])) + ((hrow[(4 * 32 + rl) * 32 + e] + hrow[(5 * 32 + rl) * 32 + e]) + (hrow[(6 * 32 + rl) * 32 + e] + hrow[(7 * 32 + rl) * 32 + e])) + RB[e]; float tv[4]; int te[4];
#pragma unroll
            for (int k = 0; k < 4; ++k) { float best = v; int bi = e;
#pragma unroll
                for (int o = 16; o >= 1; o >>= 1) { const float ov = __shfl_xor(best, o); const int oi = __shfl_xor(bi, o); if (ov > best || (ov == best && oi < bi)) { best = ov; bi = oi; } }
                tv[k] = best; te[k] = bi; if (e == bi) v = -3.0e38f; }
            float ex[4], s = 0.f;
#pragma unroll
            for (int k = 0; k < 4; ++k) { ex[k] = __expf(tv[k] - tv[0]); s += ex[k]; }
            const float inv = 1.0f / s;
#pragma unroll
            for (int k = 0; k < 4; ++k) if (lane == i * 4 + k) { mye = te[k]; myg = ex[k] * inv; } }
        if (lane < 16) myl = atomicAdd(&hist[mye], 1);
        __syncthreads();
        if (tid < 32) bres = atomicAdd(&CNT[tid], (unsigned)hist[tid]);
        pe = mye; pl = myl; pg = myg; pr = u * 32 + wid * 4 + (lane >> 2);
    }
    if (tid < 32) base[tid] = (int)bres;
    __syncthreads();
    ROUTE_FLUSH();
#undef ROUTE_FLUSH
    __syncthreads();
}
__device__ __forceinline__ void moe_segments(unsigned char* ws, int* ps, int l) {
    const int tid = ltid();
    if (tid < 64) { const unsigned* CNT = (const unsigned*)(ws + WS_CTL) + CW_CNT + l * NE; const int e = tid & 31;
        const int n = (int)((__hip_atomic_load(CNT + e, __ATOMIC_RELAXED, __HIP_MEMORY_SCOPE_AGENT) + 255u) >> 8);
        int inc = n;
#pragma unroll
        for (int o = 1; o < 32; o <<= 1) { const int v = __shfl_up(inc, o); if ((tid & 31) >= o) inc += v; }
        const int exc = inc - n;
        if (tid < 32) { ps[e] = exc << 8; if (e == NE - 1) ps[NE] = inc << 8; for (int k = 0; k < n; ++k) ps[64 + exc + k] = e; } }
    __syncthreads();
}
static __device__ __forceinline__ void phase_combine(unsigned char* ws, const float* const* tab, unsigned char* lds_g, int l, int probe = 0) {
    int* ps = (int*)lds_g; moe_segments(ws, ps, l);
    const int tid = ltid(), lane = tid & 63, wid = tid >> 6;
    const float* MODl = (const float*)(ws + WS_MOD) + (size_t)l * 3 * NMOD;
    const int* TE = (const int*)(ws + WS_TOPE); const int* TR = (const int*)(ws + WS_TOPR); const bf16_t* O2 = (const bf16_t*)(ws + WS_OUT2);
    const int nu = ((l == DEPTH - 1) ? NLAT : NTOK) / 8; const int G = gridDim.x;
    typedef int i32x4 __attribute__((ext_vector_type(4)));
    int u = lbid(); if (u >= nu) { __syncthreads(); return; }
    i32x4 en = *(const i32x4*)(TE + (size_t)(u * 8 + wid) * 4), rn = *(const i32x4*)(TR + (size_t)(u * 8 + wid) * 4);
    for (; u < nu; u += G) { const int r = u * 8 + wid; const int mb = r < NLAT ? (r >> 14) : 2;
        const int p0 = ps[en[0]] + rn[0], p1 = ps[en[1]] + rn[1], p2 = ps[en[2]] + rn[2], p3 = ps[en[3]] + rn[3];
        if (u + G < nu) { en = *(const i32x4*)(TE + (size_t)((u + G) * 8 + wid) * 4); rn = *(const i32x4*)(TR + (size_t)((u + G) * 8 + wid) * 4); }
        static_assert(OUT2_FP8, "the wide-lane combine reads fp8 expert rows");
        const bf16_t* xp = (const bf16_t*)(ws + WS_XF) + (size_t)r * DM + lane * 16; bf16_t* xo = (bf16_t*)(ws + (probe ? WS_ACT : WS_XF)) + (size_t)r * DM + lane * 16; f32x4 x[4];
        { const unsigned char* O8 = (const unsigned char*)O2 + lane * 16;
          const u32x4 w0 = *(const u32x4*)(O8 + (size_t)p0 * DM), w1 = *(const u32x4*)(O8 + (size_t)p1 * DM), w2 = *(const u32x4*)(O8 + (size_t)p2 * DM), w3 = *(const u32x4*)(O8 + (size_t)p3 * DM);
          f32x4 xa, xb, xc, xd; ld_bf8(xp, xa, xb); ld_bf8(xp + 8, xc, xd);
          const float* gp = MODl + mb * NMOD + 5 * DM + lane * 16;
          const unsigned a0[4] = {w0.x, w0.y, w0.z, w0.w}, a1[4] = {w1.x, w1.y, w1.z, w1.w}, a2[4] = {w2.x, w2.y, w2.z, w2.w}, a3[4] = {w3.x, w3.y, w3.z, w3.w};
          const f32x4 xr[4] = {xa, xb, xc, xd};
#pragma unroll
          for (int k = 0; k < 4; ++k) { const f32x4 y = (up4_fp8(a0[k]) + up4_fp8(a1[k])) + (up4_fp8(a2[k]) + up4_fp8(a3[k]));
              const f32x4 g = *(const f32x4*)(gp + k * 4) * (1.0f / OUT2_SCALE); x[k] = xr[k] + g * y; }
          if (l + 1 < DEPTH) { st_bf8(xo, x[0], x[1]); st_bf8(xo + 8, x[2], x[3]); } }
        if (l + 1 < DEPTH) { const float* MODn = MODl + 3 * NMOD;
            norm_mod_row<true>(x, tab[I_N1G] + (l + 1) * DM, MODn + mb * NMOD, MODn + mb * NMOD + DM, lane);
            bf16_t* hp = (bf16_t*)(ws + (probe ? WS_ACT + SZ_XF : WS_HA)) + (size_t)sigma_row(r, (l + 1) & 1) * DM + lane * 16;
            st_bf8(hp, x[0], x[1]); st_bf8(hp + 8, x[2], x[3]); }
        else if (r < NLAT) { float ss = 0.f;
#pragma unroll
            for (int k = 0; k < 4; ++k) ss += x[k][0] * x[k][0] + x[k][1] * x[k][1] + x[k][2] * x[k][2] + x[k][3] * x[k][3];
            ss = wave_sum(ss); const float rstd = rsqrtf(ss * (1.0f / DM) + EPS);
#pragma unroll
            for (int k = 0; k < 4; ++k) { const int c = lane * 16 + k * 4; *(f32x4*)((probe ? (float*)(ws + WS_ACT + SZ_XF) : (float*)tab[N_INPUTS]) + (size_t)r * DM + c) = x[k] * rstd * *(const f32x4*)(tab[I_FG] + c); } }
    }
    __syncthreads();
}

#define GAS __attribute__((address_space(1)))
template <class T> __device__ __forceinline__ T* launder(T* p) { unsigned long long v = (unsigned long long)p; asm volatile("" : "+s"(v)); GAS T* g = (GAS T*)v; return (T*)g; }
#define PHASE_FN static __device__ __forceinline__
#define G8_LDS(l) ((LAS unsigned char*)(l))
PHASE_FN void ph_inproj(unsigned char* ws, const float* const* tab, unsigned char* lds, int l) {
    g8::GridOrder S{(const char*)(ws + WS_HA), (const char*)(ws + WS_WIN) + (size_t)l * NIN * DM * 2, (size_t)256 * DM * 2, (size_t)256 * DM * 2, 130, 20, 130 * 20, (int)gridDim.x, lbid()};
    F8Inproj E{(bf16_t*)(ws + WS_UA), (bf16_t*)(ws + WS_Z), (unsigned char*)(ws + WS_ZG8)};
    g8::gemm_phase<true, false>(G8_LDS(lds), DM, DM * 2, DM * 2, S, E);
    if (l + 1 < DEPTH && (130 * 20) % (int)gridDim.x != 0 && (int)lbid() >= (130 * 20) % (int)gridDim.x) conv_steal(ws, tab, lds, l + 1, 1);
}
PHASE_FN void ph_s5e(unsigned char* ws, unsigned char* lds, int l) {
    S5Order S{(const char*)(ws + WS_UA), (const char*)(ws + WS_BT1) + (size_t)l * S5G * 256 * 1024 * 2, (size_t)UAROWS * UALD * 2, (size_t)256 * 1024 * 2, UALD * 2, 1024 * 2, 3, 1, (int)gridDim.x, lbid()};
    g8::Epi4<F8S5E> E{{(float*)(ws + WS_S5E)}};
    g8::gemm_phase<false, false>(G8_LDS(lds), 1024, UALD * 2, 1024 * 2, S, E);
}
PHASE_FN void ph_s5y(unsigned char* ws, unsigned char* lds, int l) {
    S5Order S{(const char*)(ws + WS_UA), (const char*)(ws + WS_BT2) + (size_t)l * S5G * 1024 * UALD * 2, (size_t)UAROWS * UALD * 2, (size_t)1024 * UALD * 2, UALD * 2, UALD * 2, (l == DEPTH - 1) ? 2 : 3, 4, (int)gridDim.x, lbid()};
    g8::Epi8<F8S5Y> E{{(bf16_t*)(ws + WS_Z5)}};
    g8::gemm_phase<true, false>(G8_LDS(lds), UALD, UALD * 2, UALD * 2, S, E);
}
PHASE_FN void ph_glu(unsigned char* ws, const float* const* tab, unsigned char* lds, int l) {
    const int probe_ = 0;
    const int nM = (l == DEPTH - 1) ? NLAT / 256 : NTOK / 256;
    g8::GridOrder S{(const char*)(ws + WS_Z5), (const char*)(ws + WS_WGLU) + (size_t)l * 512 * 512 * 2, (size_t)256 * 512 * 2, (size_t)256 * 512 * 2, nM, 2, nM * 2, (int)gridDim.x, lbid()};
    g8::Epi8<F8Glu> E{{(const bf16_t*)(ws + WS_Z5), (bf16_t*)(ws + WS_YCAT)}};
    g8::gemm_phase<true, false>(G8_LDS(lds), 512, 512 * 2, 512 * 2, S, E);
    if (l + 1 < DEPTH && !probe_ && (nM * 2) % (int)gridDim.x != 0 && (int)lbid() >= (nM * 2) % (int)gridDim.x) conv_steal(ws, tab, lds, l + 1, 1);
}
PHASE_FN void ph_up5(unsigned char* ws, const float* const* tab, unsigned char* lds, int l) {
    const int probe_ = 0;
    const int nM = (l == DEPTH - 1) ? NLAT / 256 : NTOK / 256;
    g8::GridOrder S{(const char*)(ws + WS_YCAT), (const char*)(ws + WS_WUP5) + (size_t)l * 1024 * 512 * 2, (size_t)256 * DM * 2, (size_t)256 * 512 * 2, nM, 4, nM * 4, (int)gridDim.x, lbid()};
    g8::Epi8<F8Up5> E{{(const bf16_t*)(ws + WS_Z), (bf16_t*)(ws + WS_MBUF), (const unsigned char*)(ws + WS_ZG8)}};
    g8::gemm_phase<true, false>(G8_LDS(lds), 512, DM * 2, 512 * 2, S, E);
    if (l + 1 < DEPTH && !probe_ && (nM * 4) % (int)gridDim.x != 0 && (int)lbid() >= (nM * 4) % (int)gridDim.x) conv_steal(ws, tab, lds, l + 1, 1);
}
PHASE_FN void ph_uph(unsigned char* ws, const float* const* tab, unsigned char* lds, int l, int probe = 0) {
    const int probe_ = probe;
    const int nM = (l == DEPTH - 1) ? NLAT / 256 : NTOK / 256;
    g8::GridOrder S{(const char*)(ws + WS_YCAT) + 512 * 2, (const char*)(ws + WS_WUPH) + (size_t)l * 1024 * 512 * 2, (size_t)256 * DM * 2, (size_t)256 * 512 * 2, nM, 4, nM * 4, (int)gridDim.x, lbid()};
    g8::Epi8<F8Uph> E{{(const bf16_t*)(ws + WS_Z), (bf16_t*)(ws + WS_MBUF), (bf16_t*)(ws + (probe ? WS_ACT : WS_MBUF)), (const unsigned char*)(ws + WS_ZG8)}};
    g8::gemm_phase<true, false>(G8_LDS(lds), 512, DM * 2, 512 * 2, S, E);
    if (l + 1 < DEPTH && !probe_ && (nM * 4) % (int)gridDim.x != 0 && (int)lbid() >= (nM * 4) % (int)gridDim.x) conv_steal(ws, tab, lds, l + 1, 1);
}
PHASE_FN void ph_out(unsigned char* ws, const float* const* tab, unsigned char* lds, int l, int probe = 0) {
    const int probe_ = probe;
    const int nM = (l == DEPTH - 1) ? NLAT / 256 : NTOK / 256;
    g8::GridOrder S{(const char*)(ws + WS_MBUF), (const char*)(ws + WS_WOUT) + (size_t)l * 1024 * 1024 * 2, (size_t)256 * DM * 2, (size_t)256 * DM * 2, nM, 4, nM * 4, (int)gridDim.x, lbid()};
    F8Out E{(bf16_t*)(ws + (probe ? WS_ACT : WS_XF)), (const float*)(ws + WS_MOD) + (size_t)l * 3 * NMOD, l & 1};
    g8::gemm_phase<true, false>(G8_LDS(lds), DM, DM * 2, DM * 2, S, E);
    if (l + 1 < DEPTH && !probe_ && (nM * 4) % (int)gridDim.x != 0 && (int)lbid() >= (nM * 4) % (int)gridDim.x) conv_steal(ws, tab, lds, l + 1, 2);
}
PHASE_FN void ph_moe1(unsigned char* ws, const float* const* tab, unsigned char* lds, int l) {
    int* ps = (int*)(lds + g8::STAGE_BYTES); moe_segments(ws, ps, l);
    constexpr unsigned EB = MOE1_FP8 ? 1u : 2u;
    MoeOrder S{(const char*)(ws + (MOE1_FP8 ? WS_HA8 : WS_HA)), (const char*)(ws + WS_W1) + (size_t)l * NE * 2048 * 1024 * EB, (const int*)(ws + WS_ROWTOK), ps + 64, 2048u * 1024u * EB, 8, ps[NE] >> 8, (int)gridDim.x, lbid(), true, 256 * DM * EB};
    F8Moe1 E{(bf16_t*)(ws + WS_ACT), tab[I_B1] + (size_t)l * NE * 2048};
    g8::gemm_phase<true, true, MOE1_FP8 != 0>(G8_LDS(lds), MOE1_FP8 ? DM / 2 : DM, DM * EB, DM * EB, S, E);
    if (l + 1 < DEPTH) { g8::Unit du; const int rounds = (S.ntile + 31) >> 5; if (rounds > 0 && !S.next(rounds - 1, du)) conv_steal(ws, tab, lds, l + 1, 1); }
}
PHASE_FN void ph_moe2(unsigned char* ws, const float* const* tab, unsigned char* lds, int l) {
    int* ps = (int*)(lds + g8::STAGE_BYTES); moe_segments(ws, ps, l);
    constexpr unsigned EB = MOE2_FP8 ? 1u : 2u;
    MoeOrder S{(const char*)(ws + WS_ACT), (const char*)(ws + WS_W2) + (size_t)l * NE * 1024 * 1024 * EB, (const int*)(ws + WS_ROWTOK), ps + 64, 1024u * 1024u * EB, 4, ps[NE] >> 8, (int)gridDim.x, lbid(), false, 256 * DM * EB};
    F8Moe2 E{(bf16_t*)(ws + WS_OUT2), tab[I_B2] + (size_t)l * NE * 1024, (const float*)(ws + WS_ROWGATE), ps};
    g8::gemm_phase<true, false, MOE2_FP8 != 0>(G8_LDS(lds), MOE2_FP8 ? DM / 2 : DM, DM * EB, DM * EB, S, E);
    if (l + 1 < DEPTH) { g8::Unit du; const int rounds = (S.ntile + 63) >> 6; if (rounds > 0 && !S.next(rounds - 1, du)) conv_steal(ws, tab, lds, l + 1, 1); }
}
PHASE_FN void ph_hgrn_local(unsigned char* ws, const float* const* tab, unsigned char* lds, int l) {
    hgrn_local_phase(ws, lds, l);
}
PHASE_FN void ph_carry(unsigned char* ws, const float* const* tab, int l) {
    for (int u = lbid(); u < 16 + 256; u += gridDim.x) { if (u < 16) s5_carry(ws, tab, l, u); else hgrn_carry2(ws, u - 16); }
}
PHASE_FN void ph_hgrn_out(unsigned char* ws, const float* const* tab, unsigned char* lds, int l) {
    hgrn_out_phase(ws, tab, lds, l);
}

constexpr int PH_PER_LAYER = 12;
constexpr int N_PHASES = 2 + DEPTH * PH_PER_LAYER;
__global__ void __launch_bounds__(NTHREADS, 2) mega(Params P) {
    extern __shared__ __attribute__((aligned(16))) unsigned char lds[];
    const int tid = threadIdx.x;
    LAS unsigned* xbw = (LAS unsigned*)(lds + LDS_BYTES - 16);
    if (tid < 4) xbw[tid] = 0u;
    unsigned char* ws = P.ws;
    const float** tabw = (const float**)(ws + WS_PTRS) + (size_t)blockIdx.x * 32;
    if (tid == 0) {
#pragma unroll
        for (int i = 0; i < N_INPUTS; ++i) tabw[i] = P.in[i];
        tabw[N_INPUTS] = P.out;
    }
    __syncthreads();
    const float* const* tab = (const float* const*)tabw;
    XcdBarrier bar; bar.bar = (unsigned*)(ws + WS_CTL) + CW_BAR; bar.x = 0; bar.st = nullptr;
    const int lo = P.ph_lo, hi = P.ph_hi;
    if (hi - lo > 1) bar = xcd_barrier_post((unsigned*)(ws + WS_CTL) + CW_BAR, (volatile LAS unsigned*)xbw);
#ifndef PROBE_DUP_MASK
#define PROBE_DUP_MASK 0
#endif
#define DUPON(j) ((PROBE_DUP_MASK >> (j)) & 1)
#define IN(k) (lo <= (k) && (k) < hi && ((ws = launder(ws)), (tab = launder(tab)), true))
#define SEAM(k) do { if ((k) + 1 < hi) xcd_barrier(bar); } while (0)

    if (IN(0)) { phase_prologue(ws, tab, lds, 0); if (DUPON(13)) { xcd_barrier(bar); ws = launder(ws); tab = launder(tab); phase_prologue(ws, tab, lds, 1); } SEAM(0); }
    if (IN(1)) { phase_norm1(ws, tab, lds, 0); SEAM(1); }
#define LAYER_BODY(l) do { const int pb = 2 + l * PH_PER_LAYER; \
        if (IN(pb + 0)) { { ph_inproj(ws, tab, lds, l); } if (DUPON(0)) { ws = launder(ws); tab = launder(tab); ph_inproj(ws, tab, lds, l); } SEAM(pb + 0); } \
        if (IN(pb + 1)) { { ph_s5e(ws, lds, l); ph_hgrn_local(ws, tab, lds, l); } if (DUPON(1)) { ws = launder(ws); tab = launder(tab); ph_s5e(ws, lds, l); ph_hgrn_local(ws, tab, lds, l); } SEAM(pb + 1); } \
        if (IN(pb + 2)) { { ph_carry(ws, tab, l); } if (DUPON(2)) { ws = launder(ws); tab = launder(tab); ph_carry(ws, tab, l); } SEAM(pb + 2); } \
        if (IN(pb + 3)) { { ph_s5y(ws, lds, l); ph_hgrn_out(ws, tab, lds, l); } if (DUPON(3)) { ws = launder(ws); tab = launder(tab); ph_s5y(ws, lds, l); ph_hgrn_out(ws, tab, lds, l); } SEAM(pb + 3); } \
        if (IN(pb + 4)) { { ph_glu(ws, tab, lds, l); } if (DUPON(4)) { ws = launder(ws); tab = launder(tab); ph_glu(ws, tab, lds, l); } SEAM(pb + 4); } \
        if (IN(pb + 5)) { { ph_up5(ws, tab, lds, l); } if (DUPON(5)) { ws = launder(ws); tab = launder(tab); ph_up5(ws, tab, lds, l); } SEAM(pb + 5); } \
        if (IN(pb + 6)) { ph_uph(ws, tab, lds, l); if (DUPON(6)) { ws = launder(ws); ph_uph(ws, tab, lds, l, 1); } SEAM(pb + 6); } \
        if (IN(pb + 7)) { ph_out(ws, tab, lds, l); if (DUPON(7)) { ws = launder(ws); ph_out(ws, tab, lds, l, 1); } SEAM(pb + 7); } \
        if (IN(pb + 8)) { phase_norm2_route(ws, tab, lds, l); if (DUPON(8)) { ws = launder(ws); tab = launder(tab); phase_norm2_route(ws, tab, lds, l, 1); } SEAM(pb + 8); } \
        if (IN(pb + 9)) { { ph_moe1(ws, tab, lds, l); } if (DUPON(10)) { ws = launder(ws); tab = launder(tab); ph_moe1(ws, tab, lds, l); } SEAM(pb + 9); } \
        if (IN(pb + 10)) { { ph_moe2(ws, tab, lds, l); } if (DUPON(11)) { ws = launder(ws); tab = launder(tab); ph_moe2(ws, tab, lds, l); } SEAM(pb + 10); } \
        if (IN(pb + 11)) { if (DUPON(12)) { phase_combine(ws, tab, lds, l, 1); ws = launder(ws); tab = launder(tab); } phase_combine(ws, tab, lds, l); if (l + 1 < DEPTH) conv_steal(ws, tab, lds, l + 1, 1 << 30); SEAM(pb + 11); } } while (0)
    LAYER_BODY(0); LAYER_BODY(1); LAYER_BODY(2); LAYER_BODY(3);
#undef LAYER_BODY
#undef IN
#undef SEAM
}

#ifndef MK_LAUNCH_PER_PHASE
#define MK_LAUNCH_PER_PHASE 0
#endif
extern "C" void kernel_launch(void* const* d_in, const int* in_sizes, int n_in, void* d_out, int out_size, void* d_ws, size_t ws_size, hipStream_t stream) {
    static int grid = 0;
    if (grid == 0) {
        if (n_in != N_INPUTS || out_size != NLAT * DM || ws_size < WS_END) { fprintf(stderr, "kernel_launch: unexpected problem (n_in %d, out %d, ws %zu < %zu)\n", n_in, out_size, ws_size, (size_t)WS_END); grid = -1; return; }
        int dev = 0, cus = 0, per_cu = 0;
        if (hipGetDevice(&dev) != hipSuccess || hipDeviceGetAttribute(&cus, hipDeviceAttributeMultiprocessorCount, dev) != hipSuccess) { grid = -1; return; }
        if (hipFuncSetAttribute((const void*)mega, hipFuncAttributeMaxDynamicSharedMemorySize, LDS_BYTES) != hipSuccess) { fprintf(stderr, "kernel_launch: hipFuncSetAttribute failed\n"); grid = -1; return; }
        if (hipOccupancyMaxActiveBlocksPerMultiprocessor(&per_cu, (const void*)mega, NTHREADS, LDS_BYTES) != hipSuccess || per_cu < 1) { fprintf(stderr, "kernel_launch: occupancy query says %d\n", per_cu); }
        (void)hipGetLastError();
        grid = cus;
    }
    if (grid < 0) return;
    (void)hipMemsetAsync((char*)d_ws + WS_CTL, 0, CTL_BYTES, stream);
    Params p{};
    for (int i = 0; i < N_INPUTS; ++i) p.in[i] = (const float*)d_in[i];
    p.out = (float*)d_out; p.ws = (unsigned char*)d_ws;
#if MK_LAUNCH_PER_PHASE
    for (int ph = 0; ph < N_PHASES; ++ph) { p.ph_lo = ph; p.ph_hi = ph + 1; hipLaunchKernelGGL(mega, dim3(grid), dim3(NTHREADS), LDS_BYTES, stream, p); }
#else
    p.ph_lo = 0; p.ph_hi = N_PHASES; hipLaunchKernelGGL(mega, dim3(grid), dim3(NTHREADS), LDS_BYTES, stream, p);
#endif
}
```
